# Optimizing an MI355X kernel written in HIP

```python
import math
import jax
import jax.numpy as jnp
from jax import lax
import numpy as np

D_MODEL = 1024
BATCH = 2
SEQ = 8192
DEPTH = 1

N_META = 16
Q_BLOCK = 128
ROPE_THETA = 500000.0
NORM_EPS = 1e-6
DA_HEADS = 4
DA_QK_DIM = 64
DA_V_DIM = 2 * DA_QK_DIM
DA_WIDTH = DA_HEADS * DA_V_DIM
DA_QK_WIDTH = DA_HEADS * 2 * DA_QK_DIM
ROPE_DIM = DA_QK_DIM // 4
RW_HEAD = 64
RW_WIDTH = D_MODEL - DA_WIDTH
RW_HEADS = RW_WIDTH // RW_HEAD
D_DECAY_LORA = 64
D_AAA_LORA = 64
D_GATE_LORA = 160
GN_EPS = 64e-5
MIX_WIDTH = DA_WIDTH + RW_WIDTH
DA_IN = 2 * DA_QK_WIDTH + DA_WIDTH
RW_IN = 3 * RW_WIDTH + D_DECAY_LORA + D_AAA_LORA + D_GATE_LORA
N_IN = DA_IN + RW_IN
D_FF = 2816

kernel_name = "hymba_diffattn_rwkv7_macaron"


def rms_norm(x, g, eps=NORM_EPS):
    xf = x.astype(jnp.float32)
    y = xf * lax.rsqrt(jnp.mean(xf * xf, axis=-1, keepdims=True) + eps)
    return (y * g.astype(jnp.float32)).astype(x.dtype)


def swiglu(x, w_gate, w_up, w_down):
    return (jax.nn.silu(x @ w_gate) * (x @ w_up)) @ w_down


def rope_tables(length):
    pos = jnp.arange(length, dtype=jnp.float32)
    inv_freq = ROPE_THETA ** (-jnp.arange(0, ROPE_DIM, 2, dtype=jnp.float32) / ROPE_DIM)
    ang = pos[:, None] * inv_freq[None, :]
    return jnp.cos(ang), jnp.sin(ang)


def apply_partial_rope(x, cos, sin):
    half = ROPE_DIM // 2
    c = cos[None, :, None, None, :].astype(x.dtype)
    s = sin[None, :, None, None, :].astype(x.dtype)
    x1, x2, rest = x[..., :half], x[..., half:ROPE_DIM], x[..., ROPE_DIM:]
    return jnp.concatenate([x1 * c - x2 * s, x2 * c + x1 * s, rest], axis=-1)


def token_shift(u, mix):
    prev = jnp.pad(u, ((0, 0), (1, 0), (0, 0)))[:, :-1]
    return u + (prev - u) * mix


def diff_attention(q, k, v, q_norm, k_norm, lq1, lk1, lq2, lk2, subln, cos, sin, lam_init):
    B, L, _ = q.shape
    q = q.reshape(B, L, DA_HEADS, 2, DA_QK_DIM)
    k = k.reshape(B, L, DA_HEADS, 2, DA_QK_DIM)
    v = v.reshape(B, L, DA_HEADS, DA_V_DIM)
    q = apply_partial_rope(rms_norm(q, q_norm), cos, sin)
    k = apply_partial_rope(rms_norm(k, k_norm), cos, sin)
    f32 = jnp.float32
    lam = (jnp.exp(jnp.sum(lq1.astype(f32) * lk1.astype(f32)))
           - jnp.exp(jnp.sum(lq2.astype(f32) * lk2.astype(f32))) + lam_init)
    kh = jnp.transpose(k, (0, 2, 3, 1, 4))
    vh = jnp.transpose(v, (0, 2, 1, 3))
    nb = L // Q_BLOCK
    qb = jnp.transpose(q, (0, 2, 3, 1, 4)).reshape(B, DA_HEADS, 2, nb, Q_BLOCK, DA_QK_DIM)
    qb = jnp.transpose(qb, (3, 0, 1, 2, 4, 5))
    kpos = jnp.arange(L)
    scale = DA_QK_DIM ** -0.5

    def one_block(args):
        q_blk, bi = args
        s = jnp.einsum('bhcqd,bhckd->bhcqk', q_blk, kh, preferred_element_type=f32) * scale
        qpos = bi * Q_BLOCK + jnp.arange(Q_BLOCK)
        s = jnp.where(kpos[None, :] <= qpos[:, None], s, -jnp.inf)
        p = jax.nn.softmax(s, axis=-1)
        attn = p[:, :, 0] - lam * p[:, :, 1]
        return jnp.einsum('bhqk,bhkd->bhqd', attn.astype(vh.dtype), vh)

    o = lax.map(one_block, (qb, jnp.arange(nb)))
    o = jnp.transpose(o, (1, 0, 3, 2, 4)).reshape(B, L, DA_HEADS, DA_V_DIM)
    o = rms_norm(o, subln) * (1.0 - lam_init)
    return o.reshape(B, L, DA_WIDTH)


def rwkv7_time_mix(r, k, v, w_lo, a_lo, g_lo, w0, w2, a0, a2, g2, k_k, k_a, r_k, ln_w, ln_b):
    B, L, C = r.shape
    f32 = jnp.float32

    def heads(t):
        return t.astype(f32).reshape(B, L, RW_HEADS, RW_HEAD)

    w_log = -jax.nn.softplus(-(w0 + jnp.tanh(w_lo) @ w2).astype(f32)) - 0.5
    decay = jnp.exp(-jnp.exp(w_log))
    a = jax.nn.sigmoid((a0 + a_lo @ a2).astype(f32))
    g = jax.nn.sigmoid(g_lo) @ g2
    kk = heads(k * k_k)
    kk = kk / jnp.maximum(jnp.linalg.norm(kk, axis=-1, keepdims=True), 1e-12)
    k = k.astype(f32) * (1.0 + (a - 1.0) * k_a.astype(f32))
    rh, kh, vh, wh, ah = heads(r), heads(k), heads(v), heads(decay), heads(a)
    a_neg = -kk
    b_vec = kk * ah

    def step(S, inp):
        r_t, w_t, k_t, v_t, an_t, b_t = inp
        sa = jnp.einsum('bhvk,bhk->bhv', S, an_t)
        S = S * w_t[:, :, None, :] + sa[..., None] * b_t[:, :, None, :] + v_t[..., None] * k_t[:, :, None, :]
        return S, jnp.einsum('bhvk,bhk->bhv', S, r_t)

    def seq_major(t):
        return jnp.swapaxes(t, 0, 1)

    S0 = jnp.zeros((B, RW_HEADS, RW_HEAD, RW_HEAD), f32)
    _, y = lax.scan(step, S0, (seq_major(rh), seq_major(wh), seq_major(kh),
                                seq_major(vh), seq_major(a_neg), seq_major(b_vec)))
    y = seq_major(y)
    mu = jnp.mean(y, axis=-1, keepdims=True)
    var = jnp.mean(jnp.square(y - mu), axis=-1, keepdims=True)
    y = ((y - mu) * lax.rsqrt(var + GN_EPS)).reshape(B, L, C) * ln_w.astype(f32) + ln_b.astype(f32)
    bonus = jnp.sum(rh * kh * r_k.astype(f32), axis=-1, keepdims=True) * vh
    out = (y + bonus.reshape(B, L, C)) * g.astype(f32)
    return out.astype(r.dtype)


def setup_inputs(seed: int = 0) -> dict:
    key = jax.random.key(seed)
    ks = jax.random.split(key, 32)
    f = jnp.float32

    def nrm(k, shape, scale):
        return jax.random.normal(k, shape, f) * scale

    def gain(k, shape):
        return 1.0 + 0.02 * jax.random.normal(k, shape, f)

    Dp = DEPTH
    ratio = jnp.arange(RW_WIDTH, dtype=f) / (RW_WIDTH - 1)
    w0_base = -7.0 + 5.0 * ratio ** 0.85 + 0.5
    return {
        "x": nrm(ks[0], (BATCH, SEQ, D_MODEL), 1.0),
        "meta_tokens": nrm(ks[1], (N_META, D_MODEL), 1.0),
        "ffn1_norm": gain(ks[2], (Dp, D_MODEL)),
        "ffn1_w_gate": nrm(ks[3], (Dp, D_MODEL, D_FF), D_MODEL ** -0.5),
        "ffn1_w_up": nrm(ks[4], (Dp, D_MODEL, D_FF), D_MODEL ** -0.5),
        "ffn1_w_down": nrm(ks[5], (Dp, D_FF, D_MODEL), D_FF ** -0.5),
        "mix_norm": gain(ks[6], (Dp, D_MODEL)),
        "w_in": nrm(ks[7], (Dp, D_MODEL, N_IN), D_MODEL ** -0.5),
        "da_q_norm": gain(ks[8], (Dp, DA_QK_DIM)),
        "da_k_norm": gain(ks[9], (Dp, DA_QK_DIM)),
        "da_lambda_q1": nrm(ks[10], (Dp, DA_QK_DIM), 0.1),
        "da_lambda_k1": nrm(ks[11], (Dp, DA_QK_DIM), 0.1),
        "da_lambda_q2": nrm(ks[12], (Dp, DA_QK_DIM), 0.1),
        "da_lambda_k2": nrm(ks[13], (Dp, DA_QK_DIM), 0.1),
        "da_subln": gain(ks[14], (Dp, DA_V_DIM)),
        "rw_shift_mix": jax.random.uniform(ks[15], (Dp, RW_IN), f),
        "rw_w0": w0_base[None, :] + nrm(ks[16], (Dp, RW_WIDTH), 0.1),
        "rw_w2": nrm(ks[17], (Dp, D_DECAY_LORA, RW_WIDTH), 0.1 * D_DECAY_LORA ** -0.5),
        "rw_a0": nrm(ks[18], (Dp, RW_WIDTH), 0.1),
        "rw_a2": nrm(ks[19], (Dp, D_AAA_LORA, RW_WIDTH), 0.1 * D_AAA_LORA ** -0.5),
        "rw_g2": nrm(ks[20], (Dp, D_GATE_LORA, RW_WIDTH), D_GATE_LORA ** -0.5),
        "rw_k_k": 0.85 + nrm(ks[21], (Dp, RW_WIDTH), 0.02),
        "rw_k_a": 1.0 + nrm(ks[22], (Dp, RW_WIDTH), 0.02),
        "rw_r_k": nrm(ks[23], (Dp, RW_HEADS, RW_HEAD), 0.1),
        "rw_ln_w": gain(ks[24], (Dp, RW_WIDTH)),
        "rw_ln_b": nrm(ks[25], (Dp, RW_WIDTH), 0.02),
        "w_out": nrm(ks[26], (Dp, MIX_WIDTH, D_MODEL), MIX_WIDTH ** -0.5),
        "ffn2_norm": gain(ks[27], (Dp, D_MODEL)),
        "ffn2_w_gate": nrm(ks[28], (Dp, D_MODEL, D_FF), D_MODEL ** -0.5),
        "ffn2_w_up": nrm(ks[29], (Dp, D_MODEL, D_FF), D_MODEL ** -0.5),
        "ffn2_w_down": nrm(ks[30], (Dp, D_FF, D_MODEL), D_FF ** -0.5),
    }


def reference(x, meta_tokens, ffn1_norm, ffn1_w_gate, ffn1_w_up, ffn1_w_down, mix_norm, w_in,
              da_q_norm, da_k_norm, da_lambda_q1, da_lambda_k1, da_lambda_q2, da_lambda_k2, da_subln,
              rw_shift_mix, rw_w0, rw_w2, rw_a0, rw_a2, rw_g2, rw_k_k, rw_k_a, rw_r_k, rw_ln_w, rw_ln_b,
              w_out, ffn2_norm, ffn2_w_gate, ffn2_w_up, ffn2_w_down):
    B, T, _ = x.shape
    L = N_META + T
    L_pad = -(-L // Q_BLOCK) * Q_BLOCK
    meta = jnp.broadcast_to(meta_tokens.astype(x.dtype)[None], (B, N_META, D_MODEL))
    h = jnp.concatenate([meta, x], axis=1)
    h = jnp.pad(h, ((0, 0), (0, L_pad - L), (0, 0)))
    cos, sin = rope_tables(L_pad)
    rw_splits = [RW_WIDTH, 2 * RW_WIDTH, 3 * RW_WIDTH,
                 3 * RW_WIDTH + D_DECAY_LORA, 3 * RW_WIDTH + D_DECAY_LORA + D_AAA_LORA]
    for l in range(DEPTH):
        lam_init = 0.8 - 0.6 * math.exp(-0.3 * l)
        h = h + 0.5 * swiglu(rms_norm(h, ffn1_norm[l]), ffn1_w_gate[l], ffn1_w_up[l], ffn1_w_down[l])
        n = rms_norm(h, mix_norm[l])
        u = n @ w_in[l]
        u_da, u_rw = u[..., :DA_IN], u[..., DA_IN:]
        q, k, v = jnp.split(u_da, [DA_QK_WIDTH, 2 * DA_QK_WIDTH], axis=-1)
        u_rw = token_shift(u_rw, rw_shift_mix[l])
        r_rw, k_rw, v_rw, w_lo, a_lo, g_lo = jnp.split(u_rw, rw_splits, axis=-1)
        o_da = diff_attention(q, k, v, da_q_norm[l], da_k_norm[l], da_lambda_q1[l], da_lambda_k1[l],
                              da_lambda_q2[l], da_lambda_k2[l], da_subln[l], cos, sin, lam_init)
        o_rw = rwkv7_time_mix(r_rw, k_rw, v_rw, w_lo, a_lo, g_lo, rw_w0[l], rw_w2[l], rw_a0[l],
                              rw_a2[l], rw_g2[l], rw_k_k[l], rw_k_a[l], rw_r_k[l], rw_ln_w[l], rw_ln_b[l])
        h = h + jnp.concatenate([o_da, o_rw], axis=-1) @ w_out[l]
        h = h + 0.5 * swiglu(rms_norm(h, ffn2_norm[l]), ffn2_w_gate[l], ffn2_w_up[l], ffn2_w_down[l])
    return h[:, N_META:L]
```

```cpp
#include <hip/hip_runtime.h>
#include <hip/hip_cooperative_groups.h>
#include <cstdio>
#include <cstdint>
namespace cg = cooperative_groups;
namespace pg8 {
#define PG8_LAS __attribute__((address_space(3)))
typedef unsigned short bf16_t;
typedef short bf16x8 __attribute__((ext_vector_type(8)));
typedef float f32x4 __attribute__((ext_vector_type(4)));
typedef unsigned u32x4 __attribute__((ext_vector_type(4)));
constexpr int BM = 256, BK = 64, HALF = 128, HTB = HALF * BK * 2  , STAGE_BYTES = 8 * HTB, NXCD = 8, WGM = 8;

__host__ __device__ __forceinline__ int lds_byte(int r, int c) { const int st = (r >> 4) * 2 + (c >> 5), rr = r & 15, cc = c & 31, ob = rr * 64 + cc * 2; return st * 1024 + (ob ^ (((ob >> 9) & 1) << 5)); }
__host__ __device__ __forceinline__ void stage_rc(int b, int& R, int& C) { const int st = b / 1024, sb = b % 1024, swz = sb ^ (((sb >> 9) & 1) << 5); R = (st >> 1) * 16 + swz / 64; C = (st & 1) * 32 + (swz % 64) / 2; }
__host__ __device__ __forceinline__ int perm32(int rho) { const int n = rho >> 4, i = rho & 15; return 8 * (i >> 2) + 4 * n + (i & 3); }

struct Unit { int pm, pn; };
struct Gemm { const bf16_t* A; const bf16_t* Bt; int M, N, K; };

struct StaticOrder {
    int nM, nN, nwg, G, c;
    __host__ __device__ void init(int M, int N, int G_, int c_) { nM = M / BM; nN = N / BM; nwg = nM * nN; G = G_; c = c_; }
    __host__ __device__ bool next(int i, Unit& u) const {
        const long L = (long)i * G + c; if (L >= nwg) return false;
        int wgid = (int)L; { const int q = nwg / NXCD, r = nwg % NXCD, xcd = wgid % NXCD, off = wgid / NXCD; wgid = (xcd < r ? xcd * (q + 1) : r * (q + 1) + (xcd - r) * q) + off; }
        const int nig = WGM * nN, gid = wgid / nig, fm = gid * WGM, gsz = (nM - fm) < WGM ? (nM - fm) : WGM;
        u.pm = fm + ((wgid % nig) % gsz); u.pn = (wgid % nig) / gsz; return true;
    }
    __device__ __forceinline__ void a_ready(const Unit&) const {}
    __device__ __forceinline__ void done(const Unit&) const {}
};
__device__ __forceinline__ unsigned cvt_pk_bf16(float lo, float hi) { unsigned r; asm volatile("v_cvt_pk_bf16_f32 %0, %1, %2" : "=v"(r) : "v"(lo), "v"(hi)); return r; }
template <class Epi, class Sched, bool ALIGN_EPI = false, bool SP2 = false>
__device__ __forceinline__ void gemm_phase(PG8_LAS unsigned char* lds, const Gemm g, const Sched& S, const Epi& E) {
    const int tid = threadIdx.x, wid = __builtin_amdgcn_readfirstlane(tid >> 6), lane = tid & 63, wr = wid >> 2, wc = wid & 3, fr = lane & 15, fq = lane >> 4;
    const int K = g.K, nt = K / BK;
    unsigned voffA[2], voffB[2];
#pragma unroll
    for (int i = 0; i < 2; ++i) { int R, C; stage_rc(tid * 16 + i * 8192, R, C); const int Rb = Epi::PERM ? ((R & ~31) + perm32(R & 31)) : R;
        voffA[i] = (unsigned)(R * K + C) * 2u; voffB[i] = (unsigned)(Rb * K + C) * 2u; }
    const size_t kstep = (size_t)(BK * 2);
    const size_t hstep = (size_t)HALF * K * 2;
    const size_t tstep = 2 * hstep;
    const unsigned ldsw = (unsigned)wid * 1024u;
    const int aoff = lds_byte(wr * 64 + fr, fq * 8), boff = lds_byte(wc * 32 + fr, fq * 8);
#define PG8_SA(b, h) (((b) * 2 + (h)) * HTB)
#define PG8_SB(b, h) ((4 + (b) * 2 + (h)) * HTB)
#define PG8_STAGE(bufoff, gbase, voff) do { _Pragma("unroll") for (int _i = 0; _i < 2; ++_i) \
        __builtin_amdgcn_global_load_lds((const unsigned*)((const char*)(gbase) + (voff)[_i]), (PG8_LAS unsigned*)(lds + (bufoff) + ldsw + _i * 8192), 16, 0, 0); } while (0)
#define PG8_LDA(dst, b, h) do { _Pragma("unroll") for (int m = 0; m < 4; ++m) _Pragma("unroll") for (int k = 0; k < 2; ++k) dst[m][k] = *(const PG8_LAS bf16x8*)(lds + PG8_SA(b, h) + aoff + m * 2048 + k * 1024); } while (0)
#define PG8_LDB(dst, b, h) do { _Pragma("unroll") for (int n = 0; n < 2; ++n) _Pragma("unroll") for (int k = 0; k < 2; ++k) dst[n][k] = *(const PG8_LAS bf16x8*)(lds + PG8_SB(b, h) + boff + n * 2048 + k * 1024); } while (0)
#define PG8_MMA(ai, bj, At, Bt) do { __builtin_amdgcn_s_setprio(1); _Pragma("unroll") for (int m = 0; m < 4; ++m) _Pragma("unroll") for (int n = 0; n < 2; ++n) _Pragma("unroll") for (int k = 0; k < 2; ++k) \
        acc[ai][bj][m][n] = __builtin_amdgcn_mfma_f32_16x16x32_bf16(Bt[n][k], At[m][k], acc[ai][bj][m][n], 0, 0, 0); __builtin_amdgcn_s_setprio(0); } while (0)
#define PG8_WAIT_V(n) asm volatile("s_waitcnt vmcnt(" #n ")" ::: "memory")
#define PG8_WAIT_L(n) asm volatile("s_waitcnt lgkmcnt(" #n ")" ::: "memory")
#define PG8_BAR __builtin_amdgcn_s_barrier()
#define PG8_SCHED __builtin_amdgcn_sched_barrier(0)
    Unit cur, nxt; int ui = 0;
    if (!S.next(0, cur)) return;
    f32x4 acc[2][2][4][2];
#pragma unroll
    for (int a = 0; a < 2; ++a)
#pragma unroll
        for (int b = 0; b < 2; ++b)
#pragma unroll
            for (int m = 0; m < 4; ++m)
#pragma unroll
                for (int n = 0; n < 2; ++n) acc[a][b][m][n] = (f32x4){0.f, 0.f, 0.f, 0.f};
    bf16x8 At[4][2], B0[2][2], B1[2][2];
    const char* cA = (const char*)g.A + (size_t)cur.pm * tstep; const char* cB = (const char*)g.Bt + (size_t)cur.pn * tstep;
    S.a_ready(cur);
    if constexpr (SP2) {
        PG8_STAGE(PG8_SB(0, 0), cB, voffB); PG8_STAGE(PG8_SB(0, 1), cB + hstep, voffB); PG8_STAGE(PG8_SA(0, 0), cA, voffA); PG8_STAGE(PG8_SA(0, 1), cA + hstep, voffA);
        if (wr == 1) PG8_BAR;
        PG8_WAIT_V(2); PG8_BAR;
        PG8_STAGE(PG8_SB(1, 0), cB + kstep, voffB); PG8_STAGE(PG8_SA(1, 0), cA + kstep, voffA); PG8_STAGE(PG8_SB(1, 1), cB + hstep + kstep, voffB);
        PG8_WAIT_V(6); PG8_BAR;
    } else {
        PG8_STAGE(PG8_SB(0, 0), cB, voffB); PG8_STAGE(PG8_SA(0, 0), cA, voffA); PG8_STAGE(PG8_SB(0, 1), cB + hstep, voffB); PG8_STAGE(PG8_SA(0, 1), cA + hstep, voffA);
        if (wr == 1) PG8_BAR;
        PG8_WAIT_V(4); PG8_BAR;
        PG8_STAGE(PG8_SB(1, 0), cB + kstep, voffB); PG8_STAGE(PG8_SA(1, 0), cA + kstep, voffA); PG8_STAGE(PG8_SB(1, 1), cB + hstep + kstep, voffB);
        PG8_WAIT_V(6); PG8_BAR;
    }
    for (;;) {
        const bool has_next = S.next(ui + 1, nxt);
        const char* nA = has_next ? (const char*)g.A + (size_t)nxt.pm * tstep : cA; const char* nB = has_next ? (const char*)g.Bt + (size_t)nxt.pn * tstep : cB;
        for (int t = 0; t < nt; t += 2) {
            const bool last = (t == nt - 2);
            const char* a1 = cA + (size_t)(t + 1) * kstep;
            const char* a2 = last ? nA : cA + (size_t)(t + 2) * kstep; const char* b2 = last ? nB : cB + (size_t)(t + 2) * kstep;
            const char* a3 = a2 + kstep; const char* b3 = b2 + kstep;
            if (last && has_next) S.a_ready(nxt);
            if constexpr (SP2) {
            PG8_LDB(B0, 0, 0); PG8_LDB(B1, 0, 1); PG8_SCHED; PG8_LDA(At, 0, 0); PG8_STAGE(PG8_SA(1, 1), a1 + hstep, voffA);
            PG8_WAIT_V(8); PG8_WAIT_L(0); PG8_BAR; PG8_MMA(0, 0, At, B0); PG8_MMA(0, 1, At, B1); PG8_BAR; PG8_SCHED;
            PG8_LDA(At, 0, 1); PG8_STAGE(PG8_SB(0, 0), b2, voffB); PG8_STAGE(PG8_SB(0, 1), b2 + hstep, voffB); PG8_STAGE(PG8_SA(0, 0), a2, voffA);
            PG8_WAIT_V(8); PG8_WAIT_L(0); PG8_BAR; PG8_MMA(1, 0, At, B0); PG8_MMA(1, 1, At, B1); PG8_BAR; PG8_SCHED;
            PG8_LDB(B0, 1, 0); PG8_LDB(B1, 1, 1); PG8_SCHED; PG8_LDA(At, 1, 0); PG8_STAGE(PG8_SA(0, 1), a2 + hstep, voffA);
            PG8_WAIT_V(8); PG8_WAIT_L(0); PG8_BAR; PG8_MMA(0, 0, At, B0); PG8_MMA(0, 1, At, B1); PG8_BAR; PG8_SCHED;
            PG8_LDA(At, 1, 1); PG8_STAGE(PG8_SB(1, 0), b3, voffB); PG8_STAGE(PG8_SB(1, 1), b3 + hstep, voffB); PG8_STAGE(PG8_SA(1, 0), a3, voffA);
            PG8_WAIT_V(8); PG8_WAIT_L(0); PG8_BAR; PG8_MMA(1, 0, At, B0); PG8_MMA(1, 1, At, B1); PG8_BAR; PG8_SCHED;
            } else {
            PG8_LDB(B0, 0, 0); PG8_SCHED; PG8_LDA(At, 0, 0); PG8_STAGE(PG8_SA(1, 1), a1 + hstep, voffA);
            PG8_WAIT_L(8); PG8_BAR; PG8_WAIT_L(0); PG8_MMA(0, 0, At, B0); PG8_BAR; PG8_SCHED;
            PG8_LDB(B1, 0, 1); PG8_STAGE(PG8_SB(0, 0), b2, voffB);
            PG8_BAR; PG8_WAIT_L(0); PG8_MMA(0, 1, At, B1); PG8_BAR;
            PG8_LDA(At, 0, 1); PG8_STAGE(PG8_SA(0, 0), a2, voffA);
            PG8_BAR; PG8_WAIT_L(0); PG8_MMA(1, 0, At, B0); PG8_BAR; PG8_SCHED;
            PG8_STAGE(PG8_SB(0, 1), b2 + hstep, voffB);
            PG8_WAIT_V(6); PG8_BAR; PG8_MMA(1, 1, At, B1); PG8_BAR;
            PG8_LDB(B0, 1, 0); PG8_SCHED; PG8_LDA(At, 1, 0); PG8_STAGE(PG8_SA(0, 1), a2 + hstep, voffA);
            PG8_WAIT_L(8); PG8_BAR; PG8_WAIT_L(0); PG8_MMA(0, 0, At, B0); PG8_BAR; PG8_SCHED;
            PG8_LDB(B1, 1, 1); PG8_STAGE(PG8_SB(1, 0), b3, voffB);
            PG8_BAR; PG8_WAIT_L(0); PG8_MMA(0, 1, At, B1); PG8_BAR;
            PG8_LDA(At, 1, 1); PG8_STAGE(PG8_SA(1, 0), a3, voffA);
            PG8_BAR; PG8_WAIT_L(0); PG8_MMA(1, 0, At, B0); PG8_BAR; PG8_SCHED;
            PG8_STAGE(PG8_SB(1, 1), b3 + hstep, voffB);
            PG8_WAIT_V(6); PG8_BAR; PG8_MMA(1, 1, At, B1); PG8_BAR;
            }
        }
        if constexpr (ALIGN_EPI) { if (wr == 0) PG8_BAR; }
        if constexpr (!Epi::AFTER_DRAIN) { E(acc, cur, wr, wc, fr, fq); S.done(cur); }
        if (!has_next) break;
#pragma unroll
        for (int a = 0; a < 2; ++a)
#pragma unroll
            for (int b = 0; b < 2; ++b)
#pragma unroll
                for (int m = 0; m < 4; ++m)
#pragma unroll
                    for (int n = 0; n < 2; ++n) acc[a][b][m][n] = (f32x4){0.f, 0.f, 0.f, 0.f};
        cur = nxt; cA = nA; cB = nB; ++ui;
        if constexpr (ALIGN_EPI) { if (wr == 1) PG8_BAR; }
    }
    PG8_WAIT_V(0);
    if constexpr (!ALIGN_EPI) { if (wr == 0) PG8_BAR; }
    PG8_BAR;
    if constexpr (Epi::AFTER_DRAIN) { E.fused(acc, cur, wr, wc, fr, fq, lds, wid, lane); S.done(cur); }
#undef PG8_SA
#undef PG8_SB
#undef PG8_STAGE
#undef PG8_LDA
#undef PG8_LDB
#undef PG8_MMA
#undef PG8_WAIT_V
#undef PG8_WAIT_L
#undef PG8_BAR
#undef PG8_SCHED
}
}
#define PG8_SP2 true
#define PG8_ALIGN true
#define LAS __attribute__((address_space(3)))
typedef unsigned short bf16;
typedef short bf16x8 __attribute__((ext_vector_type(8)));
typedef short s16x4 __attribute__((ext_vector_type(4)));
typedef float f32x4 __attribute__((ext_vector_type(4)));
typedef float f32x2 __attribute__((ext_vector_type(2)));
typedef float f32x16 __attribute__((ext_vector_type(16)));
typedef unsigned u32x4 __attribute__((ext_vector_type(4)));
typedef unsigned u32x2 __attribute__((ext_vector_type(2)));

constexpr int NWAVES = 8, NTHR = 512;
constexpr int BATCH = 2, T = 8192, D = 1024, FF = 2816, NMETA = 16, LP = 8208, M = BATCH * T, PR = BATCH * LP;
constexpr int NIN = 3360, NINP = 3584, DAW = 1536, RWW = 1824, VP = 8256;
constexpr float NORM_EPS = 1e-6f, GN_EPS = 64e-5f;
constexpr size_t MiB = 1u << 20;
constexpr size_t WS_XB = 0, WS_T = 32 * MiB, WS_URW = 32 * MiB, WS_UDA = 90 * MiB, WS_Y = 90 * MiB;
constexpr size_t WS_Q = 139 * MiB, QKV_BYTES = (size_t)BATCH * 4 * VP * 128 * 2, WS_K = WS_Q + QKV_BYTES, WS_VT = WS_K + QKV_BYTES;
constexpr size_t WS_W1A = 139 * MiB, WS_W1D = 150 * MiB, WS_WIN = 156 * MiB, WS_XB2 = 106 * MiB  , WS_TC = 139 * MiB  , WS_W2A = 122 * MiB, WS_W2D = 133 * MiB;
constexpr size_t WS_E = 188 * MiB, WS_A = 205 * MiB, WS_G = 222 * MiB;
constexpr size_t WS_WOUT = 239 * MiB, WS_LORA = 241 * MiB, WS_SMALL = 242 * MiB, WS_END = 244 * MiB;
static_assert(WS_VT + QKV_BYTES <= WS_E && (size_t)PR * RWW * 2 <= (WS_UDA - WS_URW) && (size_t)PR * DAW * 2 <= (WS_Q - WS_UDA) && (size_t)PR * 512 * 2 <= 17 * MiB, "ws map");
static_assert(WS_TC + (size_t)(M / 2) * FF * 2 <= WS_E && WS_Y + (size_t)M * 512 * 2 <= WS_XB2 && WS_XB2 + (size_t)(M / 2) * D * 2 <= WS_W2A, "tail ws map");
constexpr size_t SM_SSQ0 = 0, SM_SSQ1 = 65536, SM_SSQ2 = 131072, SM_BETA = 196608  , SM_XBM = 786432, SM_XBM2 = 819200, SM_TM = 851968  , SM_SSQM0 = 950272, SM_SSQM1 = 950528, SM_MISC = 950784;
constexpr int SUBW = 3584;
constexpr size_t SM_BAR = 983040;

__device__ __forceinline__ unsigned f2bf(float f) { unsigned u = __builtin_bit_cast(unsigned, f); return (u + 0x7fffu + ((u >> 16) & 1u)) >> 16; }
typedef __bf16 bf16x2_t __attribute__((ext_vector_type(2)));
__device__ __forceinline__ unsigned pk2(float lo, float hi) { const f32x2 v = {lo, hi}; return __builtin_bit_cast(unsigned, __builtin_convertvector(v, bf16x2_t)); }
__device__ __forceinline__ float bf2f(unsigned short b) { return __builtin_bit_cast(float, (unsigned)b << 16); }
__device__ __forceinline__ float bflo(unsigned w) { return __builtin_bit_cast(float, w << 16); }
__device__ __forceinline__ float bfhi(unsigned w) { return __builtin_bit_cast(float, w & 0xffff0000u); }
__device__ __forceinline__ float wave_sum(float v) {
#pragma unroll
    for (int o = 1; o < 64; o <<= 1) v += __shfl_xor(v, o);
    return v;
}
__device__ __forceinline__ float sigmoidf_(float x) { return __builtin_amdgcn_rcpf(1.0f + __expf(-x)); }
__device__ __forceinline__ u32x4 pack8(const float* v) { u32x4 w; w.x = pk2(v[0], v[1]); w.y = pk2(v[2], v[3]); w.z = pk2(v[4], v[5]); w.w = pk2(v[6], v[7]); return w; }
__device__ __forceinline__ void unpack8(u32x4 w, float* v) { v[0] = bflo(w.x); v[1] = bfhi(w.x); v[2] = bflo(w.y); v[3] = bfhi(w.y); v[4] = bflo(w.z); v[5] = bfhi(w.z); v[6] = bflo(w.w); v[7] = bfhi(w.w); }

struct Args {
    const float* in[31];
    float* out; unsigned char* ws;
};
enum { I_X = 0, I_META, I_F1N, I_F1G, I_F1U, I_F1D, I_MIXN, I_WIN, I_QN, I_KN, I_LQ1, I_LK1, I_LQ2, I_LK2, I_SUBLN, I_SHIFT, I_W0, I_W2, I_A0, I_A2, I_G2, I_KK, I_KA, I_RK, I_LNW, I_LNB, I_WOUT,
       I_F2N, I_F2G, I_F2U, I_F2D };

__device__ __forceinline__ int amap_tile(int k, int half) { return (k < 16 ? k : k + 16) + 16 * half; }
__device__ __forceinline__ int cmap_tile(int pm, int half) { const int p = pm - 16 * half; return p < 16 ? p : p - 16; }
struct EpiSwiglu {
    static constexpr bool PERM = true, AFTER_DRAIN = false;
    bf16* Tout; const float* ssq; int half, mode;
    __device__ __forceinline__ void operator()(const pg8::f32x4 (&acc)[2][2][4][2], const pg8::Unit& u, int wr, int wc, int fr, int fq) const {
        const int tA = mode == 1 ? amap_tile(u.pm, half) : u.pm;
        const int row0 = u.pm * 256 + wr * 64 + fr, row0A = tA * 256 + wr * 64 + fr, hc0 = u.pn * 128 + wc * 32 + 8 * fq;
#pragma unroll
        for (int ai = 0; ai < 2; ++ai)
#pragma unroll
            for (int m = 0; m < 4; ++m) {
                const int row = row0 + ai * 128 + m * 16;
                const float rs = rsqrtf(ssq[row0A + ai * 128 + m * 16] * (1.0f / D) + NORM_EPS);
                float t[8];
#pragma unroll
                for (int n = 0; n < 2; ++n)
#pragma unroll
                    for (int e = 0; e < 4; ++e) { const float g = acc[ai][0][m][n][e] * rs, up = acc[ai][1][m][n][e] * rs; t[4 * n + e] = g * sigmoidf_(g) * up; }
                *(u32x4*)(Tout + (size_t)row * FF + hc0) = pack8(t);
            }
    }
};
struct EpiRes {
    static constexpr bool PERM = true, AFTER_DRAIN = false;
    const float* base; float* out; bf16* xb; float* ssq; float scale; int half, mode;
    __device__ __forceinline__ void operator()(const pg8::f32x4 (&acc)[2][2][4][2], const pg8::Unit& u, int wr, int wc, int fr, int fq) const {
        const int tA = mode == 2 ? amap_tile(u.pm, half) : u.pm, tC = mode == 1 ? cmap_tile(u.pm, half) : u.pm;
        const int row0 = tA * 256 + wr * 64 + fr, row0C = tC * 256 + wr * 64 + fr, col0 = u.pn * 256 + wc * 32 + 8 * fq;
#pragma unroll
        for (int ai = 0; ai < 2; ++ai)
#pragma unroll
            for (int m = 0; m < 4; ++m) {
                const int row = row0 + ai * 128 + m * 16, rowC = row0C + ai * 128 + m * 16; float s = 0.f;
#pragma unroll
                for (int bj = 0; bj < 2; ++bj) {
                    const size_t o = (size_t)row * D + col0 + bj * 128, oC = (size_t)rowC * D + col0 + bj * 128;
                    const f32x4 b0 = *(const f32x4*)(base + o), b1 = *(const f32x4*)(base + o + 4);
                    const f32x4 h0 = b0 + acc[ai][bj][m][0] * scale, h1 = b1 + acc[ai][bj][m][1] * scale;
                    *(f32x4*)(out + o) = h0; *(f32x4*)(out + o + 4) = h1;
                    if (xb) { u32x4 w; w.x = pk2(h0[0], h0[1]); w.y = pk2(h0[2], h0[3]); w.z = pk2(h1[0], h1[1]); w.w = pk2(h1[2], h1[3]); *(u32x4*)(xb + oC) = w; }
                    s += (h0[0] * h0[0] + h0[1] * h0[1]) + (h0[2] * h0[2] + h0[3] * h0[3]) + (h1[0] * h1[0] + h1[1] * h1[1]) + (h1[2] * h1[2] + h1[3] * h1[3]);
                }
                if (ssq) { s += __shfl_xor(s, 16); s += __shfl_xor(s, 32); if (fq == 0) atomicAdd(ssq + row, s); }
            }
    }
};
struct HalfOrder {
    pg8::StaticOrder so; int half, actual;
    __device__ __forceinline__ void init(int N, int G_, int c_, int half_, int actual_) { so.init(M / 2, N, G_, c_); half = half_; actual = actual_; }
    __device__ __forceinline__ bool next(int i, pg8::Unit& u) const { if (!so.next(i, u)) return false; if (actual) u.pm = amap_tile(u.pm, half); return true; }
    __device__ __forceinline__ void a_ready(const pg8::Unit&) const {}
    __device__ __forceinline__ void done(const pg8::Unit&) const {}
};
struct EpiU {
    static constexpr bool PERM = true, AFTER_DRAIN = false;
    bf16* uda; bf16* urw; const float* ssq;
    __device__ __forceinline__ void operator()(const pg8::f32x4 (&acc)[2][2][4][2], const pg8::Unit& u, int wr, int wc, int fr, int fq) const {
        const int row0 = u.pm * 256 + wr * 64 + fr, col0 = u.pn * 256 + wc * 32 + 8 * fq;
#pragma unroll
        for (int ai = 0; ai < 2; ++ai)
#pragma unroll
            for (int m = 0; m < 4; ++m) {
                const int row = row0 + ai * 128 + m * 16;
                const int pr = (row >> 13) * LP + NMETA + (row & 8191);
                const float rs = rsqrtf(ssq[row] * (1.0f / D) + NORM_EPS);
#pragma unroll
                for (int bj = 0; bj < 2; ++bj) {
                    const int c = col0 + bj * 128;
                    if (c < NIN) {
                        float t[8];
#pragma unroll
                        for (int n = 0; n < 2; ++n)
#pragma unroll
                            for (int e = 0; e < 4; ++e) t[4 * n + e] = acc[ai][bj][m][n][e] * rs;
                        bf16* dst = (c < DAW) ? (uda + (size_t)pr * DAW + c) : (urw + (size_t)pr * RWW + (c - DAW));
                        *(u32x4*)dst = pack8(t);
                    }
                }
            }
    }
};

__device__ __forceinline__ f32x4 mfma16(bf16x8 a, bf16x8 b, f32x4 c) { return __builtin_amdgcn_mfma_f32_16x16x32_bf16(a, b, c, 0, 0, 0); }
__device__ __forceinline__ f32x16 mfma32(bf16x8 a, bf16x8 b, f32x16 c) { return __builtin_amdgcn_mfma_f32_32x32x16_bf16(a, b, c, 0, 0, 0); }
__device__ __forceinline__ f32x4 mm16(const bf16* A, int lda, const bf16* Bt, int ldb, int K, int lane) {
    const int r = lane & 15, q = lane >> 4;
    const bf16x8* ap = (const bf16x8*)(A + (size_t)r * lda + 8 * q);
    const bf16x8* bp = (const bf16x8*)(Bt + (size_t)r * ldb + 8 * q);
    f32x4 acc = {0.f, 0.f, 0.f, 0.f};
#pragma unroll 8
    for (int kk = 0; kk < K / 32; ++kk) acc = mfma16(ap[4 * kk], bp[4 * kk], acc);
    return acc;
}
__device__ __forceinline__ void transpose_item(const float* W, int K, int N, bf16* WT, const float* gain, int mode, LAS float* scr, int item, int lane) {
    const int nblk = (N + 63) / 64, kb = item / nblk, nb = item % nblk, k0 = 64 * kb, n0 = 64 * nb;
    const int r4 = lane >> 4, c4 = (lane & 15) * 4;
    const bool colok = n0 + c4 < N;
#pragma unroll
    for (int i = 0; i < 16; ++i) {
        const int kk = r4 + 4 * i;
        f32x4 v = {0.f, 0.f, 0.f, 0.f};
        if (colok) v = *(const f32x4*)(W + (size_t)(k0 + kk) * N + n0 + c4);
        if (gain) v = v * gain[k0 + kk];
        LAS float* d = scr + kk * 65 + c4; d[0] = v.x; d[1] = v.y; d[2] = v.z; d[3] = v.w;
    }
    asm volatile("s_waitcnt lgkmcnt(0)" ::: "memory");
    const int c = lane & 7;
#pragma unroll
    for (int j = 0; j < 8; ++j) {
        const int nl = (lane >> 3) + 8 * j, n = n0 + nl; const LAS float* s = scr + (8 * c) * 65 + nl;
        const int orow = (mode == 0) ? n : ((n >> 7) * 256 + (n & 127) + (mode == 2 ? 128 : 0));
        u32x4 o; o.x = pk2(s[0 * 65], s[1 * 65]); o.y = pk2(s[2 * 65], s[3 * 65]); o.z = pk2(s[4 * 65], s[5 * 65]); o.w = pk2(s[6 * 65], s[7 * 65]);
        if (n < N) *(u32x4*)(WT + (size_t)orow * K + k0 + 8 * c) = o;
    }
    asm volatile("s_waitcnt lgkmcnt(0)" ::: "memory");
}
__device__ __forceinline__ void row_to_bf16(const float* xrow, bf16* orow, float* ssq_out, int lane) {
    const f32x4* xr = (const f32x4*)xrow + lane; f32x4 v[4]; float s = 0.f;
#pragma unroll
    for (int j = 0; j < 4; ++j) { v[j] = xr[64 * j]; s += (v[j].x * v[j].x + v[j].y * v[j].y) + (v[j].z * v[j].z + v[j].w * v[j].w); }
    s = wave_sum(s); if (lane == 0) *ssq_out = s;
    u32x2* o8 = (u32x2*)orow + lane;
#pragma unroll
    for (int j = 0; j < 4; ++j) { u32x2 w; w.x = pk2(v[j].x, v[j].y); w.y = pk2(v[j].z, v[j].w); o8[64 * j] = w; }
}
__device__ __forceinline__ float dpp_f(float x, int ctrl_sel) {
    const int xi = __builtin_bit_cast(int, x); int r;
    if (ctrl_sel == 0) r = __builtin_amdgcn_update_dpp(0, xi, 0xB1, 0xF, 0xF, true);
    else if (ctrl_sel == 1) r = __builtin_amdgcn_update_dpp(0, xi, 0x4E, 0xF, 0xF, true);
    else if (ctrl_sel == 2) r = __builtin_amdgcn_update_dpp(0, xi, 0x141, 0xF, 0xF, true);
    else r = __builtin_amdgcn_update_dpp(0, xi, 0x140, 0xF, 0xF, true);
    return __builtin_bit_cast(float, r);
}
__device__ __forceinline__ float fmul_s(float a, float b) { float r; asm("v_mul_f32_e32 %0, %1, %2" : "=v"(r) : "v"(a), "v"(b)); return r; }
__device__ __forceinline__ float fadd_s(float a, float b) { float r; asm("v_add_f32_e32 %0, %1, %2" : "=v"(r) : "v"(a), "v"(b)); return r; }
__device__ __forceinline__ float fsub_s(float a, float b) { float r; asm("v_sub_f32_e32 %0, %1, %2" : "=v"(r) : "v"(a), "v"(b)); return r; }
__device__ __forceinline__ float ffma_s(float a, float b, float c) { float r; asm("v_fma_f32 %0, %1, %2, %3" : "=v"(r) : "v"(a), "v"(b), "v"(c)); return r; }
__device__ __forceinline__ float sum16(float x) { x += dpp_f(x, 0); x += dpp_f(x, 1); x += dpp_f(x, 2); x += dpp_f(x, 3); return x; }

#define XB_TMO      128
#define XB_XCNT(j)  (256  + 64 * (j))
#define XB_XSUB(j)  (1280 + 64 * (j))
#define XB_XGEN(j)  (2304 + 64 * (j))
#define XB_TOP      3328
#define XB_TOPGEN   3392
#define XCD_BAR_WORDS 3456
#define XB_SPIN_CAP (1u << 18)

__device__ __forceinline__ unsigned xb_ld(unsigned* p)              { return __hip_atomic_load(p, __ATOMIC_RELAXED, __HIP_MEMORY_SCOPE_AGENT); }
__device__ __forceinline__ unsigned xb_add(unsigned* p, unsigned v) { return __hip_atomic_fetch_add(p, v, __ATOMIC_RELAXED, __HIP_MEMORY_SCOPE_AGENT); }
__device__ __forceinline__ unsigned xb_xcc_id() { return (unsigned)__builtin_amdgcn_s_getreg((3 << 11) | 20) & 0xFu; }
#define XB_SPIN(cond, bar) do { unsigned _sp = 0; while (cond) { __builtin_amdgcn_s_sleep(1); \
    if ((++_sp & 255u) == 0u) { if (xb_ld(&(bar)[XB_TMO])) break; if (_sp > XB_SPIN_CAP) { atomicAdd(&(bar)[XB_TMO], 1u); break; } } } } while (0)

struct XcdBarrier {
    unsigned* bar; unsigned x;
    volatile LAS unsigned* st;
};

__device__ __forceinline__ XcdBarrier xcd_barrier_post(unsigned* bar, volatile LAS unsigned* st) {
    XcdBarrier b; b.bar = bar; b.x = xb_xcc_id(); b.st = st;
    if (threadIdx.x == 0) (void)xb_add(&bar[XB_XCNT(b.x)], 1u);
    return b;
}
__device__ __forceinline__ void xcd_barrier_complete(unsigned* bar, unsigned x, unsigned& nloc, unsigned& nx, unsigned gsz) {
    const unsigned G = gsz;
    unsigned sum, cnt, mine, sp = 0u;
    for (;;) {
        sum = 0u; cnt = 0u; mine = 0u;
#pragma unroll
        for (unsigned j = 0; j < 16; ++j) { const unsigned c = xb_ld(&bar[XB_XCNT(j)]); sum += c; cnt += (c > 0u) ? 1u : 0u; mine = (j == x) ? c : mine; }
        if (sum == G) break;
        __builtin_amdgcn_s_sleep(1);
        if ((++sp & 255u) == 0u) { if (xb_ld(&bar[XB_TMO])) break; if (sp > XB_SPIN_CAP) { atomicAdd(&bar[XB_TMO], 1u); break; } }
    }
    nloc = mine > 0u ? mine : 1u; nx = cnt > 0u ? cnt : 1u;
}

__device__ __forceinline__ void xcd_barrier(const XcdBarrier& b, unsigned gsz = 0u) {
    asm volatile("s_waitcnt vmcnt(0)" ::: "memory");
    __syncthreads();
    if (threadIdx.x == 0) {
        unsigned* bar = b.bar;
        __builtin_amdgcn_s_waitcnt(0);
        unsigned nloc = b.st[0], nx = b.st[1];
        if (nloc == 0u) { xcd_barrier_complete(bar, b.x, nloc, nx, gsz ? gsz : gridDim.x); b.st[0] = nloc; b.st[1] = nx; }
        const unsigned old = xb_add(&bar[XB_XSUB(b.x)], 1u);
        const unsigned gen = old / nloc;
        if (old + 1u == (gen + 1u) * nloc) {
            __builtin_amdgcn_fence(__ATOMIC_RELEASE, "agent");
            asm volatile("s_waitcnt vmcnt(0)" ::: "memory");
            const unsigned og = xb_add(&bar[XB_TOP], 1u);
            const unsigned tg = og / nx;
            if (og + 1u == (tg + 1u) * nx) xb_add(&bar[XB_TOPGEN], 1u);
            else XB_SPIN(xb_ld(&bar[XB_TOPGEN]) == tg, bar);
            __builtin_amdgcn_fence(__ATOMIC_ACQUIRE, "agent");
            xb_add(&bar[XB_XGEN(b.x)], 1u);
            asm volatile("s_waitcnt vmcnt(0)" ::: "memory");
        } else {
            XB_SPIN(xb_ld(&bar[XB_XGEN(b.x)]) == gen, bar);
            __builtin_amdgcn_fence(__ATOMIC_ACQUIRE, "agent");
            asm volatile("s_waitcnt vmcnt(0)" ::: "memory");
        }
    }
    __syncthreads();
}

__device__ __forceinline__ void p6_half(const bf16* URW, const bf16* Ab, const bf16* Gb, const bf16* Y, bf16* XB, const float* mixp, const float* ka, const float* rk, const float* lnwp, const float* lnbp,
                                        int half, int wi, int nw, int lane) {
    const int c0 = 8 * lane;
    float mr[8], mk[8], mv[8], kac[8], rkc[8], lnw[8], lnb[8];
#pragma unroll
    for (int j = 0; j < 8; ++j) { mr[j] = mixp[c0 + j]; mk[j] = mixp[512 + c0 + j]; mv[j] = mixp[1024 + c0 + j]; kac[j] = ka[c0 + j]; rkc[j] = rk[c0 + j]; lnw[j] = lnwp[c0 + j]; lnb[j] = lnbp[c0 + j]; }
    for (int r = wi; r < M / 2; r += nw) {
        const int m = amap_tile(r >> 8, half) * 256 + (r & 255);
        const int b = m >> 13, t = m & 8191, pr = b * LP + NMETA + t;
        const bf16* cur = URW + (size_t)pr * RWW + c0; const bf16* prv = cur - RWW;
        float rc[8], rp[8], kc[8], kp[8], vc[8], vp[8], a8[8], g8[8], y[8];
        unpack8(*(const u32x4*)cur, rc); unpack8(*(const u32x4*)prv, rp); unpack8(*(const u32x4*)(cur + 512), kc); unpack8(*(const u32x4*)(prv + 512), kp);
        unpack8(*(const u32x4*)(cur + 1024), vc); unpack8(*(const u32x4*)(prv + 1024), vp);
        unpack8(*(const u32x4*)(Ab + (size_t)pr * 512 + c0), a8); unpack8(*(const u32x4*)(Gb + (size_t)pr * 512 + c0), g8);
        unpack8(*(const u32x4*)(Y + (size_t)m * 512 + c0), y);
        float s = 0.f, beta = 0.f;
#pragma unroll
        for (int j = 0; j < 8; ++j) { s += y[j]; const float r_ = rc[j] + (rp[j] - rc[j]) * mr[j], k_ = kc[j] + (kp[j] - kc[j]) * mk[j]; beta += r_ * (k_ * (1.0f + (a8[j] - 1.0f) * kac[j])) * rkc[j]; }
        s += __shfl_xor(s, 1); s += __shfl_xor(s, 2); s += __shfl_xor(s, 4);
        beta += __shfl_xor(beta, 1); beta += __shfl_xor(beta, 2); beta += __shfl_xor(beta, 4);
        const float mu = s * (1.0f / 64); float q = 0.f;
#pragma unroll
        for (int j = 0; j < 8; ++j) { y[j] -= mu; q += y[j] * y[j]; }
        q += __shfl_xor(q, 1); q += __shfl_xor(q, 2); q += __shfl_xor(q, 4);
        const float rstd = rsqrtf(q * (1.0f / 64) + GN_EPS);
        float o[8];
#pragma unroll
        for (int j = 0; j < 8; ++j) { const float v_ = vc[j] + (vp[j] - vc[j]) * mv[j]; o[j] = (y[j] * rstd * lnw[j] + lnb[j] + beta * v_) * g8[j]; }
        *(u32x4*)(XB + (size_t)m * D + 512 + c0) = pack8(o);
    }
}
#define TAIL_HALF(HALF_, GS_, CI_, BAR1_, BAR2_, BAR3_) do { \
        p6_half(URW, Ab, Gb, Y, XB, args.in[I_SHIFT], args.in[I_KA], args.in[I_RK], args.in[I_LNW], args.in[I_LNB], (HALF_), (CI_) * NWAVES + wave, (GS_) * NWAVES, lane); \
        BAR1_; \
        { pg8::Gemm g{XB, WOUT, M / 2, D, D}; HalfOrder S; S.init(D, (GS_), (CI_), (HALF_), 1); EpiRes E{out, out, XB2, ssq2, 1.0f, (HALF_), 1}; \
          pg8::gemm_phase<EpiRes, HalfOrder, PG8_ALIGN, PG8_SP2>(lds, g, S, E); } \
        BAR2_; \
        { pg8::Gemm g{XB2, W2A, M / 2, 2 * FF, D}; HalfOrder S; S.init(2 * FF, (GS_), (CI_), (HALF_), 0); EpiSwiglu E{TC, ssq2, (HALF_), 1}; \
          pg8::gemm_phase<EpiSwiglu, HalfOrder, PG8_ALIGN, PG8_SP2>(lds, g, S, E); } \
        BAR3_; \
        { pg8::Gemm g{TC, W2D, M / 2, D, FF}; HalfOrder S; S.init(D, (GS_), (CI_), (HALF_), 0); EpiRes E{out, out, nullptr, nullptr, 0.5f, (HALF_), 2}; \
          pg8::gemm_phase<EpiRes, HalfOrder, PG8_ALIGN, PG8_SP2>(lds, g, S, E); } \
    } while (0)
__device__ __forceinline__ void sub_barrier(unsigned* ctr, unsigned target) {
    asm volatile("s_waitcnt vmcnt(0)" ::: "memory");
    __syncthreads();
    if (threadIdx.x == 0) {
        __builtin_amdgcn_fence(__ATOMIC_RELEASE, "agent"); asm volatile("s_waitcnt vmcnt(0)" ::: "memory");
        __hip_atomic_fetch_add(ctr, 1u, __ATOMIC_RELAXED, __HIP_MEMORY_SCOPE_AGENT);
        unsigned sp = 0;
        while (__hip_atomic_load(ctr, __ATOMIC_RELAXED, __HIP_MEMORY_SCOPE_AGENT) < target) { __builtin_amdgcn_s_sleep(2); if (++sp > (1u << 22)) break; }
        __builtin_amdgcn_fence(__ATOMIC_ACQUIRE, "agent"); asm volatile("s_waitcnt vmcnt(0)" ::: "memory");
    }
    __syncthreads();
}
__device__ __forceinline__ void wait_flag(unsigned* ctr, unsigned target) {
    if (threadIdx.x == 0) {
        unsigned sp = 0;
        while (__hip_atomic_load(ctr, __ATOMIC_RELAXED, __HIP_MEMORY_SCOPE_AGENT) < target) { __builtin_amdgcn_s_sleep(4); if (++sp > (1u << 22)) break; }
        __builtin_amdgcn_fence(__ATOMIC_ACQUIRE, "agent"); asm volatile("s_waitcnt vmcnt(0)" ::: "memory");
    }
    __syncthreads();
}
constexpr int LDS_BYTES = 147456;
constexpr int ATT_KB = 64 * 272, ATT_VB = 128 * 136, ATT_BUF = ATT_KB + ATT_VB;
constexpr int LDS_MISC = 143360;
constexpr int SCAN_STEP_F = 384, SCAN_CH = 32;

__global__ void __launch_bounds__(NTHR, 2) fwd_kernel(Args args) {
    extern __shared__ __attribute__((aligned(16))) unsigned char lds_raw[];
    LAS unsigned char* lds = (LAS unsigned char*)lds_raw;
    const int tid = threadIdx.x, lane = tid & 63, wave = __builtin_amdgcn_readfirstlane(tid >> 6);
    const int G = gridDim.x, bx = blockIdx.x;
    const int gw = bx * NWAVES + wave, NGW = G * NWAVES;
    unsigned char* ws = args.ws;
    bf16* XB = (bf16*)(ws + WS_XB); bf16* TB = (bf16*)(ws + WS_T); bf16* URW = (bf16*)(ws + WS_URW); bf16* UDA = (bf16*)(ws + WS_UDA); bf16* Y = (bf16*)(ws + WS_Y); bf16* TC = (bf16*)(ws + WS_TC);
    bf16* Qb = (bf16*)(ws + WS_Q); bf16* Kb = (bf16*)(ws + WS_K); bf16* Vt = (bf16*)(ws + WS_VT);
    bf16* W1A = (bf16*)(ws + WS_W1A); bf16* W1D = (bf16*)(ws + WS_W1D); bf16* WIN = (bf16*)(ws + WS_WIN); bf16* XB2 = (bf16*)(ws + WS_XB2);
    bf16* W2A = (bf16*)(ws + WS_W2A); bf16* W2D = (bf16*)(ws + WS_W2D);
    bf16* Eb = (bf16*)(ws + WS_E); bf16* Ab = (bf16*)(ws + WS_A); bf16* Gb = (bf16*)(ws + WS_G);
    bf16* WOUT = (bf16*)(ws + WS_WOUT);
    bf16* W2T = (bf16*)(ws + WS_LORA); bf16* A2T = W2T + 512 * 64; bf16* G2T = A2T + 512 * 64;
    unsigned char* sm = ws + WS_SMALL;
    float* ssq0 = (float*)(sm + SM_SSQ0); float* ssq1 = (float*)(sm + SM_SSQ1); float* ssq2 = (float*)(sm + SM_SSQ2); float* INV = (float*)(sm + SM_BETA);
    bf16* XBM = (bf16*)(sm + SM_XBM); bf16* XBM2 = (bf16*)(sm + SM_XBM2); bf16* TM = (bf16*)(sm + SM_TM);
    float* ssqm0 = (float*)(sm + SM_SSQM0); float* ssqm1 = (float*)(sm + SM_SSQM1); float* misc = (float*)(sm + SM_MISC); unsigned* qctr = (unsigned*)(misc + 16);
    const float* x = args.in[I_X];
    float* out = args.out;
    if (tid < 4) ((LAS unsigned*)(lds + LDS_MISC + 64))[tid] = 0u;
    __syncthreads();
    const XcdBarrier xbar = xcd_barrier_post((unsigned*)(sm + SM_BAR), (volatile LAS unsigned*)(lds + LDS_MISC + 64));
    if (bx >= 64 && tid == 0) (void)xb_add(&((unsigned*)(sm + SM_BAR) + 4096)[XB_XCNT(xbar.x)], 1u);

    {
        LAS float* scr = (LAS float*)(lds + wave * 16640);
        constexpr int IT_G = (D / 64) * (FF / 64);
        for (int it = gw; it < 2 * IT_G; it += NGW) {
            if (it < IT_G) transpose_item(args.in[I_F1G], D, FF, W1A, args.in[I_F1N], 1, scr, it, lane);
            else transpose_item(args.in[I_F1U], D, FF, W1A, args.in[I_F1N], 2, scr, it - IT_G, lane);
        }
        for (int m = gw; m < M; m += NGW) row_to_bf16(x + (size_t)m * D, XB + (size_t)m * D, ssq0 + m, lane);
        if (gw < NMETA) row_to_bf16(args.in[I_META] + (size_t)gw * D, XBM + (size_t)gw * D, ssqm0 + gw, lane);
        const int gt = bx * NTHR + tid, NGT = G * NTHR;
        for (int i = gt; i < M; i += NGT) { ssq1[i] = 0.f; ssq2[i] = 0.f; }
        if (gt < 16) ssqm1[gt] = 0.f;
        if (gt == 0) { qctr[0] = 0u; qctr[1] = 0u; }
        for (int i = gt; i < 512 * 64; i += NGT) { const int n = i >> 6, k = i & 63; W2T[i] = (bf16)f2bf(args.in[I_W2][k * 512 + n]); A2T[i] = (bf16)f2bf(args.in[I_A2][k * 512 + n]); }
        for (int i = gt; i < 512 * 160; i += NGT) { const int n = i / 160, k = i % 160; G2T[i] = (bf16)f2bf(args.in[I_G2][k * 512 + n]); }
        if (gw == 0) {
            const float s1 = wave_sum(args.in[I_LQ1][lane] * args.in[I_LK1][lane]), s2 = wave_sum(args.in[I_LQ2][lane] * args.in[I_LK2][lane]);
            if (lane == 0) misc[0] = expf(s1) - expf(s2) + 0.2f;
        }
    }
    xcd_barrier(xbar);

    {
        const int mw1 = (G == 256) ? (bx >= 128 ? (bx - 128) * NWAVES + wave : (1 << 30)) : gw, ms1 = (G == 256) ? 128 * NWAVES : NGW;
        for (int hc = mw1; hc < FF / 16; hc += ms1) {
            const int grow = (hc >> 3) * 256 + (hc & 7) * 16;
            const f32x4 ag = mm16(XBM, D, W1A + (size_t)grow * D, D, D, lane), au = mm16(XBM, D, W1A + (size_t)(grow + 128) * D, D, D, lane);
#pragma unroll
            for (int e = 0; e < 4; ++e) { const int row = 4 * (lane >> 4) + e; const float rs = rsqrtf(ssqm0[row] * (1.0f / D) + NORM_EPS); const float g = ag[e] * rs, up = au[e] * rs;
                TM[row * FF + hc * 16 + (lane & 15)] = (bf16)f2bf(g * sigmoidf_(g) * up); }
        }
        pg8::Gemm g{XB, W1A, M, 2 * FF, D}; pg8::StaticOrder S; S.init(M, 2 * FF, G, bx);
        EpiSwiglu E{TB, ssq0, 0, 0};
        pg8::gemm_phase<EpiSwiglu, pg8::StaticOrder, PG8_ALIGN, PG8_SP2>(lds, g, S, E);
        if (G == 256 ? bx >= 128 : true) {
            LAS float* scr = (LAS float*)(lds + wave * 16640);
            constexpr int IT_D = (FF / 64) * (D / 64), IT_IN = (D / 64) * ((NIN + 63) / 64), IT_O = (D / 64) * (D / 64), NIT = IT_D + IT_IN + IT_O;
            const int nb = (G == 256) ? 128 : G, b0 = (G == 256) ? 128 : 0;
            for (int it = (bx - b0) * NWAVES + wave; it < NIT; it += nb * NWAVES) {
                int r = it;
                if (r < IT_D) { transpose_item(args.in[I_F1D], FF, D, W1D, nullptr, 0, scr, r, lane); continue; } r -= IT_D;
                if (r < IT_IN) { transpose_item(args.in[I_WIN], D, NIN, WIN, args.in[I_MIXN], 0, scr, r, lane); continue; } r -= IT_IN;
                transpose_item(args.in[I_WOUT], D, D, WOUT, nullptr, 0, scr, r, lane);
            }
        }
    }
    xcd_barrier(xbar);

    {
        for (int cb = bx; cb < D / 16; cb += G) {
            f32x4 a = mm16(TM + 352 * wave, FF, W1D + (size_t)cb * 16 * FF + 352 * wave, FF, 352, lane);
            LAS f32x4* red = (LAS f32x4*)lds;
            red[wave * 64 + lane] = a;
            __syncthreads();
            if (wave == 0) {
#pragma unroll
                for (int w8 = 1; w8 < 8; ++w8) a += red[w8 * 64 + lane];
#pragma unroll
                for (int e = 0; e < 4; ++e) { const int row = 4 * (lane >> 4) + e, col = cb * 16 + (lane & 15); const float h = args.in[I_META][row * D + col] + 0.5f * a[e];
                    XBM2[row * D + col] = (bf16)f2bf(h); float s = h * h; s += __shfl_xor(s, 1); s += __shfl_xor(s, 2); s += __shfl_xor(s, 4); s += __shfl_xor(s, 8);
                    if ((lane & 15) == 0) atomicAdd(ssqm1 + row, s); }
            }
            __syncthreads();
        }
        pg8::Gemm g{TB, W1D, M, D, FF}; pg8::StaticOrder S; S.init(M, D, G, bx);
        EpiRes E{x, out, XB, ssq1, 0.5f, 0, 0};
        pg8::gemm_phase<EpiRes, pg8::StaticOrder, PG8_ALIGN, PG8_SP2>(lds, g, S, E);
    }
    xcd_barrier(xbar);

    {
        const int mw3 = (G == 256) ? (bx >= 128 ? (bx - 128) * NWAVES + wave : (1 << 30)) : gw, ms3 = (G == 256) ? 128 * NWAVES : NGW;
        for (int cb = mw3; cb < NIN / 16; cb += ms3) {
            const f32x4 a = mm16(XBM2, D, WIN + (size_t)cb * 16 * D, D, D, lane);
#pragma unroll
            for (int e = 0; e < 4; ++e) { const int row = 4 * (lane >> 4) + e, col = cb * 16 + (lane & 15); const float rs = rsqrtf(ssqm1[row] * (1.0f / D) + NORM_EPS);
                const bf16 v = (bf16)f2bf(a[e] * rs);
#pragma unroll
                for (int b = 0; b < BATCH; ++b) { const int pr = b * LP + row; if (col < DAW) UDA[(size_t)pr * DAW + col] = v; else URW[(size_t)pr * RWW + col - DAW] = v; } }
        }
        pg8::Gemm g{XB, WIN, M, NINP, D}; pg8::StaticOrder S; S.init(M, NINP, G, bx);
        EpiU E{UDA, URW, ssq1};
        pg8::gemm_phase<EpiU, pg8::StaticOrder, PG8_ALIGN, PG8_SP2>(lds, g, S, E);
    }
    xcd_barrier(xbar);

    {
        {
            const int e8 = lane & 7, d0 = e8 * 8, grp = lane >> 3, hh = grp >> 1, cc = grp & 1;
            float qn[8], kn[8];
#pragma unroll
            for (int j = 0; j < 8; ++j) { qn[j] = args.in[I_QN][d0 + j]; kn[j] = args.in[I_KN][d0 + j]; }
            float kmix[8], kkc8[8];
#pragma unroll
            for (int j = 0; j < 8; ++j) { kmix[j] = args.in[I_SHIFT][512 + 8 * lane + j]; kkc8[j] = args.in[I_KK][8 * lane + j]; }
            const double invf[8] = {1.0, 0.19392274474868576, 0.03760603093086393, 0.007292664737217109, 0.001414213562373095, 0.0002742481756762073, 5.318295896944988e-05, 1.031338537721246e-05};
            for (int pr = gw; pr < PR; pr += NGW) {
                const int b = pr / LP, p = pr - b * LP;
                const bf16* urow = UDA + (size_t)pr * DAW;
                float q[8], k[8];
                unpack8(*(const u32x4*)(urow + 8 * lane), q); unpack8(*(const u32x4*)(urow + 512 + 8 * lane), k);
                float sq = 0.f, sk = 0.f;
#pragma unroll
                for (int j = 0; j < 8; ++j) { sq += q[j] * q[j]; sk += k[j] * k[j]; }
                sq += __shfl_xor(sq, 1); sq += __shfl_xor(sq, 2); sq += __shfl_xor(sq, 4);
                sk += __shfl_xor(sk, 1); sk += __shfl_xor(sk, 2); sk += __shfl_xor(sk, 4);
                const float rq = rsqrtf(sq * (1.0f / 64) + NORM_EPS), rk = rsqrtf(sk * (1.0f / 64) + NORM_EPS);
#pragma unroll
                for (int j = 0; j < 8; ++j) { q[j] *= rq * qn[j]; k[j] *= rk * kn[j]; }
#pragma unroll
                for (int j = 0; j < 8; ++j) {
                    const float qo = __shfl_xor(q[j], 1), ko = __shfl_xor(k[j], 1);
                    if (e8 < 2) {
                        double rev = (double)p * invf[j] * 0.15915494309189535; rev -= floor(rev);
                        const float rf = (float)rev, cs = __builtin_amdgcn_cosf(rf), sn = __builtin_amdgcn_sinf(rf);
                        if (e8 == 0) { q[j] = q[j] * cs - qo * sn; k[j] = k[j] * cs - ko * sn; }
                        else         { q[j] = q[j] * cs + qo * sn; k[j] = k[j] * cs + ko * sn; }
                    }
                }
#pragma unroll
                for (int j = 0; j < 8; ++j) q[j] *= 0.18033688011112042f;
                const size_t o = ((size_t)(b * 4 + hh) * VP + p) * 128 + cc * 64 + d0;
                *(u32x4*)(Qb + o) = pack8(q); *(u32x4*)(Kb + o) = pack8(k);
                {
                    const bf16* rrow = URW + (size_t)pr * RWW + 512 + 8 * lane;
                    float kc[8], kp8[8];
                    unpack8(*(const u32x4*)rrow, kc);
                    if (p > 0) unpack8(*(const u32x4*)(rrow - RWW), kp8); else {
#pragma unroll
                        for (int j = 0; j < 8; ++j) kp8[j] = 0.f; }
                    float ss = 0.f;
#pragma unroll
                    for (int j = 0; j < 8; ++j) { const float kv = (kc[j] + (kp8[j] - kc[j]) * kmix[j]) * kkc8[j]; ss += kv * kv; }
                    ss += __shfl_xor(ss, 1); ss += __shfl_xor(ss, 2); ss += __shfl_xor(ss, 4);
                    if (e8 == 0) INV[(size_t)pr * 8 + grp] = 1.0f / fmaxf(sqrtf(ss), 1e-12f);
                }
            }
        }
        {
            LAS unsigned short* tile = (LAS unsigned short*)lds;
            for (int it = bx; it < BATCH * (VP / 64); it += G) {
                const int b = it / (VP / 64), p0 = (it % (VP / 64)) * 64;
#pragma unroll
                for (int i = 0; i < 8; ++i) {
                    const int id = tid + NTHR * i, row = id >> 6, c16 = id & 63;
                    u32x4 v = {0u, 0u, 0u, 0u};
                    if (p0 + row < LP) v = *(const u32x4*)(UDA + (size_t)(b * LP + p0 + row) * DAW + 1024 + c16 * 8);
                    *(LAS u32x4*)(tile + row * 520 + c16 * 8) = v;
                }
                __syncthreads();
                {
                    unsigned w[32];
#pragma unroll
                    for (int pp = 0; pp < 32; ++pp) w[pp] = (unsigned)tile[(2 * pp) * 520 + tid] | ((unsigned)tile[(2 * pp + 1) * 520 + tid] << 16);
                    u32x4* dst = (u32x4*)(Vt + ((size_t)(b * 4 + (tid >> 7)) * 128 + (tid & 127)) * VP + p0);
#pragma unroll
                    for (int i = 0; i < 8; ++i) { u32x4 o; o.x = w[4 * i]; o.y = w[4 * i + 1]; o.z = w[4 * i + 2]; o.w = w[4 * i + 3]; dst[i] = o; }
                }
                __syncthreads();
            }
        }
        {
            const int r16 = lane & 15, q4 = lane >> 4;
            const float* mixp = args.in[I_SHIFT];
            for (int it2 = wave * G + bx; it2 < 2 * (PR / 16); it2 += NGW) {
                const int rg = it2 >> 1, cb0 = (it2 & 1) * 16;
                const int pr = rg * 16 + r16, p = pr % LP;
                const bf16* cur = URW + (size_t)pr * RWW; const bf16* prv = cur - RWW;
                bf16x8 Aw[2], Aa[2], Ag[5];
#pragma unroll
                for (int s = 0; s < 9; ++s) {
                    const int col = (s < 2) ? (1536 + 32 * s + 8 * q4) : (s < 4) ? (1600 + 32 * (s - 2) + 8 * q4) : (1664 + 32 * (s - 4) + 8 * q4);
                    float c8[8], p8[8];
                    unpack8(*(const u32x4*)(cur + col), c8);
                    if (p > 0) unpack8(*(const u32x4*)(prv + col), p8); else {
#pragma unroll
                        for (int j = 0; j < 8; ++j) p8[j] = 0.f; }
#pragma unroll
                    for (int j = 0; j < 8; ++j) { float v = c8[j] + (p8[j] - c8[j]) * mixp[col + j];
                        if (s < 2) v = tanhf(v); else if (s >= 4) v = sigmoidf_(v);
                        c8[j] = v; }
                    const u32x4 w = pack8(c8); const bf16x8 f = __builtin_bit_cast(bf16x8, w);
                    if (s < 2) Aw[s] = f; else if (s < 4) Aa[s - 2] = f; else Ag[s - 4] = f;
                }
                for (int cb = cb0; cb < cb0 + 16; ++cb) {
                    const int n = cb * 16 + r16;
                    f32x4 aw = {0.f, 0.f, 0.f, 0.f}, aa = aw, ag = aw;
#pragma unroll
                    for (int s = 0; s < 2; ++s) { aw = mfma16(Aw[s], *(const bf16x8*)(W2T + n * 64 + 32 * s + 8 * q4), aw); aa = mfma16(Aa[s], *(const bf16x8*)(A2T + n * 64 + 32 * s + 8 * q4), aa); }
#pragma unroll
                    for (int s = 0; s < 5; ++s) ag = mfma16(Ag[s], *(const bf16x8*)(G2T + n * 160 + 32 * s + 8 * q4), ag);
                    const float w0 = args.in[I_W0][n], a0 = args.in[I_A0][n];
#pragma unroll
                    for (int e = 0; e < 4; ++e) {
                        const size_t o = (size_t)(rg * 16 + 4 * q4 + e) * 512 + n;
                        Eb[o] = (bf16)f2bf(0.6065306597126334f * sigmoidf_(w0 + aw[e]));
                        Ab[o] = (bf16)f2bf(sigmoidf_(a0 + aa[e]));
                        Gb[o] = (bf16)f2bf(ag[e]);
                    }
                }
            }
        }
    }
    xcd_barrier(xbar);

    {
        if (bx < 64) {
            const int chain = bx >> 2, quarter = bx & 3, b = chain >> 3, h = chain & 7;
            constexpr int SC2 = 16, OPF = 320, NC2 = LP / SC2;
            static_assert(NC2 * SC2 == LP && (NC2 & 1) == 1, "chunking");
            LAS float* OP = (LAS float*)lds;
            LAS unsigned short* RB = (LAS unsigned short*)(lds + 40960);
            LAS unsigned char* SP = lds + 45056;
            if (wave >= 4) {
                const int lw = wave - 4, col = h * 64 + lane;
                const float* mixp = args.in[I_SHIFT];
                const float mix_r = mixp[col], mix_k = mixp[512 + col], mix_v = mixp[1024 + col];
                const float kkc = args.in[I_KK][col], kac = args.in[I_KA][col];
                struct LSet { unsigned short ur[5], uk[5], uv[5], ue[4], ua[4]; float iv[4]; };
                LSet s0, s1;
                const bf16* ubase = URW + (size_t)b * LP * RWW + col; const bf16* ebase = Eb + (size_t)b * LP * 512 + col; const bf16* abase = Ab + (size_t)b * LP * 512 + col; const float* ibase = INV + (size_t)b * LP * 8 + h;
                bf16* ybase = Y + (size_t)b * T * 512 + h * 64 + 16 * quarter + 4 * (lane >> 4);
                unsigned* halfflag = (unsigned*)(sm + SM_BAR) + SUBW + 64 * 7;
#define SCAN_LOAD(S_, c_) do { const int pb_ = (c_) * SC2 + 4 * lw; _Pragma("unroll") for (int i_ = 0; i_ < 5; ++i_) { const int p_ = pb_ + i_ - 1; const int pc_ = p_ < 0 ? 0 : p_; \
        const bf16* u_ = ubase + (size_t)pc_ * RWW; S_.ur[i_] = u_[0]; S_.uk[i_] = u_[512]; S_.uv[i_] = u_[1024]; \
        if (i_ > 0) { S_.ue[i_ - 1] = ebase[(size_t)pc_ * 512]; S_.ua[i_ - 1] = abase[(size_t)pc_ * 512]; S_.iv[i_ - 1] = ibase[(size_t)pc_ * 8]; } } } while (0)
#define SCAN_PROC(S_, c_) do { const int pb_ = (c_) * SC2 + 4 * lw; LAS float* dst_ = OP + ((c_) & 1) * (SC2 * OPF) + (4 * lw) * OPF + lane; LAS unsigned short* rb_ = RB + ((c_) & 1) * (SC2 * 64) + (4 * lw) * 64 + lane; \
        _Pragma("unroll") for (int i_ = 0; i_ < 4; ++i_) { \
        const float rc_ = bf2f(S_.ur[i_ + 1]), kc_ = bf2f(S_.uk[i_ + 1]), vc_ = bf2f(S_.uv[i_ + 1]); const bool first_ = (pb_ + i_) == 0; \
        const float rp_ = first_ ? 0.f : bf2f(S_.ur[i_]), kp0_ = first_ ? 0.f : bf2f(S_.uk[i_]), vp_ = first_ ? 0.f : bf2f(S_.uv[i_]); \
        const float r_ = rc_ + (rp_ - rc_) * mix_r, k_ = kc_ + (kp0_ - kc_) * mix_k, v_ = vc_ + (vp_ - vc_) * mix_v, e_ = bf2f(S_.ue[i_]), a_ = bf2f(S_.ua[i_]); \
        const float kk_ = k_ * kkc * S_.iv[i_], kp_ = k_ * (1.0f + (a_ - 1.0f) * kac); \
        dst_[i_ * OPF + 0] = __expf(-e_); dst_[i_ * OPF + 64] = -kk_; dst_[i_ * OPF + 128] = kk_ * a_; dst_[i_ * OPF + 192] = kp_; dst_[i_ * OPF + 256] = v_; \
        rb_[i_ * 64] = (unsigned short)f2bf(r_); } } while (0)
#define SCAN_YPASS(c_) do { _Pragma("unroll") for (int i_ = 0; i_ < 4; ++i_) { const int st_ = 4 * lw + i_, p_ = (c_) * SC2 + st_; \
        const LAS unsigned char* sp_ = SP + ((c_) & 1) * 36864 + (st_ * 16 + (lane & 15)) * 144 + 16 * (lane >> 4); const LAS unsigned short* rb_ = RB + ((c_) & 1) * (SC2 * 64) + st_ * 64 + 8 * (lane >> 4); \
        f32x4 acc_ = {0.f, 0.f, 0.f, 0.f}; \
        acc_ = mfma16(*(const LAS bf16x8*)sp_, *(const LAS bf16x8*)rb_, acc_); acc_ = mfma16(*(const LAS bf16x8*)(sp_ + 64), *(const LAS bf16x8*)(rb_ + 32), acc_); \
        if ((lane & 15) == 0 && p_ >= NMETA) *(u32x2*)(ybase + (size_t)(p_ - NMETA) * 512) = (u32x2){pk2(acc_.x, acc_.y), pk2(acc_.z, acc_.w)}; } } while (0)
                SCAN_LOAD(s0, 0); SCAN_LOAD(s1, 1); SCAN_PROC(s0, 0); SCAN_LOAD(s0, 2);
                __syncthreads();
                for (int c = 0; c < NC2; c += 2) {
                    if (c == 258 && wave == 4 && lane == 0) {
                        __builtin_amdgcn_fence(__ATOMIC_RELEASE, "agent"); asm volatile("s_waitcnt vmcnt(0)" ::: "memory");
                        __hip_atomic_fetch_add(halfflag, 1u, __ATOMIC_RELAXED, __HIP_MEMORY_SCOPE_AGENT);
                    }
                    if (c >= 1) SCAN_YPASS(c - 1);
                    if (c + 1 < NC2) { SCAN_PROC(s1, c + 1); if (c + 3 < NC2) SCAN_LOAD(s1, c + 3); }
                    __syncthreads();
                    if (c + 1 < NC2) {
                        SCAN_YPASS(c);
                        if (c == 256) asm volatile("s_waitcnt vmcnt(0)" ::: "memory");
                        if (c + 2 < NC2) { SCAN_PROC(s0, c + 2); if (c + 4 < NC2) SCAN_LOAD(s0, c + 4); }
                        __syncthreads();
                    }
                }
                SCAN_YPASS(NC2 - 1);
#undef SCAN_LOAD
#undef SCAN_PROC
#undef SCAN_YPASS
            } else {
                const int rr = lane >> 4, kq = lane & 15, vrow = 16 * quarter + 4 * wave + rr;
                f32x4 S = {0.f, 0.f, 0.f, 0.f};
                __builtin_amdgcn_s_setprio(3);
                __syncthreads();
                for (int c = 0; c < NC2; ++c) {
                    const LAS float* cb = OP + (c & 1) * (SC2 * OPF);
                    LAS unsigned char* spw = SP + (c & 1) * 36864 + (4 * wave + rr) * 144 + 8 * kq;
                    f32x4 w = ((const LAS f32x4*)cb)[kq], an = ((const LAS f32x4*)(cb + 64))[kq], bv = ((const LAS f32x4*)(cb + 128))[kq], kp = ((const LAS f32x4*)(cb + 192))[kq];
                    float vv = cb[256 + vrow];
#define SB_ __builtin_amdgcn_sched_barrier(0)
#pragma unroll
                    for (int st = 0; st < SC2; ++st) {
                        const bool more = st + 1 < SC2;
                        const LAS float* sp = cb + (more ? st + 1 : st) * OPF;
                        f32x4 nw = w, nan_ = an, nbv = bv, nkp = kp; float nvv = vv;
                        f32x2 t = S.zw * an.zw; SB_;
                        t = S.xy * an.xy + t; SB_;
                        f32x2 u01 = kp.xy * vv; SB_;
                        float x = t.x + t.y; SB_;
                        f32x2 u23 = kp.zw * vv; SB_;
                        u01 = S.xy * w.xy + u01; SB_;
                        x += dpp_f(x, 0); SB_;
                        u23 = S.zw * w.zw + u23; SB_;
                        if (more) nw = ((const LAS f32x4*)sp)[kq]; SB_;
                        x += dpp_f(x, 1); SB_;
                        if (more) nan_ = ((const LAS f32x4*)(sp + 64))[kq]; SB_;
                        if (more) nbv = ((const LAS f32x4*)(sp + 128))[kq]; SB_;
                        x += dpp_f(x, 2); SB_;
                        if (more) nkp = ((const LAS f32x4*)(sp + 192))[kq]; SB_;
                        if (more) nvv = sp[256 + vrow]; SB_;
                        x += dpp_f(x, 3); SB_;
                        S.xy = bv.xy * x + u01; SB_;
                        S.zw = bv.zw * x + u23; SB_;
                        *(LAS u32x2*)(spw + st * 2304) = (u32x2){pk2(S.x, S.y), pk2(S.z, S.w)}; SB_;
                        w = nw; an = nan_; bv = nbv; kp = nkp; vv = nvv;
                    }
#undef SB_
                    __syncthreads();
                }
                __builtin_amdgcn_s_setprio(0);
            }
            __syncthreads();
        }
        if (bx >= 64) {
            const float lam = misc[0];
            LAS unsigned* shu = (LAS unsigned*)(lds + LDS_MISC);
            const int c = wave >> 2, qg = wave & 3, r32 = lane & 31, hh = lane >> 5;
            for (;;) {
                if (tid == 0) shu[0] = atomicAdd(qctr, 1u);
                __syncthreads();
                const unsigned un = shu[0];
                if (un >= 512u) break;
                const int qi = (un < 256u) ? 31 - (int)(un >> 3) : 63 - (int)((un - 256u) >> 3), bh = (int)(un & 7u), b = bh >> 2, h = bh & 3;
                const int qbase = NMETA + 128 * qi + 32 * qg, qpos = qbase + r32;
                const bf16* qrow = Qb + ((size_t)bh * VP + qpos) * 128 + c * 64 + 8 * hh;
                bf16x8 qf[4];
#pragma unroll
                for (int s = 0; s < 4; ++s) qf[s] = *(const bf16x8*)(qrow + 16 * s);
                f32x16 o[4];
#pragma unroll
                for (int d = 0; d < 4; ++d)
#pragma unroll
                    for (int e = 0; e < 16; ++e) o[d][e] = 0.f;
                float mrun = -1e30f, lsum = 0.f;
                const int ntiles = 2 * qi + 3;
                const bf16* ksrc[2]; const bf16* vsrc[2]; int kdst[2], vdst[2];
#pragma unroll
                for (int ii = 0; ii < 2; ++ii) { const int id = tid + NTHR * ii;
                    ksrc[ii] = Kb + ((size_t)bh * VP + (id >> 4)) * 128 + (id & 15) * 8; kdst[ii] = (id >> 4) * 272 + (id & 15) * 16;
                    vsrc[ii] = Vt + ((size_t)bh * 128 + (id >> 3)) * VP + (id & 7) * 8; vdst[ii] = ATT_KB + (id >> 3) * 136 + (id & 7) * 16; }
                u32x4 kr[2], vr[2];
#define ATT_LOAD(j_) do { _Pragma("unroll") for (int ii = 0; ii < 2; ++ii) { kr[ii] = *(const u32x4*)(ksrc[ii] + (size_t)(j_) * 64 * 128); vr[ii] = *(const u32x4*)(vsrc[ii] + (j_) * 64); } } while (0)
#define ATT_WRITE(j_) do { LAS unsigned char* bb_ = lds + ((j_) & 1) * ATT_BUF; _Pragma("unroll") for (int ii = 0; ii < 2; ++ii) { *(LAS u32x4*)(bb_ + kdst[ii]) = kr[ii]; \
        *(LAS u32x2*)(bb_ + vdst[ii]) = (u32x2){vr[ii].x, vr[ii].y}; *(LAS u32x2*)(bb_ + vdst[ii] + 8) = (u32x2){vr[ii].z, vr[ii].w}; } } while (0)
                ATT_LOAD(0); ATT_WRITE(0);
                __syncthreads();
                for (int j = 0; j < ntiles; ++j) {
                    if (j + 1 < ntiles) ATT_LOAD(j + 1);
                    if (64 * j <= qbase + 31) {
                        const LAS unsigned char* kb_ = lds + (j & 1) * ATT_BUF + r32 * 272 + c * 128 + hh * 16;
                        const LAS unsigned char* vb_ = lds + (j & 1) * ATT_BUF + ATT_KB + r32 * 136 + hh * 8;
                        f32x16 s0, s1;
#pragma unroll
                        for (int e = 0; e < 16; ++e) { s0[e] = 0.f; s1[e] = 0.f; }
#pragma unroll
                        for (int s = 0; s < 4; ++s) { s0 = mfma32(*(const LAS bf16x8*)(kb_ + s * 32), qf[s], s0); s1 = mfma32(*(const LAS bf16x8*)(kb_ + 32 * 272 + s * 32), qf[s], s1); }
                        if (64 * j + 63 > qbase) {
#pragma unroll
                            for (int e = 0; e < 16; ++e) { const int key = 64 * j + (e & 3) + 8 * (e >> 2) + 4 * hh; if (key > qpos) s0[e] = -1e30f; if (key + 32 > qpos) s1[e] = -1e30f; }
                        }
                        float tm = fmaxf(s0[0], s1[0]);
#pragma unroll
                        for (int e = 1; e < 16; ++e) tm = fmaxf(tm, fmaxf(s0[e], s1[e]));
                        tm = fmaxf(tm, __shfl_xor(tm, 32));
                        const float mnew = fmaxf(mrun, tm), alpha = __builtin_amdgcn_exp2f(mrun - mnew); mrun = mnew;
                        float rsum = 0.f;
#pragma unroll
                        for (int e = 0; e < 16; ++e) { s0[e] = __builtin_amdgcn_exp2f(s0[e] - mnew); s1[e] = __builtin_amdgcn_exp2f(s1[e] - mnew); rsum += s0[e] + s1[e]; }
                        lsum = lsum * alpha + rsum;
                        if (__builtin_amdgcn_ballot_w64(alpha != 1.0f) != 0ull) {
#pragma unroll
                            for (int d = 0; d < 4; ++d) o[d] = o[d] * alpha;
                        }
                        bf16x8 pf[4];
#pragma unroll
                        for (int s = 0; s < 4; ++s) { u32x4 w;
                            if (s < 2) { w.x = pk2(s0[8 * s], s0[8 * s + 1]); w.y = pk2(s0[8 * s + 2], s0[8 * s + 3]); w.z = pk2(s0[8 * s + 4], s0[8 * s + 5]); w.w = pk2(s0[8 * s + 6], s0[8 * s + 7]); }
                            else { const int t = s - 2; w.x = pk2(s1[8 * t], s1[8 * t + 1]); w.y = pk2(s1[8 * t + 2], s1[8 * t + 3]); w.z = pk2(s1[8 * t + 4], s1[8 * t + 5]); w.w = pk2(s1[8 * t + 6], s1[8 * t + 7]); }
                            pf[s] = __builtin_bit_cast(bf16x8, w); }
#pragma unroll
                        for (int d = 0; d < 4; ++d)
#pragma unroll
                            for (int s = 0; s < 4; ++s) {
                                const u32x2 lo = *(const LAS u32x2*)(vb_ + d * 32 * 136 + s * 32), hi = *(const LAS u32x2*)(vb_ + d * 32 * 136 + s * 32 + 16);
                                const u32x4 vv = {lo.x, lo.y, hi.x, hi.y};
                                o[d] = mfma32(__builtin_bit_cast(bf16x8, vv), pf[s], o[d]);
                            }
                    }
                    if (j + 1 < ntiles) ATT_WRITE(j + 1);
                    __syncthreads();
                }
#undef ATT_LOAD
#undef ATT_WRITE
                lsum += __shfl_xor(lsum, 32);
                const float inv = 1.0f / lsum;
                LAS float* X = (LAS float*)lds;
                if (c == 1) {
#pragma unroll
                    for (int d = 0; d < 4; ++d)
#pragma unroll
                        for (int e = 0; e < 16; ++e) X[((qg * 4 + d) * 16 + e) * 64 + lane] = o[d][e] * inv;
                }
                __syncthreads();
                if (c == 0) {
                    float sq = 0.f;
#pragma unroll
                    for (int d = 0; d < 4; ++d)
#pragma unroll
                        for (int e = 0; e < 16; ++e) { const float v = o[d][e] * inv - lam * X[((qg * 4 + d) * 16 + e) * 64 + lane]; o[d][e] = v; sq += v * v; }
                    sq += __shfl_xor(sq, 32);
                    const float rn = rsqrtf(sq * (1.0f / 128) + NORM_EPS) * 0.8f;
                    bf16* orow = XB + (size_t)(b * T + 128 * qi + 32 * qg + r32) * D + h * 128;
#pragma unroll
                    for (int d = 0; d < 4; ++d)
#pragma unroll
                        for (int g4 = 0; g4 < 4; ++g4) {
                            const int dv0 = 32 * d + 8 * g4 + 4 * hh;
                            const f32x4 sl = *(const f32x4*)(args.in[I_SUBLN] + dv0);
                            u32x2 w; w.x = pk2(o[d][4 * g4] * rn * sl.x, o[d][4 * g4 + 1] * rn * sl.y); w.y = pk2(o[d][4 * g4 + 2] * rn * sl.z, o[d][4 * g4 + 3] * rn * sl.w);
                            *(u32x2*)(orow + dv0) = w;
                        }
                }
                __syncthreads();
            }
        }
        if (bx >= 64) {
            LAS float* scr = (LAS float*)(lds + wave * 16640);
            constexpr int IT_G = (D / 64) * (FF / 64), IT_D = (FF / 64) * (D / 64), NIT = 2 * IT_G + IT_D;
            for (int it = (bx - 64) * NWAVES + wave; it < NIT; it += (G - 64) * NWAVES) {
                int r = it;
                if (r < IT_G) { transpose_item(args.in[I_F2G], D, FF, W2A, args.in[I_F2N], 1, scr, r, lane); continue; } r -= IT_G;
                if (r < IT_G) { transpose_item(args.in[I_F2U], D, FF, W2A, args.in[I_F2N], 2, scr, r, lane); continue; } r -= IT_G;
                transpose_item(args.in[I_F2D], FF, D, W2D, nullptr, 0, scr, r, lane);
            }
            unsigned* subw = (unsigned*)(sm + SM_BAR) + SUBW;
            XcdBarrier xsub; xsub.bar = (unsigned*)(sm + SM_BAR) + 4096; xsub.x = xbar.x; xsub.st = (volatile LAS unsigned*)(lds + LDS_MISC + 72); const unsigned GS = (unsigned)(G - 64);
            xcd_barrier(xsub, GS);
            wait_flag(subw + 64 * 7, 64u);
            TAIL_HALF(0, G - 64, bx - 64, xcd_barrier(xsub, GS), xcd_barrier(xsub, GS), xcd_barrier(xsub, GS));
        }
    }
    xcd_barrier(xbar);

    TAIL_HALF(1, G, bx, xcd_barrier(xbar), xcd_barrier(xbar), xcd_barrier(xbar));
}

extern "C" void kernel_launch(void* const* d_in, const int* in_sizes, int n_in, void* d_out, int out_size, void* d_ws, size_t ws_size, hipStream_t stream) {
    static int grid = 0;
    if (grid == 0) {
        if (n_in != 31 || out_size != M * D || ws_size < WS_END) { fprintf(stderr, "kernel_launch: unexpected shapes (n_in %d out %d ws %zu)\n", n_in, out_size, ws_size); grid = -1; return; }
        int dev = 0, cus = 0, per_cu = 0;
        (void)hipGetDevice(&dev); (void)hipDeviceGetAttribute(&cus, hipDeviceAttributeMultiprocessorCount, dev);
        if (hipFuncSetAttribute((const void*)fwd_kernel, hipFuncAttributeMaxDynamicSharedMemorySize, LDS_BYTES) != hipSuccess) { fprintf(stderr, "kernel_launch: hipFuncSetAttribute failed\n"); grid = -1; return; }
        if (hipOccupancyMaxActiveBlocksPerMultiprocessor(&per_cu, (const void*)fwd_kernel, NTHR, LDS_BYTES) != hipSuccess || per_cu < 1) { fprintf(stderr, "kernel_launch: occupancy query says %d\n", per_cu); per_cu = 1; }
        (void)hipGetLastError();
        grid = cus;
        if (grid > cus * per_cu) grid = cus * per_cu;
        if (grid > 256) grid = 256;
    }
    if (grid < 0) return;
    Args a{};
    for (int i = 0; i < 31; ++i) a.in[i] = (const float*)d_in[i];
    a.out = (float*)d_out; a.ws = (unsigned char*)d_ws;
    (void)hipMemsetAsync((unsigned char*)d_ws + WS_SMALL + SM_BAR, 0, 32768, stream);
    void* kargs[] = {&a};
    hipError_t e = hipLaunchCooperativeKernel((const void*)fwd_kernel, dim3(grid), dim3(NTHR), kargs, LDS_BYTES, stream);
    if (e != hipSuccess) fprintf(stderr, "cooperative launch failed: %s (grid %d)\n", hipGetErrorString(e), grid);
}
```

```cpp
#include <hip/hip_runtime.h>
#include <hip/hip_cooperative_groups.h>
#include <cstdio>
#include <cstdint>
namespace cg = cooperative_groups;
namespace pg8 {
#define PG8_LAS __attribute__((address_space(3)))
typedef unsigned short bf16_t;
typedef short bf16x8 __attribute__((ext_vector_type(8)));
typedef float f32x4 __attribute__((ext_vector_type(4)));
typedef unsigned u32x4 __attribute__((ext_vector_type(4)));
constexpr int BM = 256, BK = 64, HALF = 128, HTB = HALF * BK * 2  , STAGE_BYTES = 8 * HTB, NXCD = 8, WGM = 8;

__host__ __device__ __forceinline__ int lds_byte(int r, int c) { const int st = (r >> 4) * 2 + (c >> 5), rr = r & 15, cc = c & 31, ob = rr * 64 + cc * 2; return st * 1024 + (ob ^ (((ob >> 9) & 1) << 5)); }
__host__ __device__ __forceinline__ void stage_rc(int b, int& R, int& C) { const int st = b / 1024, sb = b % 1024, swz = sb ^ (((sb >> 9) & 1) << 5); R = (st >> 1) * 16 + swz / 64; C = (st & 1) * 32 + (swz % 64) / 2; }
__host__ __device__ __forceinline__ int perm32(int rho) { const int n = rho >> 4, i = rho & 15; return 8 * (i >> 2) + 4 * n + (i & 3); }

struct Unit { int pm, pn; };
struct Gemm { const bf16_t* A; const bf16_t* Bt; int M, N, K; };

struct StaticOrder {
    int nM, nN, nwg, G, c;
    __host__ __device__ void init(int M, int N, int G_, int c_) { nM = M / BM; nN = N / BM; nwg = nM * nN; G = G_; c = c_; }
    __host__ __device__ bool next(int i, Unit& u) const {
        const long L = (long)i * G + c; if (L >= nwg) return false;
        int wgid = (int)L; { const int q = nwg / NXCD, r = nwg % NXCD, xcd = wgid % NXCD, off = wgid / NXCD; wgid = (xcd < r ? xcd * (q + 1) : r * (q + 1) + (xcd - r) * q) + off; }
        const int nig = WGM * nN, gid = wgid / nig, fm = gid * WGM, gsz = (nM - fm) < WGM ? (nM - fm) : WGM;
        u.pm = fm + ((wgid % nig) % gsz); u.pn = (wgid % nig) / gsz; return true;
    }
    __device__ __forceinline__ void a_ready(const Unit&) const {}
    __device__ __forceinline__ void done(const Unit&) const {}
};
__device__ __forceinline__ unsigned cvt_pk_bf16(float lo, float hi) { unsigned r; asm volatile("v_cvt_pk_bf16_f32 %0, %1, %2" : "=v"(r) : "v"(lo), "v"(hi)); return r; }
template <class Epi, class Sched, bool ALIGN_EPI = false, bool SP2 = false>
__device__ __forceinline__ void gemm_phase(PG8_LAS unsigned char* lds, const Gemm g, const Sched& S, const Epi& E) {
    const int tid = threadIdx.x, wid = __builtin_amdgcn_readfirstlane(tid >> 6), lane = tid & 63, wr = wid >> 2, wc = wid & 3, fr = lane & 15, fq = lane >> 4;
    const int K = g.K, nt = K / BK;
    unsigned voffA[2], voffB[2];
#pragma unroll
    for (int i = 0; i < 2; ++i) { int R, C; stage_rc(tid * 16 + i * 8192, R, C); const int Rb = Epi::PERM ? ((R & ~31) + perm32(R & 31)) : R;
        voffA[i] = (unsigned)(R * K + C) * 2u; voffB[i] = (unsigned)(Rb * K + C) * 2u; }
    const size_t kstep = (size_t)(BK * 2);
    const size_t hstep = (size_t)HALF * K * 2;
    const size_t tstep = 2 * hstep;
    const unsigned ldsw = (unsigned)wid * 1024u;
    const int aoff = lds_byte(wr * 64 + fr, fq * 8), boff = lds_byte(wc * 32 + fr, fq * 8);
#define PG8_SA(b, h) (((b) * 2 + (h)) * HTB)
#define PG8_SB(b, h) ((4 + (b) * 2 + (h)) * HTB)
#define PG8_STAGE(bufoff, gbase, voff) do { _Pragma("unroll") for (int _i = 0; _i < 2; ++_i) \
        __builtin_amdgcn_global_load_lds((const unsigned*)((const char*)(gbase) + (voff)[_i]), (PG8_LAS unsigned*)(lds + (bufoff) + ldsw + _i * 8192), 16, 0, 0); } while (0)
#define PG8_LDA(dst, b, h) do { _Pragma("unroll") for (int m = 0; m < 4; ++m) _Pragma("unroll") for (int k = 0; k < 2; ++k) dst[m][k] = *(const PG8_LAS bf16x8*)(lds + PG8_SA(b, h) + aoff + m * 2048 + k * 1024); } while (0)
#define PG8_LDB(dst, b, h) do { _Pragma("unroll") for (int n = 0; n < 2; ++n) _Pragma("unroll") for (int k = 0; k < 2; ++k) dst[n][k] = *(const PG8_LAS bf16x8*)(lds + PG8_SB(b, h) + boff + n * 2048 + k * 1024); } while (0)
#define PG8_MMA(ai, bj, At, Bt) do { __builtin_amdgcn_s_setprio(1); _Pragma("unroll") for (int m = 0; m < 4; ++m) _Pragma("unroll") for (int n = 0; n < 2; ++n) _Pragma("unroll") for (int k = 0; k < 2; ++k) \
        acc[ai][bj][m][n] = __builtin_amdgcn_mfma_f32_16x16x32_bf16(Bt[n][k], At[m][k], acc[ai][bj][m][n], 0, 0, 0); __builtin_amdgcn_s_setprio(0); } while (0)
#define PG8_WAIT_V(n) asm volatile("s_waitcnt vmcnt(" #n ")" ::: "memory")
#define PG8_WAIT_L(n) asm volatile("s_waitcnt lgkmcnt(" #n ")" ::: "memory")
#define PG8_BAR __builtin_amdgcn_s_barrier()
#define PG8_SCHED __builtin_amdgcn_sched_barrier(0)
    Unit cur, nxt; int ui = 0;
    if (!S.next(0, cur)) return;
    f32x4 acc[2][2][4][2];
#pragma unroll
    for (int a = 0; a < 2; ++a)
#pragma unroll
        for (int b = 0; b < 2; ++b)
#pragma unroll
            for (int m = 0; m < 4; ++m)
#pragma unroll
                for (int n = 0; n < 2; ++n) acc[a][b][m][n] = (f32x4){0.f, 0.f, 0.f, 0.f};
    bf16x8 At[4][2], B0[2][2], B1[2][2];
    const char* cA = (const char*)g.A + (size_t)cur.pm * tstep; const char* cB = (const char*)g.Bt + (size_t)cur.pn * tstep;
    S.a_ready(cur);
    if constexpr (SP2) {
        PG8_STAGE(PG8_SB(0, 0), cB, voffB); PG8_STAGE(PG8_SB(0, 1), cB + hstep, voffB); PG8_STAGE(PG8_SA(0, 0), cA, voffA); PG8_STAGE(PG8_SA(0, 1), cA + hstep, voffA);
        if (wr == 1) PG8_BAR;
        PG8_WAIT_V(2); PG8_BAR;
        PG8_STAGE(PG8_SB(1, 0), cB + kstep, voffB); PG8_STAGE(PG8_SA(1, 0), cA + kstep, voffA); PG8_STAGE(PG8_SB(1, 1), cB + hstep + kstep, voffB);
        PG8_WAIT_V(6); PG8_BAR;
    } else {
        PG8_STAGE(PG8_SB(0, 0), cB, voffB); PG8_STAGE(PG8_SA(0, 0), cA, voffA); PG8_STAGE(PG8_SB(0, 1), cB + hstep, voffB); PG8_STAGE(PG8_SA(0, 1), cA + hstep, voffA);
        if (wr == 1) PG8_BAR;
        PG8_WAIT_V(4); PG8_BAR;
        PG8_STAGE(PG8_SB(1, 0), cB + kstep, voffB); PG8_STAGE(PG8_SA(1, 0), cA + kstep, voffA); PG8_STAGE(PG8_SB(1, 1), cB + hstep + kstep, voffB);
        PG8_WAIT_V(6); PG8_BAR;
    }
    for (;;) {
        const bool has_next = S.next(ui + 1, nxt);
        const char* nA = has_next ? (const char*)g.A + (size_t)nxt.pm * tstep : cA; const char* nB = has_next ? (const char*)g.Bt + (size_t)nxt.pn * tstep : cB;
        for (int t = 0; t < nt; t += 2) {
            const bool last = (t == nt - 2);
            const char* a1 = cA + (size_t)(t + 1) * kstep;
            const char* a2 = last ? nA : cA + (size_t)(t + 2) * kstep; const char* b2 = last ? nB : cB + (size_t)(t + 2) * kstep;
            const char* a3 = a2 + kstep; const char* b3 = b2 + kstep;
            if (last && has_next) S.a_ready(nxt);
            if constexpr (SP2) {
            PG8_LDB(B0, 0, 0); PG8_LDB(B1, 0, 1); PG8_SCHED; PG8_LDA(At, 0, 0); PG8_STAGE(PG8_SA(1, 1), a1 + hstep, voffA);
            PG8_WAIT_V(8); PG8_WAIT_L(0); PG8_BAR; PG8_MMA(0, 0, At, B0); PG8_MMA(0, 1, At, B1); PG8_BAR; PG8_SCHED;
            PG8_LDA(At, 0, 1); PG8_STAGE(PG8_SB(0, 0), b2, voffB); PG8_STAGE(PG8_SB(0, 1), b2 + hstep, voffB); PG8_STAGE(PG8_SA(0, 0), a2, voffA);
            PG8_WAIT_V(8); PG8_WAIT_L(0); PG8_BAR; PG8_MMA(1, 0, At, B0); PG8_MMA(1, 1, At, B1); PG8_BAR; PG8_SCHED;
            PG8_LDB(B0, 1, 0); PG8_LDB(B1, 1, 1); PG8_SCHED; PG8_LDA(At, 1, 0); PG8_STAGE(PG8_SA(0, 1), a2 + hstep, voffA);
            PG8_WAIT_V(8); PG8_WAIT_L(0); PG8_BAR; PG8_MMA(0, 0, At, B0); PG8_MMA(0, 1, At, B1); PG8_BAR; PG8_SCHED;
            PG8_LDA(At, 1, 1); PG8_STAGE(PG8_SB(1, 0), b3, voffB); PG8_STAGE(PG8_SB(1, 1), b3 + hstep, voffB); PG8_STAGE(PG8_SA(1, 0), a3, voffA);
            PG8_WAIT_V(8); PG8_WAIT_L(0); PG8_BAR; PG8_MMA(1, 0, At, B0); PG8_MMA(1, 1, At, B1); PG8_BAR; PG8_SCHED;
            } else {
            PG8_LDB(B0, 0, 0); PG8_SCHED; PG8_LDA(At, 0, 0); PG8_STAGE(PG8_SA(1, 1), a1 + hstep, voffA);
            PG8_WAIT_L(8); PG8_BAR; PG8_WAIT_L(0); PG8_MMA(0, 0, At, B0); PG8_BAR; PG8_SCHED;
            PG8_LDB(B1, 0, 1); PG8_STAGE(PG8_SB(0, 0), b2, voffB);
            PG8_BAR; PG8_WAIT_L(0); PG8_MMA(0, 1, At, B1); PG8_BAR;
            PG8_LDA(At, 0, 1); PG8_STAGE(PG8_SA(0, 0), a2, voffA);
            PG8_BAR; PG8_WAIT_L(0); PG8_MMA(1, 0, At, B0); PG8_BAR; PG8_SCHED;
            PG8_STAGE(PG8_SB(0, 1), b2 + hstep, voffB);
            PG8_WAIT_V(6); PG8_BAR; PG8_MMA(1, 1, At, B1); PG8_BAR;
            PG8_LDB(B0, 1, 0); PG8_SCHED; PG8_LDA(At, 1, 0); PG8_STAGE(PG8_SA(0, 1), a2 + hstep, voffA);
            PG8_WAIT_L(8); PG8_BAR; PG8_WAIT_L(0); PG8_MMA(0, 0, At, B0); PG8_BAR; PG8_SCHED;
            PG8_LDB(B1, 1, 1); PG8_STAGE(PG8_SB(1, 0), b3, voffB);
            PG8_BAR; PG8_WAIT_L(0); PG8_MMA(0, 1, At, B1); PG8_BAR;
            PG8_LDA(At, 1, 1); PG8_STAGE(PG8_SA(1, 0), a3, voffA);
            PG8_BAR; PG8_WAIT_L(0); PG8_MMA(1, 0, At, B0); PG8_BAR; PG8_SCHED;
            PG8_STAGE(PG8_SB(1, 1), b3 + hstep, voffB);
            PG8_WAIT_V(6); PG8_BAR; PG8_MMA(1, 1, At, B1); PG8_BAR;
            }
        }
        if constexpr (ALIGN_EPI) { if (wr == 0) PG8_BAR; }
        if constexpr (!Epi::AFTER_DRAIN) { E(acc, cur, wr, wc, fr, fq); S.done(cur); }
        if (!has_next) break;
#pragma unroll
        for (int a = 0; a < 2; ++a)
#pragma unroll
            for (int b = 0; b < 2; ++b)
#pragma unroll
                for (int m = 0; m < 4; ++m)
#pragma unroll
                    for (int n = 0; n < 2; ++n) acc[a][b][m][n] = (f32x4){0.f, 0.f, 0.f, 0.f};
        cur = nxt; cA = nA; cB = nB; ++ui;
        if constexpr (ALIGN_EPI) { if (wr == 1) PG8_BAR; }
    }
    PG8_WAIT_V(0);
    if constexpr (!ALIGN_EPI) { if (wr == 0) PG8_BAR; }
    PG8_BAR;
    if constexpr (Epi::AFTER_DRAIN) { E.fused(acc, cur, wr, wc, fr, fq, lds, wid, lane); S.done(cur); }
#undef PG8_SA
#undef PG8_SB
#undef PG8_STAGE
#undef PG8_LDA
#undef PG8_LDB
#undef PG8_MMA
#undef PG8_WAIT_V
#undef PG8_WAIT_L
#undef PG8_BAR
#undef PG8_SCHED
}
}
#define PG8_SP2 true
#define PG8_ALIGN true
#define LAS __attribute__((address_space(3)))
typedef unsigned short bf16;
typedef short bf16x8 __attribute__((ext_vector_type(8)));
typedef short s16x4 __attribute__((ext_vector_type(4)));
typedef float f32x4 __attribute__((ext_vector_type(4)));
typedef float f32x2 __attribute__((ext_vector_type(2)));
typedef float f32x16 __attribute__((ext_vector_type(16)));
typedef unsigned u32x4 __attribute__((ext_vector_type(4)));
typedef unsigned u32x2 __attribute__((ext_vector_type(2)));

constexpr int NWAVES = 8, NTHR = 512;
constexpr int BATCH = 2, T = 8192, D = 1024, FF = 2816, NMETA = 16, LP = 8208, M = BATCH * T, PR = BATCH * LP;
constexpr int NIN = 3360, NINP = 3584, DAW = 1536, RWW = 1824, VP = 8256;
constexpr float NORM_EPS = 1e-6f, GN_EPS = 64e-5f;
constexpr size_t MiB = 1u << 20;
constexpr size_t WS_XB = 0, WS_T = 32 * MiB, WS_URW = 32 * MiB, WS_UDA = 90 * MiB, WS_Y = 90 * MiB;
constexpr size_t WS_Q = 139 * MiB, QKV_BYTES = (size_t)BATCH * 4 * VP * 128 * 2, WS_K = WS_Q + QKV_BYTES, WS_VT = WS_K + QKV_BYTES;
constexpr size_t WS_W1A = 139 * MiB, WS_W1D = 150 * MiB, WS_WIN = 156 * MiB, WS_XB2 = 106 * MiB  , WS_TC = 139 * MiB  , WS_W2A = 122 * MiB, WS_W2D = 133 * MiB;
constexpr size_t WS_E = 188 * MiB, WS_A = 205 * MiB, WS_G = 222 * MiB;
constexpr size_t WS_WOUT = 239 * MiB, WS_LORA = 241 * MiB, WS_SMALL = 242 * MiB, WS_END = 244 * MiB;
static_assert(WS_VT + QKV_BYTES <= WS_E && (size_t)PR * RWW * 2 <= (WS_UDA - WS_URW) && (size_t)PR * DAW * 2 <= (WS_Q - WS_UDA) && (size_t)PR * 512 * 2 <= 17 * MiB, "ws map");
static_assert(WS_TC + (size_t)(M / 2) * FF * 2 <= WS_E && WS_Y + (size_t)M * 512 * 2 <= WS_XB2 && WS_XB2 + (size_t)(M / 2) * D * 2 <= WS_W2A, "tail ws map");
constexpr size_t SM_SSQ0 = 0, SM_SSQ1 = 65536, SM_SSQ2 = 131072, SM_BETA = 196608  , SM_XBM = 786432, SM_XBM2 = 819200, SM_TM = 851968  , SM_SSQM0 = 950272, SM_SSQM1 = 950528, SM_MISC = 950784;
constexpr int SUBW = 3584;
constexpr size_t SM_BAR = 983040;

__device__ __forceinline__ unsigned f2bf(float f) { unsigned u = __builtin_bit_cast(unsigned, f); return (u + 0x7fffu + ((u >> 16) & 1u)) >> 16; }
typedef __bf16 bf16x2_t __attribute__((ext_vector_type(2)));
__device__ __forceinline__ unsigned pk2(float lo, float hi) { const f32x2 v = {lo, hi}; return __builtin_bit_cast(unsigned, __builtin_convertvector(v, bf16x2_t)); }
__device__ __forceinline__ float bf2f(unsigned short b) { return __builtin_bit_cast(float, (unsigned)b << 16); }
__device__ __forceinline__ float bflo(unsigned w) { return __builtin_bit_cast(float, w << 16); }
__device__ __forceinline__ float bfhi(unsigned w) { return __builtin_bit_cast(float, w & 0xffff0000u); }
__device__ __forceinline__ float wave_sum(float v) {
#pragma unroll
    for (int o = 1; o < 64; o <<= 1) v += __shfl_xor(v, o);
    return v;
}
__device__ __forceinline__ float sigmoidf_(float x) { return __builtin_amdgcn_rcpf(1.0f + __expf(-x)); }
__device__ __forceinline__ u32x4 pack8(const float* v) { u32x4 w; w.x = pk2(v[0], v[1]); w.y = pk2(v[2], v[3]); w.z = pk2(v[4], v[5]); w.w = pk2(v[6], v[7]); return w; }
__device__ __forceinline__ void unpack8(u32x4 w, float* v) { v[0] = bflo(w.x); v[1] = bfhi(w.x); v[2] = bflo(w.y); v[3] = bfhi(w.y); v[4] = bflo(w.z); v[5] = bfhi(w.z); v[6] = bflo(w.w); v[7] = bfhi(w.w); }

struct Args {
    const float* in[31];
    float* out; unsigned char* ws;
};
enum { I_X = 0, I_META, I_F1N, I_F1G, I_F1U, I_F1D, I_MIXN, I_WIN, I_QN, I_KN, I_LQ1, I_LK1, I_LQ2, I_LK2, I_SUBLN, I_SHIFT, I_W0, I_W2, I_A0, I_A2, I_G2, I_KK, I_KA, I_RK, I_LNW, I_LNB, I_WOUT,
       I_F2N, I_F2G, I_F2U, I_F2D };

__device__ __forceinline__ int amap_tile(int k, int half) { return (k < 16 ? k : k + 16) + 16 * half; }
__device__ __forceinline__ int cmap_tile(int pm, int half) { const int p = pm - 16 * half; return p < 16 ? p : p - 16; }
struct EpiSwiglu {
    static constexpr bool PERM = true, AFTER_DRAIN = false;
    bf16* Tout; const float* ssq; int half, mode;
    __device__ __forceinline__ void operator()(const pg8::f32x4 (&acc)[2][2][4][2], const pg8::Unit& u, int wr, int wc, int fr, int fq) const {
        const int tA = mode == 1 ? amap_tile(u.pm, half) : u.pm;
        const int row0 = u.pm * 256 + wr * 64 + fr, row0A = tA * 256 + wr * 64 + fr, hc0 = u.pn * 128 + wc * 32 + 8 * fq;
#pragma unroll
        for (int ai = 0; ai < 2; ++ai)
#pragma unroll
            for (int m = 0; m < 4; ++m) {
                const int row = row0 + ai * 128 + m * 16;
                const float rs = rsqrtf(ssq[row0A + ai * 128 + m * 16] * (1.0f / D) + NORM_EPS);
                float t[8];
#pragma unroll
                for (int n = 0; n < 2; ++n)
#pragma unroll
                    for (int e = 0; e < 4; ++e) { const float g = acc[ai][0][m][n][e] * rs, up = acc[ai][1][m][n][e] * rs; t[4 * n + e] = g * sigmoidf_(g) * up; }
                *(u32x4*)(Tout + (size_t)row * FF + hc0) = pack8(t);
            }
    }
};
struct EpiRes {
    static constexpr bool PERM = true, AFTER_DRAIN = false;
    const float* base; float* out; bf16* xb; float* ssq; float scale; int half, mode;
    __device__ __forceinline__ void operator()(const pg8::f32x4 (&acc)[2][2][4][2], const pg8::Unit& u, int wr, int wc, int fr, int fq) const {
        const int tA = mode == 2 ? amap_tile(u.pm, half) : u.pm, tC = mode == 1 ? cmap_tile(u.pm, half) : u.pm;
        const int row0 = tA * 256 + wr * 64 + fr, row0C = tC * 256 + wr * 64 + fr, col0 = u.pn * 256 + wc * 32 + 8 * fq;
#pragma unroll
        for (int ai = 0; ai < 2; ++ai)
#pragma unroll
            for (int m = 0; m < 4; ++m) {
                const int row = row0 + ai * 128 + m * 16, rowC = row0C + ai * 128 + m * 16; float s = 0.f;
#pragma unroll
                for (int bj = 0; bj < 2; ++bj) {
                    const size_t o = (size_t)row * D + col0 + bj * 128, oC = (size_t)rowC * D + col0 + bj * 128;
                    const f32x4 b0 = *(const f32x4*)(base + o), b1 = *(const f32x4*)(base + o + 4);
                    const f32x4 h0 = b0 + acc[ai][bj][m][0] * scale, h1 = b1 + acc[ai][bj][m][1] * scale;
                    *(f32x4*)(out + o) = h0; *(f32x4*)(out + o + 4) = h1;
                    if (xb) { u32x4 w; w.x = pk2(h0[0], h0[1]); w.y = pk2(h0[2], h0[3]); w.z = pk2(h1[0], h1[1]); w.w = pk2(h1[2], h1[3]); *(u32x4*)(xb + oC) = w; }
                    s += (h0[0] * h0[0] + h0[1] * h0[1]) + (h0[2] * h0[2] + h0[3] * h0[3]) + (h1[0] * h1[0] + h1[1] * h1[1]) + (h1[2] * h1[2] + h1[3] * h1[3]);
                }
                if (ssq) { s += __shfl_xor(s, 16); s += __shfl_xor(s, 32); if (fq == 0) atomicAdd(ssq + row, s); }
            }
    }
};
struct HalfOrder {
    pg8::StaticOrder so; int half, actual;
    __device__ __forceinline__ void init(int N, int G_, int c_, int half_, int actual_) { so.init(M / 2, N, G_, c_); half = half_; actual = actual_; }
    __device__ __forceinline__ bool next(int i, pg8::Unit& u) const { if (!so.next(i, u)) return false; if (actual) u.pm = amap_tile(u.pm, half); return true; }
    __device__ __forceinline__ void a_ready(const pg8::Unit&) const {}
    __device__ __forceinline__ void done(const pg8::Unit&) const {}
};
struct EpiU {
    static constexpr bool PERM = true, AFTER_DRAIN = false;
    bf16* uda; bf16* urw; const float* ssq;
    __device__ __forceinline__ void operator()(const pg8::f32x4 (&acc)[2][2][4][2], const pg8::Unit& u, int wr, int wc, int fr, int fq) const {
        const int row0 = u.pm * 256 + wr * 64 + fr, col0 = u.pn * 256 + wc * 32 + 8 * fq;
#pragma unroll
        for (int ai = 0; ai < 2; ++ai)
#pragma unroll
            for (int m = 0; m < 4; ++m) {
                const int row = row0 + ai * 128 + m * 16;
                const int pr = (row >> 13) * LP + NMETA + (row & 8191);
                const float rs = rsqrtf(ssq[row] * (1.0f / D) + NORM_EPS);
#pragma unroll
                for (int bj = 0; bj < 2; ++bj) {
                    const int c = col0 + bj * 128;
                    if (c < NIN) {
                        float t[8];
#pragma unroll
                        for (int n = 0; n < 2; ++n)
#pragma unroll
                            for (int e = 0; e < 4; ++e) t[4 * n + e] = acc[ai][bj][m][n][e] * rs;
                        bf16* dst = (c < DAW) ? (uda + (size_t)pr * DAW + c) : (urw + (size_t)pr * RWW + (c - DAW));
                        *(u32x4*)dst = pack8(t);
                    }
                }
            }
    }
};

__device__ __forceinline__ f32x4 mfma16(bf16x8 a, bf16x8 b, f32x4 c) { return __builtin_amdgcn_mfma_f32_16x16x32_bf16(a, b, c, 0, 0, 0); }
__device__ __forceinline__ f32x16 mfma32(bf16x8 a, bf16x8 b, f32x16 c) { return __builtin_amdgcn_mfma_f32_32x32x16_bf16(a, b, c, 0, 0, 0); }
__device__ __forceinline__ f32x4 mm16(const bf16* A, int lda, const bf16* Bt, int ldb, int K, int lane) {
    const int r = lane & 15, q = lane >> 4;
    const bf16x8* ap = (const bf16x8*)(A + (size_t)r * lda + 8 * q);
    const bf16x8* bp = (const bf16x8*)(Bt + (size_t)r * ldb + 8 * q);
    f32x4 acc = {0.f, 0.f, 0.f, 0.f};
#pragma unroll 8
    for (int kk = 0; kk < K / 32; ++kk) acc = mfma16(ap[4 * kk], bp[4 * kk], acc);
    return acc;
}
__device__ __forceinline__ void transpose_item(const float* W, int K, int N, bf16* WT, const float* gain, int mode, LAS float* scr, int item, int lane) {
    const int nblk = (N + 63) / 64, kb = item / nblk, nb = item % nblk, k0 = 64 * kb, n0 = 64 * nb;
    const int r4 = lane >> 4, c4 = (lane & 15) * 4;
    const bool colok = n0 + c4 < N;
#pragma unroll
    for (int i = 0; i < 16; ++i) {
        const int kk = r4 + 4 * i;
        f32x4 v = {0.f, 0.f, 0.f, 0.f};
        if (colok) v = *(const f32x4*)(W + (size_t)(k0 + kk) * N + n0 + c4);
        if (gain) v = v * gain[k0 + kk];
        LAS float* d = scr + kk * 65 + c4; d[0] = v.x; d[1] = v.y; d[2] = v.z; d[3] = v.w;
    }
    asm volatile("s_waitcnt lgkmcnt(0)" ::: "memory");
    const int c = lane & 7;
#pragma unroll
    for (int j = 0; j < 8; ++j) {
        const int nl = (lane >> 3) + 8 * j, n = n0 + nl; const LAS float* s = scr + (8 * c) * 65 + nl;
        const int orow = (mode == 0) ? n : ((n >> 7) * 256 + (n & 127) + (mode == 2 ? 128 : 0));
        u32x4 o; o.x = pk2(s[0 * 65], s[1 * 65]); o.y = pk2(s[2 * 65], s[3 * 65]); o.z = pk2(s[4 * 65], s[5 * 65]); o.w = pk2(s[6 * 65], s[7 * 65]);
        if (n < N) *(u32x4*)(WT + (size_t)orow * K + k0 + 8 * c) = o;
    }
    asm volatile("s_waitcnt lgkmcnt(0)" ::: "memory");
}
__device__ __forceinline__ void row_to_bf16(const float* xrow, bf16* orow, float* ssq_out, int lane) {
    const f32x4* xr = (const f32x4*)xrow + lane; f32x4 v[4]; float s = 0.f;
#pragma unroll
    for (int j = 0; j < 4; ++j) { v[j] = xr[64 * j]; s += (v[j].x * v[j].x + v[j].y * v[j].y) + (v[j].z * v[j].z + v[j].w * v[j].w); }
    s = wave_sum(s); if (lane == 0) *ssq_out = s;
    u32x2* o8 = (u32x2*)orow + lane;
#pragma unroll
    for (int j = 0; j < 4; ++j) { u32x2 w; w.x = pk2(v[j].x, v[j].y); w.y = pk2(v[j].z, v[j].w); o8[64 * j] = w; }
}
__device__ __forceinline__ float dpp_f(float x, int ctrl_sel) {
    const int xi = __builtin_bit_cast(int, x); int r;
    if (ctrl_sel == 0) r = __builtin_amdgcn_update_dpp(0, xi, 0xB1, 0xF, 0xF, true);
    else if (ctrl_sel == 1) r = __builtin_amdgcn_update_dpp(0, xi, 0x4E, 0xF, 0xF, true);
    else if (ctrl_sel == 2) r = __builtin_amdgcn_update_dpp(0, xi, 0x141, 0xF, 0xF, true);
    else r = __builtin_amdgcn_update_dpp(0, xi, 0x140, 0xF, 0xF, true);
    return __builtin_bit_cast(float, r);
}
__device__ __forceinline__ float fmul_s(float a, float b) { float r; asm("v_mul_f32_e32 %0, %1, %2" : "=v"(r) : "v"(a), "v"(b)); return r; }
__device__ __forceinline__ float fadd_s(float a, float b) { float r; asm("v_add_f32_e32 %0, %1, %2" : "=v"(r) : "v"(a), "v"(b)); return r; }
__device__ __forceinline__ float fsub_s(float a, float b) { float r; asm("v_sub_f32_e32 %0, %1, %2" : "=v"(r) : "v"(a), "v"(b)); return r; }
__device__ __forceinline__ float ffma_s(float a, float b, float c) { float r; asm("v_fma_f32 %0, %1, %2, %3" : "=v"(r) : "v"(a), "v"(b), "v"(c)); return r; }
__device__ __forceinline__ float sum16(float x) { x += dpp_f(x, 0); x += dpp_f(x, 1); x += dpp_f(x, 2); x += dpp_f(x, 3); return x; }

#define XB_TMO      128
#define XB_XCNT(j)  (256  + 64 * (j))
#define XB_XSUB(j)  (1280 + 64 * (j))
#define XB_XGEN(j)  (2304 + 64 * (j))
#define XB_TOP      3328
#define XB_TOPGEN   3392
#define XCD_BAR_WORDS 3456
#define XB_SPIN_CAP (1u << 18)

__device__ __forceinline__ unsigned xb_ld(unsigned* p)              { return __hip_atomic_load(p, __ATOMIC_RELAXED, __HIP_MEMORY_SCOPE_AGENT); }
__device__ __forceinline__ unsigned xb_add(unsigned* p, unsigned v) { return __hip_atomic_fetch_add(p, v, __ATOMIC_RELAXED, __HIP_MEMORY_SCOPE_AGENT); }
__device__ __forceinline__ unsigned xb_xcc_id() { return (unsigned)__builtin_amdgcn_s_getreg((3 << 11) | 20) & 0xFu; }
#define XB_SPIN(cond, bar) do { unsigned _sp = 0; while (cond) { __builtin_amdgcn_s_sleep(1); \
    if ((++_sp & 255u) == 0u) { if (xb_ld(&(bar)[XB_TMO])) break; if (_sp > XB_SPIN_CAP) { atomicAdd(&(bar)[XB_TMO], 1u); break; } } } } while (0)

struct XcdBarrier {
    unsigned* bar; unsigned x;
    volatile LAS unsigned* st;
};

__device__ __forceinline__ XcdBarrier xcd_barrier_post(unsigned* bar, volatile LAS unsigned* st) {
    XcdBarrier b; b.bar = bar; b.x = xb_xcc_id(); b.st = st;
    if (threadIdx.x == 0) (void)xb_add(&bar[XB_XCNT(b.x)], 1u);
    return b;
}
__device__ __forceinline__ void xcd_barrier_complete(unsigned* bar, unsigned x, unsigned& nloc, unsigned& nx, unsigned gsz) {
    const unsigned G = gsz;
    unsigned sum, cnt, mine, sp = 0u;
    for (;;) {
        sum = 0u; cnt = 0u; mine = 0u;
#pragma unroll
        for (unsigned j = 0; j < 16; ++j) { const unsigned c = xb_ld(&bar[XB_XCNT(j)]); sum += c; cnt += (c > 0u) ? 1u : 0u; mine = (j == x) ? c : mine; }
        if (sum == G) break;
        __builtin_amdgcn_s_sleep(1);
        if ((++sp & 255u) == 0u) { if (xb_ld(&bar[XB_TMO])) break; if (sp > XB_SPIN_CAP) { atomicAdd(&bar[XB_TMO], 1u); break; } }
    }
    nloc = mine > 0u ? mine : 1u; nx = cnt > 0u ? cnt : 1u;
}

__device__ __forceinline__ void xcd_barrier(const XcdBarrier& b, unsigned gsz = 0u) {
    asm volatile("s_waitcnt vmcnt(0)" ::: "memory");
    __syncthreads();
    if (threadIdx.x == 0) {
        unsigned* bar = b.bar;
        __builtin_amdgcn_s_waitcnt(0);
        unsigned nloc = b.st[0], nx = b.st[1];
        if (nloc == 0u) { xcd_barrier_complete(bar, b.x, nloc, nx, gsz ? gsz : gridDim.x); b.st[0] = nloc; b.st[1] = nx; }
        const unsigned old = xb_add(&bar[XB_XSUB(b.x)], 1u);
        const unsigned gen = old / nloc;
        if (old + 1u == (gen + 1u) * nloc) {
            __builtin_amdgcn_fence(__ATOMIC_RELEASE, "agent");
            asm volatile("s_waitcnt vmcnt(0)" ::: "memory");
            const unsigned og = xb_add(&bar[XB_TOP], 1u);
            const unsigned tg = og / nx;
            if (og + 1u == (tg + 1u) * nx) xb_add(&bar[XB_TOPGEN], 1u);
            else XB_SPIN(xb_ld(&bar[XB_TOPGEN]) == tg, bar);
            __builtin_amdgcn_fence(__ATOMIC_ACQUIRE, "agent");
            xb_add(&bar[XB_XGEN(b.x)], 1u);
            asm volatile("s_waitcnt vmcnt(0)" ::: "memory");
        } else {
            XB_SPIN(xb_ld(&bar[XB_XGEN(b.x)]) == gen, bar);
            __builtin_amdgcn_fence(__ATOMIC_ACQUIRE, "agent");
            asm volatile("s_waitcnt vmcnt(0)" ::: "memory");
        }
    }
    __syncthreads();
}

__device__ __forceinline__ void p6_half(const bf16* URW, const bf16* Ab, const bf16* Gb, const bf16* Y, bf16* XB, const float* mixp, const float* ka, const float* rk, const float* lnwp, const float* lnbp,
                                        int half, int wi, int nw, int lane) {
    const int c0 = 8 * lane;
    float mr[8], mk[8], mv[8], kac[8], rkc[8], lnw[8], lnb[8];
#pragma unroll
    for (int j = 0; j < 8; ++j) { mr[j] = mixp[c0 + j]; mk[j] = mixp[512 + c0 + j]; mv[j] = mixp[1024 + c0 + j]; kac[j] = ka[c0 + j]; rkc[j] = rk[c0 + j]; lnw[j] = lnwp[c0 + j]; lnb[j] = lnbp[c0 + j]; }
    for (int r = wi; r < M / 2; r += nw) {
        const int m = amap_tile(r >> 8, half) * 256 + (r & 255);
        const int b = m >> 13, t = m & 8191, pr = b * LP + NMETA + t;
        const bf16* cur = URW + (size_t)pr * RWW + c0; const bf16* prv = cur - RWW;
        float rc[8], rp[8], kc[8], kp[8], vc[8], vp[8], a8[8], g8[8], y[8];
        unpack8(*(const u32x4*)cur, rc); unpack8(*(const u32x4*)prv, rp); unpack8(*(const u32x4*)(cur + 512), kc); unpack8(*(const u32x4*)(prv + 512), kp);
        unpack8(*(const u32x4*)(cur + 1024), vc); unpack8(*(const u32x4*)(prv + 1024), vp);
        unpack8(*(const u32x4*)(Ab + (size_t)pr * 512 + c0), a8); unpack8(*(const u32x4*)(Gb + (size_t)pr * 512 + c0), g8);
        unpack8(*(const u32x4*)(Y + (size_t)m * 512 + c0), y);
        float s = 0.f, beta = 0.f;
#pragma unroll
        for (int j = 0; j < 8; ++j) { s += y[j]; const float r_ = rc[j] + (rp[j] - rc[j]) * mr[j], k_ = kc[j] + (kp[j] - kc[j]) * mk[j]; beta += r_ * (k_ * (1.0f + (a8[j] - 1.0f) * kac[j])) * rkc[j]; }
        s += __shfl_xor(s, 1); s += __shfl_xor(s, 2); s += __shfl_xor(s, 4);
        beta += __shfl_xor(beta, 1); beta += __shfl_xor(beta, 2); beta += __shfl_xor(beta, 4);
        const float mu = s * (1.0f / 64); float q = 0.f;
#pragma unroll
        for (int j = 0; j < 8; ++j) { y[j] -= mu; q += y[j] * y[j]; }
        q += __shfl_xor(q, 1); q += __shfl_xor(q, 2); q += __shfl_xor(q, 4);
        const float rstd = rsqrtf(q * (1.0f / 64) + GN_EPS);
        float o[8];
#pragma unroll
        for (int j = 0; j < 8; ++j) { const float v_ = vc[j] + (vp[j] - vc[j]) * mv[j]; o[j] = (y[j] * rstd * lnw[j] + lnb[j] + beta * v_) * g8[j]; }
        *(u32x4*)(XB + (size_t)m * D + 512 + c0) = pack8(o);
    }
}
#define TAIL_HALF(HALF_, GS_, CI_, BAR1_, BAR2_, BAR3_) do { \
        p6_half(URW, Ab, Gb, Y, XB, args.in[I_SHIFT], args.in[I_KA], args.in[I_RK], args.in[I_LNW], args.in[I_LNB], (HALF_), (CI_) * NWAVES + wave, (GS_) * NWAVES, lane); \
        BAR1_; \
        { pg8::Gemm g{XB, WOUT, M / 2, D, D}; HalfOrder S; S.init(D, (GS_), (CI_), (HALF_), 1); EpiRes E{out, out, XB2, ssq2, 1.0f, (HALF_), 1}; \
          pg8::gemm_phase<EpiRes, HalfOrder, PG8_ALIGN, PG8_SP2>(lds, g, S, E); } \
        BAR2_; \
        { pg8::Gemm g{XB2, W2A, M / 2, 2 * FF, D}; HalfOrder S; S.init(2 * FF, (GS_), (CI_), (HALF_), 0); EpiSwiglu E{TC, ssq2, (HALF_), 1}; \
          pg8::gemm_phase<EpiSwiglu, HalfOrder, PG8_ALIGN, PG8_SP2>(lds, g, S, E); } \
        BAR3_; \
        { pg8::Gemm g{TC, W2D, M / 2, D, FF}; HalfOrder S; S.init(D, (GS_), (CI_), (HALF_), 0); EpiRes E{out, out, nullptr, nullptr, 0.5f, (HALF_), 2}; \
          pg8::gemm_phase<EpiRes, HalfOrder, PG8_ALIGN, PG8_SP2>(lds, g, S, E); } \
    } while (0)
__device__ __forceinline__ void sub_barrier(unsigned* ctr, unsigned target) {
    asm volatile("s_waitcnt vmcnt(0)" ::: "memory");
    __syncthreads();
    if (threadIdx.x == 0) {
        __builtin_amdgcn_fence(__ATOMIC_RELEASE, "agent"); asm volatile("s_waitcnt vmcnt(0)" ::: "memory");
        __hip_atomic_fetch_add(ctr, 1u, __ATOMIC_RELAXED, __HIP_MEMORY_SCOPE_AGENT);
        unsigned sp = 0;
        while (__hip_atomic_load(ctr, __ATOMIC_RELAXED, __HIP_MEMORY_SCOPE_AGENT) < target) { __builtin_amdgcn_s_sleep(2); if (++sp > (1u << 22)) break; }
        __builtin_amdgcn_fence(__ATOMIC_ACQUIRE, "agent"); asm volatile("s_waitcnt vmcnt(0)" ::: "memory");
    }
    __syncthreads();
}
__device__ __forceinline__ void wait_flag(unsigned* ctr, unsigned target) {
    if (threadIdx.x == 0) {
        unsigned sp = 0;
        while (__hip_atomic_load(ctr, __ATOMIC_RELAXED, __HIP_MEMORY_SCOPE_AGENT) < target) { __builtin_amdgcn_s_sleep(4); if (++sp > (1u << 22)) break; }
        __builtin_amdgcn_fence(__ATOMIC_ACQUIRE, "agent"); asm volatile("s_waitcnt vmcnt(0)" ::: "memory");
    }
    __syncthreads();
}
constexpr int LDS_BYTES = 147456;
constexpr int ATT_KB = 64 * 272, ATT_VB = 128 * 136, ATT_BUF = ATT_KB + ATT_VB;
constexpr int LDS_MISC = 143360;
constexpr int SCAN_STEP_F = 384, SCAN_CH = 32;

__global__ void __launch_bounds__(NTHR, 2) fwd_kernel(Args args) {
    extern __shared__ __attribute__((aligned(16))) unsigned char lds_raw[];
    LAS unsigned char* lds = (LAS unsigned char*)lds_raw;
    const int tid = threadIdx.x, lane = tid & 63, wave = __builtin_amdgcn_readfirstlane(tid >> 6);
    const int G = gridDim.x, bx = blockIdx.x;
    const int gw = bx * NWAVES + wave, NGW = G * NWAVES;
    unsigned char* ws = args.ws;
    bf16* XB = (bf16*)(ws + WS_XB); bf16* TB = (bf16*)(ws + WS_T); bf16* URW = (bf16*)(ws + WS_URW); bf16* UDA = (bf16*)(ws + WS_UDA); bf16* Y = (bf16*)(ws + WS_Y); bf16* TC = (bf16*)(ws + WS_TC);
    bf16* Qb = (bf16*)(ws + WS_Q); bf16* Kb = (bf16*)(ws + WS_K); bf16* Vt = (bf16*)(ws + WS_VT);
    bf16* W1A = (bf16*)(ws + WS_W1A); bf16* W1D = (bf16*)(ws + WS_W1D); bf16* WIN = (bf16*)(ws + WS_WIN); bf16* XB2 = (bf16*)(ws + WS_XB2);
    bf16* W2A = (bf16*)(ws + WS_W2A); bf16* W2D = (bf16*)(ws + WS_W2D);
    bf16* Eb = (bf16*)(ws + WS_E); bf16* Ab = (bf16*)(ws + WS_A); bf16* Gb = (bf16*)(ws + WS_G);
    bf16* WOUT = (bf16*)(ws + WS_WOUT);
    bf16* W2T = (bf16*)(ws + WS_LORA); bf16* A2T = W2T + 512 * 64; bf16* G2T = A2T + 512 * 64;
    unsigned char* sm = ws + WS_SMALL;
    float* ssq0 = (float*)(sm + SM_SSQ0); float* ssq1 = (float*)(sm + SM_SSQ1); float* ssq2 = (float*)(sm + SM_SSQ2); float* INV = (float*)(sm + SM_BETA);
    bf16* XBM = (bf16*)(sm + SM_XBM); bf16* XBM2 = (bf16*)(sm + SM_XBM2); bf16* TM = (bf16*)(sm + SM_TM);
    float* ssqm0 = (float*)(sm + SM_SSQM0); float* ssqm1 = (float*)(sm + SM_SSQM1); float* misc = (float*)(sm + SM_MISC); unsigned* qctr = (unsigned*)(misc + 16);
    const float* x = args.in[I_X];
    float* out = args.out;
    if (tid < 4) ((LAS unsigned*)(lds + LDS_MISC + 64))[tid] = 0u;
    __syncthreads();
    const XcdBarrier xbar = xcd_barrier_post((unsigned*)(sm + SM_BAR), (volatile LAS unsigned*)(lds + LDS_MISC + 64));
    if (bx >= 64 && tid == 0) (void)xb_add(&((unsigned*)(sm + SM_BAR) + 4096)[XB_XCNT(xbar.x)], 1u);

    {
        LAS float* scr = (LAS float*)(lds + wave * 16640);
        constexpr int IT_G = (D / 64) * (FF / 64);
        for (int it = gw; it < 2 * IT_G; it += NGW) {
            if (it < IT_G) transpose_item(args.in[I_F1G], D, FF, W1A, args.in[I_F1N], 1, scr, it, lane);
            else transpose_item(args.in[I_F1U], D, FF, W1A, args.in[I_F1N], 2, scr, it - IT_G, lane);
        }
        for (int m = gw; m < M; m += NGW) row_to_bf16(x + (size_t)m * D, XB + (size_t)m * D, ssq0 + m, lane);
        if (gw < NMETA) row_to_bf16(args.in[I_META] + (size_t)gw * D, XBM + (size_t)gw * D, ssqm0 + gw, lane);
        const int gt = bx * NTHR + tid, NGT = G * NTHR;
        for (int i = gt; i < M; i += NGT) { ssq1[i] = 0.f; ssq2[i] = 0.f; }
        if (gt < 16) ssqm1[gt] = 0.f;
        if (gt == 0) { qctr[0] = 0u; qctr[1] = 0u; }
        for (int i = gt; i < 512 * 64; i += NGT) { const int n = i >> 6, k = i & 63; W2T[i] = (bf16)f2bf(args.in[I_W2][k * 512 + n]); A2T[i] = (bf16)f2bf(args.in[I_A2][k * 512 + n]); }
        for (int i = gt; i < 512 * 160; i += NGT) { const int n = i / 160, k = i % 160; G2T[i] = (bf16)f2bf(args.in[I_G2][k * 512 + n]); }
        if (gw == 0) {
            const float s1 = wave_sum(args.in[I_LQ1][lane] * args.in[I_LK1][lane]), s2 = wave_sum(args.in[I_LQ2][lane] * args.in[I_LK2][lane]);
            if (lane == 0) misc[0] = expf(s1) - expf(s2) + 0.2f;
        }
    }
    xcd_barrier(xbar);

    {
        const int mw1 = (G == 256) ? (bx >= 128 ? (bx - 128) * NWAVES + wave : (1 << 30)) : gw, ms1 = (G == 256) ? 128 * NWAVES : NGW;
        for (int hc = mw1; hc < FF / 16; hc += ms1) {
            const int grow = (hc >> 3) * 256 + (hc & 7) * 16;
            const f32x4 ag = mm16(XBM, D, W1A + (size_t)grow * D, D, D, lane), au = mm16(XBM, D, W1A + (size_t)(grow + 128) * D, D, D, lane);
#pragma unroll
            for (int e = 0; e < 4; ++e) { const int row = 4 * (lane >> 4) + e; const float rs = rsqrtf(ssqm0[row] * (1.0f / D) + NORM_EPS); const float g = ag[e] * rs, up = au[e] * rs;
                TM[row * FF + hc * 16 + (lane & 15)] = (bf16)f2bf(g * sigmoidf_(g) * up); }
        }
        pg8::Gemm g{XB, W1A, M, 2 * FF, D}; pg8::StaticOrder S; S.init(M, 2 * FF, G, bx);
        EpiSwiglu E{TB, ssq0, 0, 0};
        pg8::gemm_phase<EpiSwiglu, pg8::StaticOrder, PG8_ALIGN, PG8_SP2>(lds, g, S, E);
        if (G == 256 ? bx >= 128 : true) {
            LAS float* scr = (LAS float*)(lds + wave * 16640);
            constexpr int IT_D = (FF / 64) * (D / 64), IT_IN = (D / 64) * ((NIN + 63) / 64), IT_O = (D / 64) * (D / 64), NIT = IT_D + IT_IN + IT_O;
            const int nb = (G == 256) ? 128 : G, b0 = (G == 256) ? 128 : 0;
            for (int it = (bx - b0) * NWAVES + wave; it < NIT; it += nb * NWAVES) {
                int r = it;
                if (r < IT_D) { transpose_item(args.in[I_F1D], FF, D, W1D, nullptr, 0, scr, r, lane); continue; } r -= IT_D;
                if (r < IT_IN) { transpose_item(args.in[I_WIN], D, NIN, WIN, args.in[I_MIXN], 0, scr, r, lane); continue; } r -= IT_IN;
                transpose_item(args.in[I_WOUT], D, D, WOUT, nullptr, 0, scr, r, lane);
            }
        }
    }
    xcd_barrier(xbar);

    {
        for (int cb = bx; cb < D / 16; cb += G) {
            f32x4 a = mm16(TM + 352 * wave, FF, W1D + (size_t)cb * 16 * FF + 352 * wave, FF, 352, lane);
            LAS f32x4* red = (LAS f32x4*)lds;
            red[wave * 64 + lane] = a;
            __syncthreads();
            if (wave == 0) {
#pragma unroll
                for (int w8 = 1; w8 < 8; ++w8) a += red[w8 * 64 + lane];
#pragma unroll
                for (int e = 0; e < 4; ++e) { const int row = 4 * (lane >> 4) + e, col = cb * 16 + (lane & 15); const float h = args.in[I_META][row * D + col] + 0.5f * a[e];
                    XBM2[row * D + col] = (bf16)f2bf(h); float s = h * h; s += __shfl_xor(s, 1); s += __shfl_xor(s, 2); s += __shfl_xor(s, 4); s += __shfl_xor(s, 8);
                    if ((lane & 15) == 0) atomicAdd(ssqm1 + row, s); }
            }
            __syncthreads();
        }
        pg8::Gemm g{TB, W1D, M, D, FF}; pg8::StaticOrder S; S.init(M, D, G, bx);
        EpiRes E{x, out, XB, ssq1, 0.5f, 0, 0};
        pg8::gemm_phase<EpiRes, pg8::StaticOrder, PG8_ALIGN, PG8_SP2>(lds, g, S, E);
    }
    xcd_barrier(xbar);

    {
        const int mw3 = (G == 256) ? (bx >= 128 ? (bx - 128) * NWAVES + wave : (1 << 30)) : gw, ms3 = (G == 256) ? 128 * NWAVES : NGW;
        for (int cb = mw3; cb < NIN / 16; cb += ms3) {
            const f32x4 a = mm16(XBM2, D, WIN + (size_t)cb * 16 * D, D, D, lane);
#pragma unroll
            for (int e = 0; e < 4; ++e) { const int row = 4 * (lane >> 4) + e, col = cb * 16 + (lane & 15); const float rs = rsqrtf(ssqm1[row] * (1.0f / D) + NORM_EPS);
                const bf16 v = (bf16)f2bf(a[e] * rs);
#pragma unroll
                for (int b = 0; b < BATCH; ++b) { const int pr = b * LP + row; if (col < DAW) UDA[(size_t)pr * DAW + col] = v; else URW[(size_t)pr * RWW + col - DAW] = v; } }
        }
        pg8::Gemm g{XB, WIN, M, NINP, D}; pg8::StaticOrder S; S.init(M, NINP, G, bx);
        EpiU E{UDA, URW, ssq1};
        pg8::gemm_phase<EpiU, pg8::StaticOrder, PG8_ALIGN, PG8_SP2>(lds, g, S, E);
    }
    xcd_barrier(xbar);

    {
        {
            const int e8 = lane & 7, d0 = e8 * 8, grp = lane >> 3, hh = grp >> 1, cc = grp & 1;
            float qn[8], kn[8];
#pragma unroll
            for (int j = 0; j < 8; ++j) { qn[j] = args.in[I_QN][d0 + j]; kn[j] = args.in[I_KN][d0 + j]; }
            float kmix[8], kkc8[8];
#pragma unroll
            for (int j = 0; j < 8; ++j) { kmix[j] = args.in[I_SHIFT][512 + 8 * lane + j]; kkc8[j] = args.in[I_KK][8 * lane + j]; }
            const double invf[8] = {1.0, 0.19392274474868576, 0.03760603093086393, 0.007292664737217109, 0.001414213562373095, 0.0002742481756762073, 5.318295896944988e-05, 1.031338537721246e-05};
            for (int pr = gw; pr < PR; pr += NGW) {
                const int b = pr / LP, p = pr - b * LP;
                const bf16* urow = UDA + (size_t)pr * DAW;
                float q[8], k[8];
                unpack8(*(const u32x4*)(urow + 8 * lane), q); unpack8(*(const u32x4*)(urow + 512 + 8 * lane), k);
                float sq = 0.f, sk = 0.f;
#pragma unroll
                for (int j = 0; j < 8; ++j) { sq += q[j] * q[j]; sk += k[j] * k[j]; }
                sq += __shfl_xor(sq, 1); sq += __shfl_xor(sq, 2); sq += __shfl_xor(sq, 4);
                sk += __shfl_xor(sk, 1); sk += __shfl_xor(sk, 2); sk += __shfl_xor(sk, 4);
                const float rq = rsqrtf(sq * (1.0f / 64) + NORM_EPS), rk = rsqrtf(sk * (1.0f / 64) + NORM_EPS);
#pragma unroll
                for (int j = 0; j < 8; ++j) { q[j] *= rq * qn[j]; k[j] *= rk * kn[j]; }
#pragma unroll
                for (int j = 0; j < 8; ++j) {
                    const float qo = __shfl_xor(q[j], 1), ko = __shfl_xor(k[j], 1);
                    if (e8 < 2) {
                        double rev = (double)p * invf[j] * 0.15915494309189535; rev -= floor(rev);
                        const float rf = (float)rev, cs = __builtin_amdgcn_cosf(rf), sn = __builtin_amdgcn_sinf(rf);
                        if (e8 == 0) { q[j] = q[j] * cs - qo * sn; k[j] = k[j] * cs - ko * sn; }
                        else         { q[j] = q[j] * cs + qo * sn; k[j] = k[j] * cs + ko * sn; }
                    }
                }
#pragma unroll
                for (int j = 0; j < 8; ++j) q[j] *= 0.18033688011112042f;
                const size_t o = ((size_t)(b * 4 + hh) * VP + p) * 128 + cc * 64 + d0;
                *(u32x4*)(Qb + o) = pack8(q); *(u32x4*)(Kb + o) = pack8(k);
                {
                    const bf16* rrow = URW + (size_t)pr * RWW + 512 + 8 * lane;
                    float kc[8], kp8[8];
                    unpack8(*(const u32x4*)rrow, kc);
                    if (p > 0) unpack8(*(const u32x4*)(rrow - RWW), kp8); else {
#pragma unroll
                        for (int j = 0; j < 8; ++j) kp8[j] = 0.f; }
                    float ss = 0.f;
#pragma unroll
                    for (int j = 0; j < 8; ++j) { const float kv = (kc[j] + (kp8[j] - kc[j]) * kmix[j]) * kkc8[j]; ss += kv * kv; }
                    ss += __shfl_xor(ss, 1); ss += __shfl_xor(ss, 2); ss += __shfl_xor(ss, 4);
                    if (e8 == 0) INV[(size_t)pr * 8 + grp] = 1.0f / fmaxf(sqrtf(ss), 1e-12f);
                }
            }
        }
        {
            LAS unsigned short* tile = (LAS unsigned short*)lds;
            for (int it = bx; it < BATCH * (VP / 64); it += G) {
                const int b = it / (VP / 64), p0 = (it % (VP / 64)) * 64;
#pragma unroll
                for (int i = 0; i < 8; ++i) {
                    const int id = tid + NTHR * i, row = id >> 6, c16 = id & 63;
                    u32x4 v = {0u, 0u, 0u, 0u};
                    if (p0 + row < LP) v = *(const u32x4*)(UDA + (size_t)(b * LP + p0 + row) * DAW + 1024 + c16 * 8);
                    *(LAS u32x4*)(tile + row * 520 + c16 * 8) = v;
                }
                __syncthreads();
                {
                    unsigned w[32];
#pragma unroll
                    for (int pp = 0; pp < 32; ++pp) w[pp] = (unsigned)tile[(2 * pp) * 520 + tid] | ((unsigned)tile[(2 * pp + 1) * 520 + tid] << 16);
                    u32x4* dst = (u32x4*)(Vt + ((size_t)(b * 4 + (tid >> 7)) * 128 + (tid & 127)) * VP + p0);
#pragma unroll
                    for (int i = 0; i < 8; ++i) { u32x4 o; o.x = w[4 * i]; o.y = w[4 * i + 1]; o.z = w[4 * i + 2]; o.w = w[4 * i + 3]; dst[i] = o; }
                }
                __syncthreads();
            }
        }
        {
            const int r16 = lane & 15, q4 = lane >> 4;
            const float* mixp = args.in[I_SHIFT];
            for (int it2 = wave * G + bx; it2 < 2 * (PR / 16); it2 += NGW) {
                const int rg = it2 >> 1, cb0 = (it2 & 1) * 16;
                const int pr = rg * 16 + r16, p = pr % LP;
                const bf16* cur = URW + (size_t)pr * RWW; const bf16* prv = cur - RWW;
                bf16x8 Aw[2], Aa[2], Ag[5];
#pragma unroll
                for (int s = 0; s < 9; ++s) {
                    const int col = (s < 2) ? (1536 + 32 * s + 8 * q4) : (s < 4) ? (1600 + 32 * (s - 2) + 8 * q4) : (1664 + 32 * (s - 4) + 8 * q4);
                    float c8[8], p8[8];
                    unpack8(*(const u32x4*)(cur + col), c8);
                    if (p > 0) unpack8(*(const u32x4*)(prv + col), p8); else {
#pragma unroll
                        for (int j = 0; j < 8; ++j) p8[j] = 0.f; }
#pragma unroll
                    for (int j = 0; j < 8; ++j) { float v = c8[j] + (p8[j] - c8[j]) * mixp[col + j];
                        if (s < 2) v = tanhf(v); else if (s >= 4) v = sigmoidf_(v);
                        c8[j] = v; }
                    const u32x4 w = pack8(c8); const bf16x8 f = __builtin_bit_cast(bf16x8, w);
                    if (s < 2) Aw[s] = f; else if (s < 4) Aa[s - 2] = f; else Ag[s - 4] = f;
                }
                for (int cb = cb0; cb < cb0 + 16; ++cb) {
                    const int n = cb * 16 + r16;
                    f32x4 aw = {0.f, 0.f, 0.f, 0.f}, aa = aw, ag = aw;
#pragma unroll
                    for (int s = 0; s < 2; ++s) { aw = mfma16(Aw[s], *(const bf16x8*)(W2T + n * 64 + 32 * s + 8 * q4), aw); aa = mfma16(Aa[s], *(const bf16x8*)(A2T + n * 64 + 32 * s + 8 * q4), aa); }
#pragma unroll
                    for (int s = 0; s < 5; ++s) ag = mfma16(Ag[s], *(const bf16x8*)(G2T + n * 160 + 32 * s + 8 * q4), ag);
                    const float w0 = args.in[I_W0][n], a0 = args.in[I_A0][n];
#pragma unroll
                    for (int e = 0; e < 4; ++e) {
                        const size_t o = (size_t)(rg * 16 + 4 * q4 + e) * 512 + n;
                        Eb[o] = (bf16)f2bf(0.6065306597126334f * sigmoidf_(w0 + aw[e]));
                        Ab[o] = (bf16)f2bf(sigmoidf_(a0 + aa[e]));
                        Gb[o] = (bf16)f2bf(ag[e]);
                    }
                }
            }
        }
    }
    xcd_barrier(xbar);

    {
        if (bx < 64) {
            const int chain = bx >> 2, quarter = bx & 3, b = chain >> 3, h = chain & 7;
            constexpr int SC2 = 16, OPF = 320, NC2 = LP / SC2;
            static_assert(NC2 * SC2 == LP && (NC2 & 1) == 1, "chunking");
            LAS float* OP = (LAS float*)lds;
            LAS unsigned short* RB = (LAS unsigned short*)(lds + 40960);
            LAS unsigned char* SP = lds + 45056;
            if (wave >= 4) {
                const int lw = wave - 4, li = lane >> 4, lq = lane & 15, c4 = h * 64 + 4 * lq;
                const float* mixp = args.in[I_SHIFT];
                const f32x4 mix_r = *(const f32x4*)(mixp + c4), mix_k = *(const f32x4*)(mixp + 512 + c4), mix_v = *(const f32x4*)(mixp + 1024 + c4);
                const f32x4 kkc = *(const f32x4*)(args.in[I_KK] + c4), kac = *(const f32x4*)(args.in[I_KA] + c4);
                struct LSet { u32x2 rc, rp, kc, kp, vc, vp, e, a; float iv; };
                LSet s0, s1;
                const bf16* ubase = URW + (size_t)b * LP * RWW + c4; const bf16* ebase = Eb + (size_t)b * LP * 512 + c4; const bf16* abase = Ab + (size_t)b * LP * 512 + c4; const float* ibase = INV + (size_t)b * LP * 8 + h;
                bf16* ybase = Y + (size_t)b * T * 512 + h * 64 + 16 * quarter + 4 * (lane >> 4);
                unsigned* halfflag = (unsigned*)(sm + SM_BAR) + SUBW + 64 * 7;
#define UNPK4_(w_) ((f32x4){bflo((w_).x), bfhi((w_).x), bflo((w_).y), bfhi((w_).y)})
#define SCAN_LOAD(S_, c_) do { const int p_ = (c_) * SC2 + 4 * lw + li; const int pm_ = p_ > 0 ? p_ - 1 : 0; const bf16* u_ = ubase + (size_t)p_ * RWW; const bf16* um_ = ubase + (size_t)pm_ * RWW; \
        S_.rc = *(const u32x2*)u_; S_.kc = *(const u32x2*)(u_ + 512); S_.vc = *(const u32x2*)(u_ + 1024); S_.rp = *(const u32x2*)um_; S_.kp = *(const u32x2*)(um_ + 512); S_.vp = *(const u32x2*)(um_ + 1024); \
        S_.e = *(const u32x2*)(ebase + (size_t)p_ * 512); S_.a = *(const u32x2*)(abase + (size_t)p_ * 512); S_.iv = ibase[(size_t)p_ * 8]; } while (0)
#define SCAN_PROC(S_, c_) do { const int p_ = (c_) * SC2 + 4 * lw + li; const float pz_ = p_ == 0 ? 0.f : 1.f;     \
        const f32x4 rc_ = UNPK4_(S_.rc), kc_ = UNPK4_(S_.kc), vc_ = UNPK4_(S_.vc), rp_ = UNPK4_(S_.rp) * pz_, kq_ = UNPK4_(S_.kp) * pz_, vp_ = UNPK4_(S_.vp) * pz_, e_ = UNPK4_(S_.e), a_ = UNPK4_(S_.a); \
        const f32x4 r_ = rc_ + (rp_ - rc_) * mix_r, k_ = kc_ + (kq_ - kc_) * mix_k, v_ = vc_ + (vp_ - vc_) * mix_v; \
        const f32x4 kk_ = k_ * kkc * S_.iv, kpv_ = k_ * ((a_ - 1.0f) * kac + 1.0f); \
        const f32x4 w_ = {__expf(-e_.x), __expf(-e_.y), __expf(-e_.z), __expf(-e_.w)}; \
        LAS float* dst_ = OP + ((c_) & 1) * (SC2 * OPF) + (4 * lw + li) * OPF + 4 * lq; \
        *(LAS f32x4*)dst_ = w_; *(LAS f32x4*)(dst_ + 64) = -kk_; *(LAS f32x4*)(dst_ + 128) = kk_ * a_; *(LAS f32x4*)(dst_ + 192) = kpv_; *(LAS f32x4*)(dst_ + 256) = v_; \
        *(LAS u32x2*)(RB + ((c_) & 1) * (SC2 * 64) + (4 * lw + li) * 64 + 4 * lq) = (u32x2){pk2(r_.x, r_.y), pk2(r_.z, r_.w)}; } while (0)
#define SCAN_YPASS(c_) do { _Pragma("unroll") for (int i_ = 0; i_ < 4; ++i_) { const int st_ = 4 * lw + i_, p_ = (c_) * SC2 + st_; \
        const LAS unsigned char* sp_ = SP + ((c_) & 1) * 36864 + (st_ * 16 + (lane & 15)) * 144 + 16 * (lane >> 4); const LAS unsigned short* rb_ = RB + ((c_) & 1) * (SC2 * 64) + st_ * 64 + 8 * (lane >> 4); \
        f32x4 acc_ = {0.f, 0.f, 0.f, 0.f}; \
        acc_ = mfma16(*(const LAS bf16x8*)sp_, *(const LAS bf16x8*)rb_, acc_); acc_ = mfma16(*(const LAS bf16x8*)(sp_ + 64), *(const LAS bf16x8*)(rb_ + 32), acc_); \
        if ((lane & 15) == 0 && p_ >= NMETA) *(u32x2*)(ybase + (size_t)(p_ - NMETA) * 512) = (u32x2){pk2(acc_.x, acc_.y), pk2(acc_.z, acc_.w)}; } } while (0)
                SCAN_LOAD(s0, 0); SCAN_LOAD(s1, 1); SCAN_PROC(s0, 0); SCAN_LOAD(s0, 2);
                __syncthreads();
                for (int c = 0; c < NC2; c += 2) {
                    if (c == 258 && wave == 4 && lane == 0) {
                        __builtin_amdgcn_fence(__ATOMIC_RELEASE, "agent"); asm volatile("s_waitcnt vmcnt(0)" ::: "memory");
                        __hip_atomic_fetch_add(halfflag, 1u, __ATOMIC_RELAXED, __HIP_MEMORY_SCOPE_AGENT);
                    }
                    if (c >= 1) SCAN_YPASS(c - 1);
                    if (c + 1 < NC2) { SCAN_PROC(s1, c + 1); if (c + 3 < NC2) SCAN_LOAD(s1, c + 3); }
                    __syncthreads();
                    if (c + 1 < NC2) {
                        SCAN_YPASS(c);
                        if (c == 256) asm volatile("s_waitcnt vmcnt(0)" ::: "memory");
                        if (c + 2 < NC2) { SCAN_PROC(s0, c + 2); if (c + 4 < NC2) SCAN_LOAD(s0, c + 4); }
                        __syncthreads();
                    }
                }
                SCAN_YPASS(NC2 - 1);
#undef SCAN_LOAD
#undef UNPK4_
#undef SCAN_PROC
#undef SCAN_YPASS
            } else {
                const int rr = lane >> 4, kq = lane & 15, vrow = 16 * quarter + 4 * wave + rr;
                f32x4 S = {0.f, 0.f, 0.f, 0.f};
                __builtin_amdgcn_s_setprio(3);
                __syncthreads();
                for (int c = 0; c < NC2; ++c) {
                    const LAS float* cb = OP + (c & 1) * (SC2 * OPF);
                    LAS unsigned char* spw = SP + (c & 1) * 36864 + (4 * wave + rr) * 144 + 8 * kq;
                    f32x4 w = ((const LAS f32x4*)cb)[kq], an = ((const LAS f32x4*)(cb + 64))[kq], bv = ((const LAS f32x4*)(cb + 128))[kq], kp = ((const LAS f32x4*)(cb + 192))[kq];
                    float vv = cb[256 + vrow];
#define SB_ __builtin_amdgcn_sched_barrier(0)
#pragma unroll
                    for (int st = 0; st < SC2; ++st) {
                        const bool more = st + 1 < SC2;
                        const LAS float* sp = cb + (more ? st + 1 : st) * OPF;
                        f32x4 nw = w, nan_ = an, nbv = bv, nkp = kp; float nvv = vv;
                        f32x2 t = S.zw * an.zw; SB_;
                        t = S.xy * an.xy + t; SB_;
                        f32x2 u01 = kp.xy * vv; SB_;
                        float x = t.x + t.y; SB_;
                        f32x2 u23 = kp.zw * vv; SB_;
                        u01 = S.xy * w.xy + u01; SB_;
                        x += dpp_f(x, 0); SB_;
                        u23 = S.zw * w.zw + u23; SB_;
                        if (more) nw = ((const LAS f32x4*)sp)[kq]; SB_;
                        x += dpp_f(x, 1); SB_;
                        if (more) nan_ = ((const LAS f32x4*)(sp + 64))[kq]; SB_;
                        if (more) nbv = ((const LAS f32x4*)(sp + 128))[kq]; SB_;
                        x += dpp_f(x, 2); SB_;
                        if (more) nkp = ((const LAS f32x4*)(sp + 192))[kq]; SB_;
                        if (more) nvv = sp[256 + vrow]; SB_;
                        x += dpp_f(x, 3); SB_;
                        S.xy = bv.xy * x + u01; SB_;
                        S.zw = bv.zw * x + u23; SB_;
                        *(LAS u32x2*)(spw + st * 2304) = (u32x2){pk2(S.x, S.y), pk2(S.z, S.w)}; SB_;
                        w = nw; an = nan_; bv = nbv; kp = nkp; vv = nvv;
                    }
#undef SB_
                    __syncthreads();
                }
                __builtin_amdgcn_s_setprio(0);
            }
            __syncthreads();
        }
        if (bx >= 64) {
            const float lam = misc[0];
            LAS unsigned* shu = (LAS unsigned*)(lds + LDS_MISC);
            const int c = wave >> 2, qg = wave & 3, r32 = lane & 31, hh = lane >> 5;
            for (;;) {
                if (tid == 0) shu[0] = atomicAdd(qctr, 1u);
                __syncthreads();
                const unsigned un = shu[0];
                if (un >= 512u) break;
                const int qi = (un < 256u) ? 31 - (int)(un >> 3) : 63 - (int)((un - 256u) >> 3), bh = (int)(un & 7u), b = bh >> 2, h = bh & 3;
                const int qbase = NMETA + 128 * qi + 32 * qg, qpos = qbase + r32;
                const bf16* qrow = Qb + ((size_t)bh * VP + qpos) * 128 + c * 64 + 8 * hh;
                bf16x8 qf[4];
#pragma unroll
                for (int s = 0; s < 4; ++s) qf[s] = *(const bf16x8*)(qrow + 16 * s);
                f32x16 o[4];
#pragma unroll
                for (int d = 0; d < 4; ++d)
#pragma unroll
                    for (int e = 0; e < 16; ++e) o[d][e] = 0.f;
                float mrun = -1e30f, lsum = 0.f;
                const int ntiles = 2 * qi + 3;
                const bf16* ksrc[2]; const bf16* vsrc[2]; int kdst[2], vdst[2];
#pragma unroll
                for (int ii = 0; ii < 2; ++ii) { const int id = tid + NTHR * ii;
                    ksrc[ii] = Kb + ((size_t)bh * VP + (id >> 4)) * 128 + (id & 15) * 8; kdst[ii] = (id >> 4) * 272 + (id & 15) * 16;
                    vsrc[ii] = Vt + ((size_t)bh * 128 + (id >> 3)) * VP + (id & 7) * 8; vdst[ii] = ATT_KB + (id >> 3) * 136 + (id & 7) * 16; }
                u32x4 kr[2], vr[2];
#define ATT_LOAD(j_) do { _Pragma("unroll") for (int ii = 0; ii < 2; ++ii) { kr[ii] = *(const u32x4*)(ksrc[ii] + (size_t)(j_) * 64 * 128); vr[ii] = *(const u32x4*)(vsrc[ii] + (j_) * 64); } } while (0)
#define ATT_WRITE(j_) do { LAS unsigned char* bb_ = lds + ((j_) & 1) * ATT_BUF; _Pragma("unroll") for (int ii = 0; ii < 2; ++ii) { *(LAS u32x4*)(bb_ + kdst[ii]) = kr[ii]; \
        *(LAS u32x2*)(bb_ + vdst[ii]) = (u32x2){vr[ii].x, vr[ii].y}; *(LAS u32x2*)(bb_ + vdst[ii] + 8) = (u32x2){vr[ii].z, vr[ii].w}; } } while (0)
                ATT_LOAD(0); ATT_WRITE(0);
                __syncthreads();
                for (int j = 0; j < ntiles; ++j) {
                    if (j + 1 < ntiles) ATT_LOAD(j + 1);
                    if (64 * j <= qbase + 31) {
                        const LAS unsigned char* kb_ = lds + (j & 1) * ATT_BUF + r32 * 272 + c * 128 + hh * 16;
                        const LAS unsigned char* vb_ = lds + (j & 1) * ATT_BUF + ATT_KB + r32 * 136 + hh * 8;
                        f32x16 s0, s1;
#pragma unroll
                        for (int e = 0; e < 16; ++e) { s0[e] = 0.f; s1[e] = 0.f; }
#pragma unroll
                        for (int s = 0; s < 4; ++s) { s0 = mfma32(*(const LAS bf16x8*)(kb_ + s * 32), qf[s], s0); s1 = mfma32(*(const LAS bf16x8*)(kb_ + 32 * 272 + s * 32), qf[s], s1); }
                        if (64 * j + 63 > qbase) {
#pragma unroll
                            for (int e = 0; e < 16; ++e) { const int key = 64 * j + (e & 3) + 8 * (e >> 2) + 4 * hh; if (key > qpos) s0[e] = -1e30f; if (key + 32 > qpos) s1[e] = -1e30f; }
                        }
                        float tm = fmaxf(s0[0], s1[0]);
#pragma unroll
                        for (int e = 1; e < 16; ++e) tm = fmaxf(tm, fmaxf(s0[e], s1[e]));
                        tm = fmaxf(tm, __shfl_xor(tm, 32));
                        const float mnew = fmaxf(mrun, tm), alpha = __builtin_amdgcn_exp2f(mrun - mnew); mrun = mnew;
                        float rsum = 0.f;
#pragma unroll
                        for (int e = 0; e < 16; ++e) { s0[e] = __builtin_amdgcn_exp2f(s0[e] - mnew); s1[e] = __builtin_amdgcn_exp2f(s1[e] - mnew); rsum += s0[e] + s1[e]; }
                        lsum = lsum * alpha + rsum;
                        if (__builtin_amdgcn_ballot_w64(alpha != 1.0f) != 0ull) {
#pragma unroll
                            for (int d = 0; d < 4; ++d) o[d] = o[d] * alpha;
                        }
                        bf16x8 pf[4];
#pragma unroll
                        for (int s = 0; s < 4; ++s) { u32x4 w;
                            if (s < 2) { w.x = pk2(s0[8 * s], s0[8 * s + 1]); w.y = pk2(s0[8 * s + 2], s0[8 * s + 3]); w.z = pk2(s0[8 * s + 4], s0[8 * s + 5]); w.w = pk2(s0[8 * s + 6], s0[8 * s + 7]); }
                            else { const int t = s - 2; w.x = pk2(s1[8 * t], s1[8 * t + 1]); w.y = pk2(s1[8 * t + 2], s1[8 * t + 3]); w.z = pk2(s1[8 * t + 4], s1[8 * t + 5]); w.w = pk2(s1[8 * t + 6], s1[8 * t + 7]); }
                            pf[s] = __builtin_bit_cast(bf16x8, w); }
#pragma unroll
                        for (int d = 0; d < 4; ++d)
#pragma unroll
                            for (int s = 0; s < 4; ++s) {
                                const u32x2 lo = *(const LAS u32x2*)(vb_ + d * 32 * 136 + s * 32), hi = *(const LAS u32x2*)(vb_ + d * 32 * 136 + s * 32 + 16);
                                const u32x4 vv = {lo.x, lo.y, hi.x, hi.y};
                                o[d] = mfma32(__builtin_bit_cast(bf16x8, vv), pf[s], o[d]);
                            }
                    }
                    if (j + 1 < ntiles) ATT_WRITE(j + 1);
                    __syncthreads();
                }
#undef ATT_LOAD
#undef ATT_WRITE
                lsum += __shfl_xor(lsum, 32);
                const float inv = 1.0f / lsum;
                LAS float* X = (LAS float*)lds;
                if (c == 1) {
#pragma unroll
                    for (int d = 0; d < 4; ++d)
#pragma unroll
                        for (int e = 0; e < 16; ++e) X[((qg * 4 + d) * 16 + e) * 64 + lane] = o[d][e] * inv;
                }
                __syncthreads();
                if (c == 0) {
                    float sq = 0.f;
#pragma unroll
                    for (int d = 0; d < 4; ++d)
#pragma unroll
                        for (int e = 0; e < 16; ++e) { const float v = o[d][e] * inv - lam * X[((qg * 4 + d) * 16 + e) * 64 + lane]; o[d][e] = v; sq += v * v; }
                    sq += __shfl_xor(sq, 32);
                    const float rn = rsqrtf(sq * (1.0f / 128) + NORM_EPS) * 0.8f;
                    bf16* orow = XB + (size_t)(b * T + 128 * qi + 32 * qg + r32) * D + h * 128;
#pragma unroll
                    for (int d = 0; d < 4; ++d)
#pragma unroll
                        for (int g4 = 0; g4 < 4; ++g4) {
                            const int dv0 = 32 * d + 8 * g4 + 4 * hh;
                            const f32x4 sl = *(const f32x4*)(args.in[I_SUBLN] + dv0);
                            u32x2 w; w.x = pk2(o[d][4 * g4] * rn * sl.x, o[d][4 * g4 + 1] * rn * sl.y); w.y = pk2(o[d][4 * g4 + 2] * rn * sl.z, o[d][4 * g4 + 3] * rn * sl.w);
                            *(u32x2*)(orow + dv0) = w;
                        }
                }
                __syncthreads();
            }
        }
        if (bx >= 64) {
            LAS float* scr = (LAS float*)(lds + wave * 16640);
            constexpr int IT_G = (D / 64) * (FF / 64), IT_D = (FF / 64) * (D / 64), NIT = 2 * IT_G + IT_D;
            for (int it = (bx - 64) * NWAVES + wave; it < NIT; it += (G - 64) * NWAVES) {
                int r = it;
                if (r < IT_G) { transpose_item(args.in[I_F2G], D, FF, W2A, args.in[I_F2N], 1, scr, r, lane); continue; } r -= IT_G;
                if (r < IT_G) { transpose_item(args.in[I_F2U], D, FF, W2A, args.in[I_F2N], 2, scr, r, lane); continue; } r -= IT_G;
                transpose_item(args.in[I_F2D], FF, D, W2D, nullptr, 0, scr, r, lane);
            }
            unsigned* subw = (unsigned*)(sm + SM_BAR) + SUBW;
            XcdBarrier xsub; xsub.bar = (unsigned*)(sm + SM_BAR) + 4096; xsub.x = xbar.x; xsub.st = (volatile LAS unsigned*)(lds + LDS_MISC + 72); const unsigned GS = (unsigned)(G - 64);
            xcd_barrier(xsub, GS);
            wait_flag(subw + 64 * 7, 64u);
            TAIL_HALF(0, G - 64, bx - 64, xcd_barrier(xsub, GS), xcd_barrier(xsub, GS), xcd_barrier(xsub, GS));
        }
    }
    xcd_barrier(xbar);

    TAIL_HALF(1, G, bx, xcd_barrier(xbar), xcd_barrier(xbar), xcd_barrier(xbar));
}

extern "C" void kernel_launch(void* const* d_in, const int* in_sizes, int n_in, void* d_out, int out_size, void* d_ws, size_t ws_size, hipStream_t stream) {
    static int grid = 0;
    if (grid == 0) {
        if (n_in != 31 || out_size != M * D || ws_size < WS_END) { fprintf(stderr, "kernel_launch: unexpected shapes (n_in %d out %d ws %zu)\n", n_in, out_size, ws_size); grid = -1; return; }
        int dev = 0, cus = 0, per_cu = 0;
        (void)hipGetDevice(&dev); (void)hipDeviceGetAttribute(&cus, hipDeviceAttributeMultiprocessorCount, dev);
        if (hipFuncSetAttribute((const void*)fwd_kernel, hipFuncAttributeMaxDynamicSharedMemorySize, LDS_BYTES) != hipSuccess) { fprintf(stderr, "kernel_launch: hipFuncSetAttribute failed\n"); grid = -1; return; }
        if (hipOccupancyMaxActiveBlocksPerMultiprocessor(&per_cu, (const void*)fwd_kernel, NTHR, LDS_BYTES) != hipSuccess || per_cu < 1) { fprintf(stderr, "kernel_launch: occupancy query says %d\n", per_cu); per_cu = 1; }
        (void)hipGetLastError();
        grid = cus;
        if (grid > cus * per_cu) grid = cus * per_cu;
        if (grid > 256) grid = 256;
    }
    if (grid < 0) return;
    Args a{};
    for (int i = 0; i < 31; ++i) a.in[i] = (const float*)d_in[i];
    a.out = (float*)d_out; a.ws = (unsigned char*)d_ws;
    (void)hipMemsetAsync((unsigned char*)d_ws + WS_SMALL + SM_BAR, 0, 32768, stream);
    void* kargs[] = {&a};
    hipError_t e = hipLaunchCooperativeKernel((const void*)fwd_kernel, dim3(grid), dim3(NTHR), kargs, LDS_BYTES, stream);
    if (e != hipSuccess) fprintf(stderr, "cooperative launch failed: %s (grid %d)\n", hipGetErrorString(e), grid);
}
```

```cpp
#include <hip/hip_runtime.h>
#include <hip/hip_cooperative_groups.h>
#include <cstdio>
#include <cstdint>
namespace cg = cooperative_groups;
namespace pg8 {
#define PG8_LAS __attribute__((address_space(3)))
typedef unsigned short bf16_t;
typedef short bf16x8 __attribute__((ext_vector_type(8)));
typedef float f32x4 __attribute__((ext_vector_type(4)));
typedef unsigned u32x4 __attribute__((ext_vector_type(4)));
constexpr int BM = 256, BK = 64, HALF = 128, HTB = HALF * BK * 2  , STAGE_BYTES = 8 * HTB, NXCD = 8, WGM = 8;

__host__ __device__ __forceinline__ int lds_byte(int r, int c) { const int st = (r >> 4) * 2 + (c >> 5), rr = r & 15, cc = c & 31, ob = rr * 64 + cc * 2; return st * 1024 + (ob ^ (((ob >> 9) & 1) << 5)); }
__host__ __device__ __forceinline__ void stage_rc(int b, int& R, int& C) { const int st = b / 1024, sb = b % 1024, swz = sb ^ (((sb >> 9) & 1) << 5); R = (st >> 1) * 16 + swz / 64; C = (st & 1) * 32 + (swz % 64) / 2; }
__host__ __device__ __forceinline__ int perm32(int rho) { const int n = rho >> 4, i = rho & 15; return 8 * (i >> 2) + 4 * n + (i & 3); }

struct Unit { int pm, pn; };
struct Gemm { const bf16_t* A; const bf16_t* Bt; int M, N, K; };

struct StaticOrder {
    int nM, nN, nwg, G, c;
    __host__ __device__ void init(int M, int N, int G_, int c_) { nM = M / BM; nN = N / BM; nwg = nM * nN; G = G_; c = c_; }
    __host__ __device__ bool next(int i, Unit& u) const {
        const long L = (long)i * G + c; if (L >= nwg) return false;
        int wgid = (int)L; { const int q = nwg / NXCD, r = nwg % NXCD, xcd = wgid % NXCD, off = wgid / NXCD; wgid = (xcd < r ? xcd * (q + 1) : r * (q + 1) + (xcd - r) * q) + off; }
        const int nig = WGM * nN, gid = wgid / nig, fm = gid * WGM, gsz = (nM - fm) < WGM ? (nM - fm) : WGM;
        u.pm = fm + ((wgid % nig) % gsz); u.pn = (wgid % nig) / gsz; return true;
    }
    __device__ __forceinline__ void a_ready(const Unit&) const {}
    __device__ __forceinline__ void done(const Unit&) const {}
};
__device__ __forceinline__ unsigned cvt_pk_bf16(float lo, float hi) { unsigned r; asm volatile("v_cvt_pk_bf16_f32 %0, %1, %2" : "=v"(r) : "v"(lo), "v"(hi)); return r; }
template <class Epi, class Sched, bool ALIGN_EPI = false, bool SP2 = false>
__device__ __forceinline__ void gemm_phase(PG8_LAS unsigned char* lds, const Gemm g, const Sched& S, const Epi& E) {
    const int tid = threadIdx.x, wid = __builtin_amdgcn_readfirstlane(tid >> 6), lane = tid & 63, wr = wid >> 2, wc = wid & 3, fr = lane & 15, fq = lane >> 4;
    const int K = g.K, nt = K / BK;
    unsigned voffA[2], voffB[2];
#pragma unroll
    for (int i = 0; i < 2; ++i) { int R, C; stage_rc(tid * 16 + i * 8192, R, C); const int Rb = Epi::PERM ? ((R & ~31) + perm32(R & 31)) : R;
        voffA[i] = (unsigned)(R * K + C) * 2u; voffB[i] = (unsigned)(Rb * K + C) * 2u; }
    const size_t kstep = (size_t)(BK * 2);
    const size_t hstep = (size_t)HALF * K * 2;
    const size_t tstep = 2 * hstep;
    const unsigned ldsw = (unsigned)wid * 1024u;
    const int aoff = lds_byte(wr * 64 + fr, fq * 8), boff = lds_byte(wc * 32 + fr, fq * 8);
#define PG8_SA(b, h) (((b) * 2 + (h)) * HTB)
#define PG8_SB(b, h) ((4 + (b) * 2 + (h)) * HTB)
#define PG8_STAGE(bufoff, gbase, voff) do { _Pragma("unroll") for (int _i = 0; _i < 2; ++_i) \
        __builtin_amdgcn_global_load_lds((const unsigned*)((const char*)(gbase) + (voff)[_i]), (PG8_LAS unsigned*)(lds + (bufoff) + ldsw + _i * 8192), 16, 0, 0); } while (0)
#define PG8_LDA(dst, b, h) do { _Pragma("unroll") for (int m = 0; m < 4; ++m) _Pragma("unroll") for (int k = 0; k < 2; ++k) dst[m][k] = *(const PG8_LAS bf16x8*)(lds + PG8_SA(b, h) + aoff + m * 2048 + k * 1024); } while (0)
#define PG8_LDB(dst, b, h) do { _Pragma("unroll") for (int n = 0; n < 2; ++n) _Pragma("unroll") for (int k = 0; k < 2; ++k) dst[n][k] = *(const PG8_LAS bf16x8*)(lds + PG8_SB(b, h) + boff + n * 2048 + k * 1024); } while (0)
#define PG8_MMA(ai, bj, At, Bt) do { __builtin_amdgcn_s_setprio(1); _Pragma("unroll") for (int m = 0; m < 4; ++m) _Pragma("unroll") for (int n = 0; n < 2; ++n) _Pragma("unroll") for (int k = 0; k < 2; ++k) \
        acc[ai][bj][m][n] = __builtin_amdgcn_mfma_f32_16x16x32_bf16(Bt[n][k], At[m][k], acc[ai][bj][m][n], 0, 0, 0); __builtin_amdgcn_s_setprio(0); } while (0)
#define PG8_WAIT_V(n) asm volatile("s_waitcnt vmcnt(" #n ")" ::: "memory")
#define PG8_WAIT_L(n) asm volatile("s_waitcnt lgkmcnt(" #n ")" ::: "memory")
#define PG8_BAR __builtin_amdgcn_s_barrier()
#define PG8_SCHED __builtin_amdgcn_sched_barrier(0)
    Unit cur, nxt; int ui = 0;
    if (!S.next(0, cur)) return;
    f32x4 acc[2][2][4][2];
#pragma unroll
    for (int a = 0; a < 2; ++a)
#pragma unroll
        for (int b = 0; b < 2; ++b)
#pragma unroll
            for (int m = 0; m < 4; ++m)
#pragma unroll
                for (int n = 0; n < 2; ++n) acc[a][b][m][n] = (f32x4){0.f, 0.f, 0.f, 0.f};
    bf16x8 At[4][2], B0[2][2], B1[2][2];
    const char* cA = (const char*)g.A + (size_t)cur.pm * tstep; const char* cB = (const char*)g.Bt + (size_t)cur.pn * tstep;
    S.a_ready(cur);
    if constexpr (SP2) {
        PG8_STAGE(PG8_SB(0, 0), cB, voffB); PG8_STAGE(PG8_SB(0, 1), cB + hstep, voffB); PG8_STAGE(PG8_SA(0, 0), cA, voffA); PG8_STAGE(PG8_SA(0, 1), cA + hstep, voffA);
        if (wr == 1) PG8_BAR;
        PG8_WAIT_V(2); PG8_BAR;
        PG8_STAGE(PG8_SB(1, 0), cB + kstep, voffB); PG8_STAGE(PG8_SA(1, 0), cA + kstep, voffA); PG8_STAGE(PG8_SB(1, 1), cB + hstep + kstep, voffB);
        PG8_WAIT_V(6); PG8_BAR;
    } else {
        PG8_STAGE(PG8_SB(0, 0), cB, voffB); PG8_STAGE(PG8_SA(0, 0), cA, voffA); PG8_STAGE(PG8_SB(0, 1), cB + hstep, voffB); PG8_STAGE(PG8_SA(0, 1), cA + hstep, voffA);
        if (wr == 1) PG8_BAR;
        PG8_WAIT_V(4); PG8_BAR;
        PG8_STAGE(PG8_SB(1, 0), cB + kstep, voffB); PG8_STAGE(PG8_SA(1, 0), cA + kstep, voffA); PG8_STAGE(PG8_SB(1, 1), cB + hstep + kstep, voffB);
        PG8_WAIT_V(6); PG8_BAR;
    }
    for (;;) {
        const bool has_next = S.next(ui + 1, nxt);
        const char* nA = has_next ? (const char*)g.A + (size_t)nxt.pm * tstep : cA; const char* nB = has_next ? (const char*)g.Bt + (size_t)nxt.pn * tstep : cB;
        for (int t = 0; t < nt; t += 2) {
            const bool last = (t == nt - 2);
            const char* a1 = cA + (size_t)(t + 1) * kstep;
            const char* a2 = last ? nA : cA + (size_t)(t + 2) * kstep; const char* b2 = last ? nB : cB + (size_t)(t + 2) * kstep;
            const char* a3 = a2 + kstep; const char* b3 = b2 + kstep;
            if (last && has_next) S.a_ready(nxt);
            if constexpr (SP2) {
            PG8_LDB(B0, 0, 0); PG8_LDB(B1, 0, 1); PG8_SCHED; PG8_LDA(At, 0, 0); PG8_STAGE(PG8_SA(1, 1), a1 + hstep, voffA);
            PG8_WAIT_V(8); PG8_WAIT_L(0); PG8_BAR; PG8_MMA(0, 0, At, B0); PG8_MMA(0, 1, At, B1); PG8_BAR; PG8_SCHED;
            PG8_LDA(At, 0, 1); PG8_STAGE(PG8_SB(0, 0), b2, voffB); PG8_STAGE(PG8_SB(0, 1), b2 + hstep, voffB); PG8_STAGE(PG8_SA(0, 0), a2, voffA);
            PG8_WAIT_V(8); PG8_WAIT_L(0); PG8_BAR; PG8_MMA(1, 0, At, B0); PG8_MMA(1, 1, At, B1); PG8_BAR; PG8_SCHED;
            PG8_LDB(B0, 1, 0); PG8_LDB(B1, 1, 1); PG8_SCHED; PG8_LDA(At, 1, 0); PG8_STAGE(PG8_SA(0, 1), a2 + hstep, voffA);
            PG8_WAIT_V(8); PG8_WAIT_L(0); PG8_BAR; PG8_MMA(0, 0, At, B0); PG8_MMA(0, 1, At, B1); PG8_BAR; PG8_SCHED;
            PG8_LDA(At, 1, 1); PG8_STAGE(PG8_SB(1, 0), b3, voffB); PG8_STAGE(PG8_SB(1, 1), b3 + hstep, voffB); PG8_STAGE(PG8_SA(1, 0), a3, voffA);
            PG8_WAIT_V(8); PG8_WAIT_L(0); PG8_BAR; PG8_MMA(1, 0, At, B0); PG8_MMA(1, 1, At, B1); PG8_BAR; PG8_SCHED;
            } else {
            PG8_LDB(B0, 0, 0); PG8_SCHED; PG8_LDA(At, 0, 0); PG8_STAGE(PG8_SA(1, 1), a1 + hstep, voffA);
            PG8_WAIT_L(8); PG8_BAR; PG8_WAIT_L(0); PG8_MMA(0, 0, At, B0); PG8_BAR; PG8_SCHED;
            PG8_LDB(B1, 0, 1); PG8_STAGE(PG8_SB(0, 0), b2, voffB);
            PG8_BAR; PG8_WAIT_L(0); PG8_MMA(0, 1, At, B1); PG8_BAR;
            PG8_LDA(At, 0, 1); PG8_STAGE(PG8_SA(0, 0), a2, voffA);
            PG8_BAR; PG8_WAIT_L(0); PG8_MMA(1, 0, At, B0); PG8_BAR; PG8_SCHED;
            PG8_STAGE(PG8_SB(0, 1), b2 + hstep, voffB);
            PG8_WAIT_V(6); PG8_BAR; PG8_MMA(1, 1, At, B1); PG8_BAR;
            PG8_LDB(B0, 1, 0); PG8_SCHED; PG8_LDA(At, 1, 0); PG8_STAGE(PG8_SA(0, 1), a2 + hstep, voffA);
            PG8_WAIT_L(8); PG8_BAR; PG8_WAIT_L(0); PG8_MMA(0, 0, At, B0); PG8_BAR; PG8_SCHED;
            PG8_LDB(B1, 1, 1); PG8_STAGE(PG8_SB(1, 0), b3, voffB);
            PG8_BAR; PG8_WAIT_L(0); PG8_MMA(0, 1, At, B1); PG8_BAR;
            PG8_LDA(At, 1, 1); PG8_STAGE(PG8_SA(1, 0), a3, voffA);
            PG8_BAR; PG8_WAIT_L(0); PG8_MMA(1, 0, At, B0); PG8_BAR; PG8_SCHED;
            PG8_STAGE(PG8_SB(1, 1), b3 + hstep, voffB);
            PG8_WAIT_V(6); PG8_BAR; PG8_MMA(1, 1, At, B1); PG8_BAR;
            }
        }
        if constexpr (ALIGN_EPI) { if (wr == 0) PG8_BAR; }
        if constexpr (!Epi::AFTER_DRAIN) { E(acc, cur, wr, wc, fr, fq); S.done(cur); }
        if (!has_next) break;
#pragma unroll
        for (int a = 0; a < 2; ++a)
#pragma unroll
            for (int b = 0; b < 2; ++b)
#pragma unroll
                for (int m = 0; m < 4; ++m)
#pragma unroll
                    for (int n = 0; n < 2; ++n) acc[a][b][m][n] = (f32x4){0.f, 0.f, 0.f, 0.f};
        cur = nxt; cA = nA; cB = nB; ++ui;
        if constexpr (ALIGN_EPI) { if (wr == 1) PG8_BAR; }
    }
    PG8_WAIT_V(0);
    if constexpr (!ALIGN_EPI) { if (wr == 0) PG8_BAR; }
    PG8_BAR;
    if constexpr (Epi::AFTER_DRAIN) { E.fused(acc, cur, wr, wc, fr, fq, lds, wid, lane); S.done(cur); }
#undef PG8_SA
#undef PG8_SB
#undef PG8_STAGE
#undef PG8_LDA
#undef PG8_LDB
#undef PG8_MMA
#undef PG8_WAIT_V
#undef PG8_WAIT_L
#undef PG8_BAR
#undef PG8_SCHED
}
}
#define PG8_SP2 true
#define PG8_ALIGN true
#define LAS __attribute__((address_space(3)))
typedef unsigned short bf16;
typedef short bf16x8 __attribute__((ext_vector_type(8)));
typedef short s16x4 __attribute__((ext_vector_type(4)));
typedef float f32x4 __attribute__((ext_vector_type(4)));
typedef float f32x2 __attribute__((ext_vector_type(2)));
typedef float f32x16 __attribute__((ext_vector_type(16)));
typedef unsigned u32x4 __attribute__((ext_vector_type(4)));
typedef unsigned u32x2 __attribute__((ext_vector_type(2)));

constexpr int NWAVES = 8, NTHR = 512;
constexpr int BATCH = 2, T = 8192, D = 1024, FF = 2816, NMETA = 16, LP = 8208, M = BATCH * T, PR = BATCH * LP;
constexpr int NIN = 3360, NINP = 3584, DAW = 1536, RWW = 1824, VP = 8256;
constexpr float NORM_EPS = 1e-6f, GN_EPS = 64e-5f;
constexpr size_t MiB = 1u << 20;
constexpr size_t WS_XB = 0, WS_T = 32 * MiB, WS_URW = 32 * MiB, WS_UDA = 90 * MiB, WS_Y = 90 * MiB;
constexpr int NT0 = 21, NT1 = 32 - NT0;
constexpr size_t WS_Q = 287 * MiB / 2, QKV_BYTES = (size_t)BATCH * 4 * VP * 128 * 2, WS_K = WS_Q + QKV_BYTES, WS_VT = WS_K + QKV_BYTES;
constexpr size_t WS_W1A = 139 * MiB, WS_W1D = 150 * MiB, WS_WIN = 156 * MiB, WS_XB2 = 106 * MiB  , WS_TC = 287 * MiB / 2  , WS_W2A = 127 * MiB, WS_W2D = 138 * MiB;
constexpr size_t WS_E = 403 * MiB / 2, WS_A = 871 * MiB / 4, WS_G = 234 * MiB;
constexpr size_t WS_WOUT = 1001 * MiB / 4, WS_LORA = 505 * MiB / 2, WS_SMALL = 253 * MiB, WS_END = 255 * MiB;
static_assert(WS_VT + QKV_BYTES <= WS_E && (size_t)PR * RWW * 2 <= (WS_UDA - WS_URW) && (size_t)PR * DAW * 2 <= (WS_Q - WS_UDA) && WS_E + (size_t)PR * 512 * 2 <= WS_A && WS_A + (size_t)PR * 512 * 2 <= WS_G && WS_G + (size_t)PR * 512 * 2 <= WS_WOUT, "ws map");
static_assert(WS_TC + (size_t)M * FF * 2 <= WS_WOUT && WS_TC + (size_t)(2 * NT0 * 256) * FF * 2 <= WS_E && WS_Y + (size_t)M * 512 * 2 <= WS_XB2 && WS_XB2 + (size_t)(2 * NT0 * 256) * D * 2 <= WS_W2A && WS_W2A + (size_t)2 * FF * D * 2 <= WS_W2D && WS_W2D + (size_t)FF * D * 2 <= WS_Q, "tail ws map");
constexpr size_t SM_SSQ0 = 0, SM_SSQ1 = 65536, SM_SSQ2 = 131072, SM_BETA = 196608  , SM_XBM = 786432, SM_XBM2 = 819200, SM_TM = 851968  , SM_SSQM0 = 950272, SM_SSQM1 = 950528, SM_MISC = 950784;
constexpr int SUBW = 3584;
constexpr size_t SM_BAR = 983040;

__device__ __forceinline__ unsigned f2bf(float f) { unsigned u = __builtin_bit_cast(unsigned, f); return (u + 0x7fffu + ((u >> 16) & 1u)) >> 16; }
typedef __bf16 bf16x2_t __attribute__((ext_vector_type(2)));
__device__ __forceinline__ unsigned pk2(float lo, float hi) { const f32x2 v = {lo, hi}; return __builtin_bit_cast(unsigned, __builtin_convertvector(v, bf16x2_t)); }
__device__ __forceinline__ float bf2f(unsigned short b) { return __builtin_bit_cast(float, (unsigned)b << 16); }
__device__ __forceinline__ float bflo(unsigned w) { return __builtin_bit_cast(float, w << 16); }
__device__ __forceinline__ float bfhi(unsigned w) { return __builtin_bit_cast(float, w & 0xffff0000u); }
__device__ __forceinline__ float wave_sum(float v) {
#pragma unroll
    for (int o = 1; o < 64; o <<= 1) v += __shfl_xor(v, o);
    return v;
}
__device__ __forceinline__ float sigmoidf_(float x) { return __builtin_amdgcn_rcpf(1.0f + __expf(-x)); }
__device__ __forceinline__ u32x4 pack8(const float* v) { u32x4 w; w.x = pk2(v[0], v[1]); w.y = pk2(v[2], v[3]); w.z = pk2(v[4], v[5]); w.w = pk2(v[6], v[7]); return w; }
__device__ __forceinline__ void unpack8(u32x4 w, float* v) { v[0] = bflo(w.x); v[1] = bfhi(w.x); v[2] = bflo(w.y); v[3] = bfhi(w.y); v[4] = bflo(w.z); v[5] = bfhi(w.z); v[6] = bflo(w.w); v[7] = bfhi(w.w); }

struct Args {
    const float* in[31];
    float* out; unsigned char* ws;
};
enum { I_X = 0, I_META, I_F1N, I_F1G, I_F1U, I_F1D, I_MIXN, I_WIN, I_QN, I_KN, I_LQ1, I_LK1, I_LQ2, I_LK2, I_SUBLN, I_SHIFT, I_W0, I_W2, I_A0, I_A2, I_G2, I_KK, I_KA, I_RK, I_LNW, I_LNB, I_WOUT,
       I_F2N, I_F2G, I_F2U, I_F2D };

__device__ __forceinline__ int amap_tile(int k, int half) { const int n = half ? NT1 : NT0, base = half ? NT0 : 0; return k < n ? base + k : 32 + base + (k - n); }
__device__ __forceinline__ int cmap_tile(int pm, int half) { const int n = half ? NT1 : NT0, base = half ? NT0 : 0; return pm < 32 ? pm - base : n + (pm - 32 - base); }
struct EpiSwiglu {
    static constexpr bool PERM = true, AFTER_DRAIN = false;
    bf16* Tout; const float* ssq; int half, mode;
    __device__ __forceinline__ void operator()(const pg8::f32x4 (&acc)[2][2][4][2], const pg8::Unit& u, int wr, int wc, int fr, int fq) const {
        const int tA = mode == 1 ? amap_tile(u.pm, half) : u.pm;
        const int row0 = u.pm * 256 + wr * 64 + fr, row0A = tA * 256 + wr * 64 + fr, hc0 = u.pn * 128 + wc * 32 + 8 * fq;
#pragma unroll
        for (int ai = 0; ai < 2; ++ai)
#pragma unroll
            for (int m = 0; m < 4; ++m) {
                const int row = row0 + ai * 128 + m * 16;
                const float rs = rsqrtf(ssq[row0A + ai * 128 + m * 16] * (1.0f / D) + NORM_EPS);
                float t[8];
#pragma unroll
                for (int n = 0; n < 2; ++n)
#pragma unroll
                    for (int e = 0; e < 4; ++e) { const float g = acc[ai][0][m][n][e] * rs, up = acc[ai][1][m][n][e] * rs; t[4 * n + e] = g * sigmoidf_(g) * up; }
                *(u32x4*)(Tout + (size_t)row * FF + hc0) = pack8(t);
            }
    }
};
struct EpiRes {
    static constexpr bool PERM = true, AFTER_DRAIN = false;
    const float* base; float* out; bf16* xb; float* ssq; float scale; int half, mode;
    __device__ __forceinline__ void operator()(const pg8::f32x4 (&acc)[2][2][4][2], const pg8::Unit& u, int wr, int wc, int fr, int fq) const {
        const int tA = mode == 2 ? amap_tile(u.pm, half) : (mode == 3 ? (u.pm < 2 * NT0 ? amap_tile(u.pm, 0) : amap_tile(u.pm - 2 * NT0, 1)) : u.pm), tC = mode == 1 ? cmap_tile(u.pm, half) : u.pm;
        const int row0 = tA * 256 + wr * 64 + fr, row0C = tC * 256 + wr * 64 + fr, col0 = u.pn * 256 + wc * 32 + 8 * fq;
#pragma unroll
        for (int ai = 0; ai < 2; ++ai)
#pragma unroll
            for (int m = 0; m < 4; ++m) {
                const int row = row0 + ai * 128 + m * 16, rowC = row0C + ai * 128 + m * 16; float s = 0.f;
#pragma unroll
                for (int bj = 0; bj < 2; ++bj) {
                    const size_t o = (size_t)row * D + col0 + bj * 128, oC = (size_t)rowC * D + col0 + bj * 128;
                    const f32x4 b0 = *(const f32x4*)(base + o), b1 = *(const f32x4*)(base + o + 4);
                    const f32x4 h0 = b0 + acc[ai][bj][m][0] * scale, h1 = b1 + acc[ai][bj][m][1] * scale;
                    *(f32x4*)(out + o) = h0; *(f32x4*)(out + o + 4) = h1;
                    if (xb) { u32x4 w; w.x = pk2(h0[0], h0[1]); w.y = pk2(h0[2], h0[3]); w.z = pk2(h1[0], h1[1]); w.w = pk2(h1[2], h1[3]); *(u32x4*)(xb + oC) = w; }
                    s += (h0[0] * h0[0] + h0[1] * h0[1]) + (h0[2] * h0[2] + h0[3] * h0[3]) + (h1[0] * h1[0] + h1[1] * h1[1]) + (h1[2] * h1[2] + h1[3] * h1[3]);
                }
                if (ssq) { s += __shfl_xor(s, 16); s += __shfl_xor(s, 32); if (fq == 0) atomicAdd(ssq + row, s); }
            }
    }
};
struct HalfOrder {
    pg8::StaticOrder so; int half, actual;
    __device__ __forceinline__ void init(int N, int G_, int c_, int half_, int actual_) { so.init((half_ ? 2 * NT1 : 2 * NT0) * 256, N, G_, c_); half = half_; actual = actual_; }
    __device__ __forceinline__ bool next(int i, pg8::Unit& u) const { if (!so.next(i, u)) return false; if (actual) u.pm = amap_tile(u.pm, half); return true; }
    __device__ __forceinline__ void a_ready(const pg8::Unit&) const {}
    __device__ __forceinline__ void done(const pg8::Unit&) const {}
};
struct EpiU {
    static constexpr bool PERM = true, AFTER_DRAIN = false;
    bf16* uda; bf16* urw; const float* ssq;
    __device__ __forceinline__ void operator()(const pg8::f32x4 (&acc)[2][2][4][2], const pg8::Unit& u, int wr, int wc, int fr, int fq) const {
        const int row0 = u.pm * 256 + wr * 64 + fr, col0 = u.pn * 256 + wc * 32 + 8 * fq;
#pragma unroll
        for (int ai = 0; ai < 2; ++ai)
#pragma unroll
            for (int m = 0; m < 4; ++m) {
                const int row = row0 + ai * 128 + m * 16;
                const int pr = (row >> 13) * LP + NMETA + (row & 8191);
                const float rs = rsqrtf(ssq[row] * (1.0f / D) + NORM_EPS);
#pragma unroll
                for (int bj = 0; bj < 2; ++bj) {
                    const int c = col0 + bj * 128;
                    if (c < NIN) {
                        float t[8];
#pragma unroll
                        for (int n = 0; n < 2; ++n)
#pragma unroll
                            for (int e = 0; e < 4; ++e) t[4 * n + e] = acc[ai][bj][m][n][e] * rs;
                        bf16* dst = (c < DAW) ? (uda + (size_t)pr * DAW + c) : (urw + (size_t)pr * RWW + (c - DAW));
                        *(u32x4*)dst = pack8(t);
                    }
                }
            }
    }
};

__device__ __forceinline__ f32x4 mfma16(bf16x8 a, bf16x8 b, f32x4 c) { return __builtin_amdgcn_mfma_f32_16x16x32_bf16(a, b, c, 0, 0, 0); }
__device__ __forceinline__ f32x16 mfma32(bf16x8 a, bf16x8 b, f32x16 c) { return __builtin_amdgcn_mfma_f32_32x32x16_bf16(a, b, c, 0, 0, 0); }
__device__ __forceinline__ f32x4 mm16(const bf16* A, int lda, const bf16* Bt, int ldb, int K, int lane) {
    const int r = lane & 15, q = lane >> 4;
    const bf16x8* ap = (const bf16x8*)(A + (size_t)r * lda + 8 * q);
    const bf16x8* bp = (const bf16x8*)(Bt + (size_t)r * ldb + 8 * q);
    f32x4 acc = {0.f, 0.f, 0.f, 0.f};
#pragma unroll 8
    for (int kk = 0; kk < K / 32; ++kk) acc = mfma16(ap[4 * kk], bp[4 * kk], acc);
    return acc;
}
__device__ __forceinline__ void transpose_item(const float* W, int K, int N, bf16* WT, const float* gain, int mode, LAS float* scr, int item, int lane) {
    const int nblk = (N + 63) / 64, kb = item / nblk, nb = item % nblk, k0 = 64 * kb, n0 = 64 * nb;
    const int r4 = lane >> 4, c4 = (lane & 15) * 4;
    const bool colok = n0 + c4 < N;
#pragma unroll
    for (int i = 0; i < 16; ++i) {
        const int kk = r4 + 4 * i;
        f32x4 v = {0.f, 0.f, 0.f, 0.f};
        if (colok) v = *(const f32x4*)(W + (size_t)(k0 + kk) * N + n0 + c4);
        if (gain) v = v * gain[k0 + kk];
        LAS float* d = scr + kk * 65 + c4; d[0] = v.x; d[1] = v.y; d[2] = v.z; d[3] = v.w;
    }
    asm volatile("s_waitcnt lgkmcnt(0)" ::: "memory");
    const int c = lane & 7;
#pragma unroll
    for (int j = 0; j < 8; ++j) {
        const int nl = (lane >> 3) + 8 * j, n = n0 + nl; const LAS float* s = scr + (8 * c) * 65 + nl;
        const int orow = (mode == 0) ? n : ((n >> 7) * 256 + (n & 127) + (mode == 2 ? 128 : 0));
        u32x4 o; o.x = pk2(s[0 * 65], s[1 * 65]); o.y = pk2(s[2 * 65], s[3 * 65]); o.z = pk2(s[4 * 65], s[5 * 65]); o.w = pk2(s[6 * 65], s[7 * 65]);
        if (n < N) *(u32x4*)(WT + (size_t)orow * K + k0 + 8 * c) = o;
    }
    asm volatile("s_waitcnt lgkmcnt(0)" ::: "memory");
}
__device__ __forceinline__ void row_to_bf16(const float* xrow, bf16* orow, float* ssq_out, int lane) {
    const f32x4* xr = (const f32x4*)xrow + lane; f32x4 v[4]; float s = 0.f;
#pragma unroll
    for (int j = 0; j < 4; ++j) { v[j] = xr[64 * j]; s += (v[j].x * v[j].x + v[j].y * v[j].y) + (v[j].z * v[j].z + v[j].w * v[j].w); }
    s = wave_sum(s); if (lane == 0) *ssq_out = s;
    u32x2* o8 = (u32x2*)orow + lane;
#pragma unroll
    for (int j = 0; j < 4; ++j) { u32x2 w; w.x = pk2(v[j].x, v[j].y); w.y = pk2(v[j].z, v[j].w); o8[64 * j] = w; }
}
__device__ __forceinline__ float dpp_f(float x, int ctrl_sel) {
    const int xi = __builtin_bit_cast(int, x); int r;
    if (ctrl_sel == 0) r = __builtin_amdgcn_update_dpp(0, xi, 0xB1, 0xF, 0xF, true);
    else if (ctrl_sel == 1) r = __builtin_amdgcn_update_dpp(0, xi, 0x4E, 0xF, 0xF, true);
    else if (ctrl_sel == 2) r = __builtin_amdgcn_update_dpp(0, xi, 0x141, 0xF, 0xF, true);
    else r = __builtin_amdgcn_update_dpp(0, xi, 0x140, 0xF, 0xF, true);
    return __builtin_bit_cast(float, r);
}
__device__ __forceinline__ float fmul_s(float a, float b) { float r; asm("v_mul_f32_e32 %0, %1, %2" : "=v"(r) : "v"(a), "v"(b)); return r; }
__device__ __forceinline__ float fadd_s(float a, float b) { float r; asm("v_add_f32_e32 %0, %1, %2" : "=v"(r) : "v"(a), "v"(b)); return r; }
__device__ __forceinline__ float fsub_s(float a, float b) { float r; asm("v_sub_f32_e32 %0, %1, %2" : "=v"(r) : "v"(a), "v"(b)); return r; }
__device__ __forceinline__ float ffma_s(float a, float b, float c) { float r; asm("v_fma_f32 %0, %1, %2, %3" : "=v"(r) : "v"(a), "v"(b), "v"(c)); return r; }
__device__ __forceinline__ float sum16(float x) { x += dpp_f(x, 0); x += dpp_f(x, 1); x += dpp_f(x, 2); x += dpp_f(x, 3); return x; }

#define XB_TMO      128
#define XB_XCNT(j)  (256  + 64 * (j))
#define XB_XSUB(j)  (1280 + 64 * (j))
#define XB_XGEN(j)  (2304 + 64 * (j))
#define XB_TOP      3328
#define XB_TOPGEN   3392
#define XCD_BAR_WORDS 3456
#define XB_SPIN_CAP (1u << 18)

__device__ __forceinline__ unsigned xb_ld(unsigned* p)              { return __hip_atomic_load(p, __ATOMIC_RELAXED, __HIP_MEMORY_SCOPE_AGENT); }
__device__ __forceinline__ unsigned xb_add(unsigned* p, unsigned v) { return __hip_atomic_fetch_add(p, v, __ATOMIC_RELAXED, __HIP_MEMORY_SCOPE_AGENT); }
__device__ __forceinline__ unsigned xb_xcc_id() { return (unsigned)__builtin_amdgcn_s_getreg((3 << 11) | 20) & 0xFu; }
#define XB_SPIN(cond, bar) do { unsigned _sp = 0; while (cond) { __builtin_amdgcn_s_sleep(1); \
    if ((++_sp & 255u) == 0u) { if (xb_ld(&(bar)[XB_TMO])) break; if (_sp > XB_SPIN_CAP) { atomicAdd(&(bar)[XB_TMO], 1u); break; } } } } while (0)

struct XcdBarrier {
    unsigned* bar; unsigned x;
    volatile LAS unsigned* st;
};

__device__ __forceinline__ XcdBarrier xcd_barrier_post(unsigned* bar, volatile LAS unsigned* st) {
    XcdBarrier b; b.bar = bar; b.x = xb_xcc_id(); b.st = st;
    if (threadIdx.x == 0) (void)xb_add(&bar[XB_XCNT(b.x)], 1u);
    return b;
}
__device__ __forceinline__ void xcd_barrier_complete(unsigned* bar, unsigned x, unsigned& nloc, unsigned& nx, unsigned gsz) {
    const unsigned G = gsz;
    unsigned sum, cnt, mine, sp = 0u;
    for (;;) {
        sum = 0u; cnt = 0u; mine = 0u;
#pragma unroll
        for (unsigned j = 0; j < 16; ++j) { const unsigned c = xb_ld(&bar[XB_XCNT(j)]); sum += c; cnt += (c > 0u) ? 1u : 0u; mine = (j == x) ? c : mine; }
        if (sum == G) break;
        __builtin_amdgcn_s_sleep(1);
        if ((++sp & 255u) == 0u) { if (xb_ld(&bar[XB_TMO])) break; if (sp > XB_SPIN_CAP) { atomicAdd(&bar[XB_TMO], 1u); break; } }
    }
    nloc = mine > 0u ? mine : 1u; nx = cnt > 0u ? cnt : 1u;
}

__device__ __forceinline__ void xcd_barrier(const XcdBarrier& b, unsigned gsz = 0u) {
    asm volatile("s_waitcnt vmcnt(0)" ::: "memory");
    __syncthreads();
    if (threadIdx.x == 0) {
        unsigned* bar = b.bar;
        __builtin_amdgcn_s_waitcnt(0);
        unsigned nloc = b.st[0], nx = b.st[1];
        if (nloc == 0u) { xcd_barrier_complete(bar, b.x, nloc, nx, gsz ? gsz : gridDim.x); b.st[0] = nloc; b.st[1] = nx; }
        const unsigned old = xb_add(&bar[XB_XSUB(b.x)], 1u);
        const unsigned gen = old / nloc;
        if (old + 1u == (gen + 1u) * nloc) {
            __builtin_amdgcn_fence(__ATOMIC_RELEASE, "agent");
            asm volatile("s_waitcnt vmcnt(0)" ::: "memory");
            const unsigned og = xb_add(&bar[XB_TOP], 1u);
            const unsigned tg = og / nx;
            if (og + 1u == (tg + 1u) * nx) xb_add(&bar[XB_TOPGEN], 1u);
            else XB_SPIN(xb_ld(&bar[XB_TOPGEN]) == tg, bar);
            __builtin_amdgcn_fence(__ATOMIC_ACQUIRE, "agent");
            xb_add(&bar[XB_XGEN(b.x)], 1u);
            asm volatile("s_waitcnt vmcnt(0)" ::: "memory");
        } else {
            XB_SPIN(xb_ld(&bar[XB_XGEN(b.x)]) == gen, bar);
            __builtin_amdgcn_fence(__ATOMIC_ACQUIRE, "agent");
            asm volatile("s_waitcnt vmcnt(0)" ::: "memory");
        }
    }
    __syncthreads();
}

__device__ __forceinline__ void p6_half(const bf16* URW, const bf16* Ab, const bf16* Gb, const bf16* Y, bf16* XB, const float* mixp, const float* ka, const float* rk, const float* lnwp, const float* lnbp,
                                        int half, int wi, int nw, int lane) {
    const int c0 = 8 * lane;
    float mr[8], mk[8], mv[8], kac[8], rkc[8], lnw[8], lnb[8];
#pragma unroll
    for (int j = 0; j < 8; ++j) { mr[j] = mixp[c0 + j]; mk[j] = mixp[512 + c0 + j]; mv[j] = mixp[1024 + c0 + j]; kac[j] = ka[c0 + j]; rkc[j] = rk[c0 + j]; lnw[j] = lnwp[c0 + j]; lnb[j] = lnbp[c0 + j]; }
    for (int r = wi; r < (half ? 2 * NT1 : 2 * NT0) * 256; r += nw) {
        const int m = amap_tile(r >> 8, half) * 256 + (r & 255);
        const int b = m >> 13, t = m & 8191, pr = b * LP + NMETA + t;
        const bf16* cur = URW + (size_t)pr * RWW + c0; const bf16* prv = cur - RWW;
        float rc[8], rp[8], kc[8], kp[8], vc[8], vp[8], a8[8], g8[8], y[8];
        unpack8(*(const u32x4*)cur, rc); unpack8(*(const u32x4*)prv, rp); unpack8(*(const u32x4*)(cur + 512), kc); unpack8(*(const u32x4*)(prv + 512), kp);
        unpack8(*(const u32x4*)(cur + 1024), vc); unpack8(*(const u32x4*)(prv + 1024), vp);
        unpack8(*(const u32x4*)(Ab + (size_t)pr * 512 + c0), a8); unpack8(*(const u32x4*)(Gb + (size_t)pr * 512 + c0), g8);
        unpack8(*(const u32x4*)(Y + (size_t)m * 512 + c0), y);
        float s = 0.f, beta = 0.f;
#pragma unroll
        for (int j = 0; j < 8; ++j) { s += y[j]; const float r_ = rc[j] + (rp[j] - rc[j]) * mr[j], k_ = kc[j] + (kp[j] - kc[j]) * mk[j]; beta += r_ * (k_ * (1.0f + (a8[j] - 1.0f) * kac[j])) * rkc[j]; }
        s += __shfl_xor(s, 1); s += __shfl_xor(s, 2); s += __shfl_xor(s, 4);
        beta += __shfl_xor(beta, 1); beta += __shfl_xor(beta, 2); beta += __shfl_xor(beta, 4);
        const float mu = s * (1.0f / 64); float q = 0.f;
#pragma unroll
        for (int j = 0; j < 8; ++j) { y[j] -= mu; q += y[j] * y[j]; }
        q += __shfl_xor(q, 1); q += __shfl_xor(q, 2); q += __shfl_xor(q, 4);
        const float rstd = rsqrtf(q * (1.0f / 64) + GN_EPS);
        float o[8];
#pragma unroll
        for (int j = 0; j < 8; ++j) { const float v_ = vc[j] + (vp[j] - vc[j]) * mv[j]; o[j] = (y[j] * rstd * lnw[j] + lnb[j] + beta * v_) * g8[j]; }
        *(u32x4*)(XB + (size_t)m * D + 512 + c0) = pack8(o);
    }
}
#define TAIL_HALF(HALF_, GS_, CI_, BAR1_, BAR2_) do { \
        p6_half(URW, Ab, Gb, Y, XB, args.in[I_SHIFT], args.in[I_KA], args.in[I_RK], args.in[I_LNW], args.in[I_LNB], (HALF_), (CI_) * NWAVES + wave, (GS_) * NWAVES, lane); \
        BAR1_; \
        { pg8::Gemm g{XB, WOUT, M / 2, D, D}; HalfOrder S; S.init(D, (GS_), (CI_), (HALF_), 1); EpiRes E{out, out, XB2, ssq2, 1.0f, (HALF_), 1}; \
          pg8::gemm_phase<EpiRes, HalfOrder, PG8_ALIGN, PG8_SP2>(lds, g, S, E); } \
        BAR2_; \
        { pg8::Gemm g{XB2, W2A, M / 2, 2 * FF, D}; HalfOrder S; S.init(2 * FF, (GS_), (CI_), (HALF_), 0); EpiSwiglu E{TC + (size_t)((HALF_) ? 2 * NT0 * 256 : 0) * FF, ssq2, (HALF_), 1}; \
          pg8::gemm_phase<EpiSwiglu, HalfOrder, PG8_ALIGN, PG8_SP2>(lds, g, S, E); } \
    } while (0)
__device__ __forceinline__ void sub_barrier(unsigned* ctr, unsigned target) {
    asm volatile("s_waitcnt vmcnt(0)" ::: "memory");
    __syncthreads();
    if (threadIdx.x == 0) {
        __builtin_amdgcn_fence(__ATOMIC_RELEASE, "agent"); asm volatile("s_waitcnt vmcnt(0)" ::: "memory");
        __hip_atomic_fetch_add(ctr, 1u, __ATOMIC_RELAXED, __HIP_MEMORY_SCOPE_AGENT);
        unsigned sp = 0;
        while (__hip_atomic_load(ctr, __ATOMIC_RELAXED, __HIP_MEMORY_SCOPE_AGENT) < target) { __builtin_amdgcn_s_sleep(2); if (++sp > (1u << 22)) break; }
        __builtin_amdgcn_fence(__ATOMIC_ACQUIRE, "agent"); asm volatile("s_waitcnt vmcnt(0)" ::: "memory");
    }
    __syncthreads();
}
__device__ __forceinline__ void wait_flag(unsigned* ctr, unsigned target) {
    if (threadIdx.x == 0) {
        unsigned sp = 0;
        while (__hip_atomic_load(ctr, __ATOMIC_RELAXED, __HIP_MEMORY_SCOPE_AGENT) < target) { __builtin_amdgcn_s_sleep(4); if (++sp > (1u << 22)) break; }
        __builtin_amdgcn_fence(__ATOMIC_ACQUIRE, "agent"); asm volatile("s_waitcnt vmcnt(0)" ::: "memory");
    }
    __syncthreads();
}
constexpr int LDS_BYTES = 147456;
constexpr int ATT_KB = 64 * 272, ATT_VB = 128 * 136, ATT_BUF = ATT_KB + ATT_VB;
constexpr int LDS_MISC = 143360;
constexpr int SCAN_STEP_F = 384, SCAN_CH = 32;

__global__ void __launch_bounds__(NTHR, 2) fwd_kernel(Args args) {
    extern __shared__ __attribute__((aligned(16))) unsigned char lds_raw[];
    LAS unsigned char* lds = (LAS unsigned char*)lds_raw;
    const int tid = threadIdx.x, lane = tid & 63, wave = __builtin_amdgcn_readfirstlane(tid >> 6);
    const int G = gridDim.x, bx = blockIdx.x;
    const int gw = bx * NWAVES + wave, NGW = G * NWAVES;
    unsigned char* ws = args.ws;
    bf16* XB = (bf16*)(ws + WS_XB); bf16* TB = (bf16*)(ws + WS_T); bf16* URW = (bf16*)(ws + WS_URW); bf16* UDA = (bf16*)(ws + WS_UDA); bf16* Y = (bf16*)(ws + WS_Y); bf16* TC = (bf16*)(ws + WS_TC);
    bf16* Qb = (bf16*)(ws + WS_Q); bf16* Kb = (bf16*)(ws + WS_K); bf16* Vt = (bf16*)(ws + WS_VT);
    bf16* W1A = (bf16*)(ws + WS_W1A); bf16* W1D = (bf16*)(ws + WS_W1D); bf16* WIN = (bf16*)(ws + WS_WIN); bf16* XB2 = (bf16*)(ws + WS_XB2);
    bf16* W2A = (bf16*)(ws + WS_W2A); bf16* W2D = (bf16*)(ws + WS_W2D);
    bf16* Eb = (bf16*)(ws + WS_E); bf16* Ab = (bf16*)(ws + WS_A); bf16* Gb = (bf16*)(ws + WS_G);
    bf16* WOUT = (bf16*)(ws + WS_WOUT);
    bf16* W2T = (bf16*)(ws + WS_LORA); bf16* A2T = W2T + 512 * 64; bf16* G2T = A2T + 512 * 64;
    unsigned char* sm = ws + WS_SMALL;
    float* ssq0 = (float*)(sm + SM_SSQ0); float* ssq1 = (float*)(sm + SM_SSQ1); float* ssq2 = (float*)(sm + SM_SSQ2); float* INV = (float*)(sm + SM_BETA);
    bf16* XBM = (bf16*)(sm + SM_XBM); bf16* XBM2 = (bf16*)(sm + SM_XBM2); bf16* TM = (bf16*)(sm + SM_TM);
    float* ssqm0 = (float*)(sm + SM_SSQM0); float* ssqm1 = (float*)(sm + SM_SSQM1); float* misc = (float*)(sm + SM_MISC); unsigned* qctr = (unsigned*)(misc + 16);
    const float* x = args.in[I_X];
    float* out = args.out;
    if (tid < 4) ((LAS unsigned*)(lds + LDS_MISC + 64))[tid] = 0u;
    __syncthreads();
    const XcdBarrier xbar = xcd_barrier_post((unsigned*)(sm + SM_BAR), (volatile LAS unsigned*)(lds + LDS_MISC + 64));
    if (bx >= 64 && tid == 0) (void)xb_add(&((unsigned*)(sm + SM_BAR) + 4096)[XB_XCNT(xbar.x)], 1u);

    {
        LAS float* scr = (LAS float*)(lds + wave * 16640);
        constexpr int IT_G = (D / 64) * (FF / 64);
        for (int it = gw; it < 2 * IT_G; it += NGW) {
            if (it < IT_G) transpose_item(args.in[I_F1G], D, FF, W1A, args.in[I_F1N], 1, scr, it, lane);
            else transpose_item(args.in[I_F1U], D, FF, W1A, args.in[I_F1N], 2, scr, it - IT_G, lane);
        }
        for (int m = gw; m < M; m += NGW) row_to_bf16(x + (size_t)m * D, XB + (size_t)m * D, ssq0 + m, lane);
        if (gw < NMETA) row_to_bf16(args.in[I_META] + (size_t)gw * D, XBM + (size_t)gw * D, ssqm0 + gw, lane);
        const int gt = bx * NTHR + tid, NGT = G * NTHR;
        for (int i = gt; i < M; i += NGT) { ssq1[i] = 0.f; ssq2[i] = 0.f; }
        if (gt < 16) ssqm1[gt] = 0.f;
        if (gt == 0) { qctr[0] = 0u; qctr[1] = 0u; }
        for (int i = gt; i < 512 * 64; i += NGT) { const int n = i >> 6, k = i & 63; W2T[i] = (bf16)f2bf(args.in[I_W2][k * 512 + n]); A2T[i] = (bf16)f2bf(args.in[I_A2][k * 512 + n]); }
        for (int i = gt; i < 512 * 160; i += NGT) { const int n = i / 160, k = i % 160; G2T[i] = (bf16)f2bf(args.in[I_G2][k * 512 + n]); }
        if (gw == 0) {
            const float s1 = wave_sum(args.in[I_LQ1][lane] * args.in[I_LK1][lane]), s2 = wave_sum(args.in[I_LQ2][lane] * args.in[I_LK2][lane]);
            if (lane == 0) misc[0] = expf(s1) - expf(s2) + 0.2f;
        }
    }
    xcd_barrier(xbar);

    {
        const int mw1 = (G == 256) ? (bx >= 128 ? (bx - 128) * NWAVES + wave : (1 << 30)) : gw, ms1 = (G == 256) ? 128 * NWAVES : NGW;
        for (int hc = mw1; hc < FF / 16; hc += ms1) {
            const int grow = (hc >> 3) * 256 + (hc & 7) * 16;
            const f32x4 ag = mm16(XBM, D, W1A + (size_t)grow * D, D, D, lane), au = mm16(XBM, D, W1A + (size_t)(grow + 128) * D, D, D, lane);
#pragma unroll
            for (int e = 0; e < 4; ++e) { const int row = 4 * (lane >> 4) + e; const float rs = rsqrtf(ssqm0[row] * (1.0f / D) + NORM_EPS); const float g = ag[e] * rs, up = au[e] * rs;
                TM[row * FF + hc * 16 + (lane & 15)] = (bf16)f2bf(g * sigmoidf_(g) * up); }
        }
        pg8::Gemm g{XB, W1A, M, 2 * FF, D}; pg8::StaticOrder S; S.init(M, 2 * FF, G, bx);
        EpiSwiglu E{TB, ssq0, 0, 0};
        pg8::gemm_phase<EpiSwiglu, pg8::StaticOrder, PG8_ALIGN, PG8_SP2>(lds, g, S, E);
        if (G == 256 ? bx >= 128 : true) {
            LAS float* scr = (LAS float*)(lds + wave * 16640);
            constexpr int IT_D = (FF / 64) * (D / 64), IT_IN = (D / 64) * ((NIN + 63) / 64), IT_O = (D / 64) * (D / 64), NIT = IT_D + IT_IN + IT_O;
            const int nb = (G == 256) ? 128 : G, b0 = (G == 256) ? 128 : 0;
            for (int it = (bx - b0) * NWAVES + wave; it < NIT; it += nb * NWAVES) {
                int r = it;
                if (r < IT_D) { transpose_item(args.in[I_F1D], FF, D, W1D, nullptr, 0, scr, r, lane); continue; } r -= IT_D;
                if (r < IT_IN) { transpose_item(args.in[I_WIN], D, NIN, WIN, args.in[I_MIXN], 0, scr, r, lane); continue; } r -= IT_IN;
                transpose_item(args.in[I_WOUT], D, D, WOUT, nullptr, 0, scr, r, lane);
            }
        }
    }
    xcd_barrier(xbar);

    {
        for (int cb = bx; cb < D / 16; cb += G) {
            f32x4 a = mm16(TM + 352 * wave, FF, W1D + (size_t)cb * 16 * FF + 352 * wave, FF, 352, lane);
            LAS f32x4* red = (LAS f32x4*)lds;
            red[wave * 64 + lane] = a;
            __syncthreads();
            if (wave == 0) {
#pragma unroll
                for (int w8 = 1; w8 < 8; ++w8) a += red[w8 * 64 + lane];
#pragma unroll
                for (int e = 0; e < 4; ++e) { const int row = 4 * (lane >> 4) + e, col = cb * 16 + (lane & 15); const float h = args.in[I_META][row * D + col] + 0.5f * a[e];
                    XBM2[row * D + col] = (bf16)f2bf(h); float s = h * h; s += __shfl_xor(s, 1); s += __shfl_xor(s, 2); s += __shfl_xor(s, 4); s += __shfl_xor(s, 8);
                    if ((lane & 15) == 0) atomicAdd(ssqm1 + row, s); }
            }
            __syncthreads();
        }
        pg8::Gemm g{TB, W1D, M, D, FF}; pg8::StaticOrder S; S.init(M, D, G, bx);
        EpiRes E{x, out, XB, ssq1, 0.5f, 0, 0};
        pg8::gemm_phase<EpiRes, pg8::StaticOrder, PG8_ALIGN, PG8_SP2>(lds, g, S, E);
    }
    xcd_barrier(xbar);

    {
        const int mw3 = (G == 256) ? (bx >= 128 ? (bx - 128) * NWAVES + wave : (1 << 30)) : gw, ms3 = (G == 256) ? 128 * NWAVES : NGW;
        for (int cb = mw3; cb < NIN / 16; cb += ms3) {
            const f32x4 a = mm16(XBM2, D, WIN + (size_t)cb * 16 * D, D, D, lane);
#pragma unroll
            for (int e = 0; e < 4; ++e) { const int row = 4 * (lane >> 4) + e, col = cb * 16 + (lane & 15); const float rs = rsqrtf(ssqm1[row] * (1.0f / D) + NORM_EPS);
                const bf16 v = (bf16)f2bf(a[e] * rs);
#pragma unroll
                for (int b = 0; b < BATCH; ++b) { const int pr = b * LP + row; if (col < DAW) UDA[(size_t)pr * DAW + col] = v; else URW[(size_t)pr * RWW + col - DAW] = v; } }
        }
        pg8::Gemm g{XB, WIN, M, NINP, D}; pg8::StaticOrder S; S.init(M, NINP, G, bx);
        EpiU E{UDA, URW, ssq1};
        pg8::gemm_phase<EpiU, pg8::StaticOrder, PG8_ALIGN, PG8_SP2>(lds, g, S, E);
    }
    xcd_barrier(xbar);

    {
        {
            const int e8 = lane & 7, d0 = e8 * 8, grp = lane >> 3, hh = grp >> 1, cc = grp & 1;
            float qn[8], kn[8];
#pragma unroll
            for (int j = 0; j < 8; ++j) { qn[j] = args.in[I_QN][d0 + j]; kn[j] = args.in[I_KN][d0 + j]; }
            float kmix[8], kkc8[8];
#pragma unroll
            for (int j = 0; j < 8; ++j) { kmix[j] = args.in[I_SHIFT][512 + 8 * lane + j]; kkc8[j] = args.in[I_KK][8 * lane + j]; }
            const double invf[8] = {1.0, 0.19392274474868576, 0.03760603093086393, 0.007292664737217109, 0.001414213562373095, 0.0002742481756762073, 5.318295896944988e-05, 1.031338537721246e-05};
            for (int pr = gw; pr < PR; pr += NGW) {
                const int b = pr / LP, p = pr - b * LP;
                const bf16* urow = UDA + (size_t)pr * DAW;
                float q[8], k[8];
                unpack8(*(const u32x4*)(urow + 8 * lane), q); unpack8(*(const u32x4*)(urow + 512 + 8 * lane), k);
                float sq = 0.f, sk = 0.f;
#pragma unroll
                for (int j = 0; j < 8; ++j) { sq += q[j] * q[j]; sk += k[j] * k[j]; }
                sq += __shfl_xor(sq, 1); sq += __shfl_xor(sq, 2); sq += __shfl_xor(sq, 4);
                sk += __shfl_xor(sk, 1); sk += __shfl_xor(sk, 2); sk += __shfl_xor(sk, 4);
                const float rq = rsqrtf(sq * (1.0f / 64) + NORM_EPS), rk = rsqrtf(sk * (1.0f / 64) + NORM_EPS);
#pragma unroll
                for (int j = 0; j < 8; ++j) { q[j] *= rq * qn[j]; k[j] *= rk * kn[j]; }
#pragma unroll
                for (int j = 0; j < 8; ++j) {
                    const float qo = __shfl_xor(q[j], 1), ko = __shfl_xor(k[j], 1);
                    if (e8 < 2) {
                        double rev = (double)p * invf[j] * 0.15915494309189535; rev -= floor(rev);
                        const float rf = (float)rev, cs = __builtin_amdgcn_cosf(rf), sn = __builtin_amdgcn_sinf(rf);
                        if (e8 == 0) { q[j] = q[j] * cs - qo * sn; k[j] = k[j] * cs - ko * sn; }
                        else         { q[j] = q[j] * cs + qo * sn; k[j] = k[j] * cs + ko * sn; }
                    }
                }
#pragma unroll
                for (int j = 0; j < 8; ++j) q[j] *= 0.18033688011112042f;
                const size_t o = ((size_t)(b * 4 + hh) * VP + p) * 128 + cc * 64 + d0;
                *(u32x4*)(Qb + o) = pack8(q); *(u32x4*)(Kb + o) = pack8(k);
                {
                    const bf16* rrow = URW + (size_t)pr * RWW + 512 + 8 * lane;
                    float kc[8], kp8[8];
                    unpack8(*(const u32x4*)rrow, kc);
                    if (p > 0) unpack8(*(const u32x4*)(rrow - RWW), kp8); else {
#pragma unroll
                        for (int j = 0; j < 8; ++j) kp8[j] = 0.f; }
                    float ss = 0.f;
#pragma unroll
                    for (int j = 0; j < 8; ++j) { const float kv = (kc[j] + (kp8[j] - kc[j]) * kmix[j]) * kkc8[j]; ss += kv * kv; }
                    ss += __shfl_xor(ss, 1); ss += __shfl_xor(ss, 2); ss += __shfl_xor(ss, 4);
                    if (e8 == 0) INV[(size_t)pr * 8 + grp] = 1.0f / fmaxf(sqrtf(ss), 1e-12f);
                }
            }
        }
        {
            LAS unsigned short* tile = (LAS unsigned short*)lds;
            for (int it = bx; it < BATCH * (VP / 64); it += G) {
                const int b = it / (VP / 64), p0 = (it % (VP / 64)) * 64;
#pragma unroll
                for (int i = 0; i < 8; ++i) {
                    const int id = tid + NTHR * i, row = id >> 6, c16 = id & 63;
                    u32x4 v = {0u, 0u, 0u, 0u};
                    if (p0 + row < LP) v = *(const u32x4*)(UDA + (size_t)(b * LP + p0 + row) * DAW + 1024 + c16 * 8);
                    *(LAS u32x4*)(tile + row * 520 + c16 * 8) = v;
                }
                __syncthreads();
                {
                    unsigned w[32];
#pragma unroll
                    for (int pp = 0; pp < 32; ++pp) w[pp] = (unsigned)tile[(2 * pp) * 520 + tid] | ((unsigned)tile[(2 * pp + 1) * 520 + tid] << 16);
                    u32x4* dst = (u32x4*)(Vt + ((size_t)(b * 4 + (tid >> 7)) * 128 + (tid & 127)) * VP + p0);
#pragma unroll
                    for (int i = 0; i < 8; ++i) { u32x4 o; o.x = w[4 * i]; o.y = w[4 * i + 1]; o.z = w[4 * i + 2]; o.w = w[4 * i + 3]; dst[i] = o; }
                }
                __syncthreads();
            }
        }
        {
            const int r16 = lane & 15, q4 = lane >> 4;
            const float* mixp = args.in[I_SHIFT];
            for (int it2 = wave * G + bx; it2 < 2 * (PR / 16); it2 += NGW) {
                const int rg = it2 >> 1, cb0 = (it2 & 1) * 16;
                const int pr = rg * 16 + r16, p = pr % LP;
                const bf16* cur = URW + (size_t)pr * RWW; const bf16* prv = cur - RWW;
                bf16x8 Aw[2], Aa[2], Ag[5];
#pragma unroll
                for (int s = 0; s < 9; ++s) {
                    const int col = (s < 2) ? (1536 + 32 * s + 8 * q4) : (s < 4) ? (1600 + 32 * (s - 2) + 8 * q4) : (1664 + 32 * (s - 4) + 8 * q4);
                    float c8[8], p8[8];
                    unpack8(*(const u32x4*)(cur + col), c8);
                    if (p > 0) unpack8(*(const u32x4*)(prv + col), p8); else {
#pragma unroll
                        for (int j = 0; j < 8; ++j) p8[j] = 0.f; }
#pragma unroll
                    for (int j = 0; j < 8; ++j) { float v = c8[j] + (p8[j] - c8[j]) * mixp[col + j];
                        if (s < 2) v = tanhf(v); else if (s >= 4) v = sigmoidf_(v);
                        c8[j] = v; }
                    const u32x4 w = pack8(c8); const bf16x8 f = __builtin_bit_cast(bf16x8, w);
                    if (s < 2) Aw[s] = f; else if (s < 4) Aa[s - 2] = f; else Ag[s - 4] = f;
                }
                for (int cb = cb0; cb < cb0 + 16; ++cb) {
                    const int n = cb * 16 + r16;
                    f32x4 aw = {0.f, 0.f, 0.f, 0.f}, aa = aw, ag = aw;
#pragma unroll
                    for (int s = 0; s < 2; ++s) { aw = mfma16(Aw[s], *(const bf16x8*)(W2T + n * 64 + 32 * s + 8 * q4), aw); aa = mfma16(Aa[s], *(const bf16x8*)(A2T + n * 64 + 32 * s + 8 * q4), aa); }
#pragma unroll
                    for (int s = 0; s < 5; ++s) ag = mfma16(Ag[s], *(const bf16x8*)(G2T + n * 160 + 32 * s + 8 * q4), ag);
                    const float w0 = args.in[I_W0][n], a0 = args.in[I_A0][n];
#pragma unroll
                    for (int e = 0; e < 4; ++e) {
                        const size_t o = (size_t)(rg * 16 + 4 * q4 + e) * 512 + n;
                        Eb[o] = (bf16)f2bf(0.6065306597126334f * sigmoidf_(w0 + aw[e]));
                        Ab[o] = (bf16)f2bf(sigmoidf_(a0 + aa[e]));
                        Gb[o] = (bf16)f2bf(ag[e]);
                    }
                }
            }
        }
    }
    xcd_barrier(xbar);

    {
        if (bx < 64) {
            const int chain = bx >> 2, quarter = bx & 3, b = chain >> 3, h = chain & 7;
            constexpr int SC2 = 16, OPF = 320, NC2 = LP / SC2;
            static_assert(NC2 * SC2 == LP && (NC2 & 1) == 1, "chunking");
            constexpr int CF = (NMETA + NT0 * 256) / SC2 - 1;
            static_assert((CF & 1) == 0 && (NMETA + NT0 * 256) % SC2 == 0, "flag chunk must be handled in the second half of a loop iteration");
            LAS float* OP = (LAS float*)lds;
            LAS unsigned short* RB = (LAS unsigned short*)(lds + 40960);
            LAS unsigned char* SP = lds + 45056;
            if (wave >= 4) {
                const int lw = wave - 4, li = lane >> 4, lq = lane & 15, c4 = h * 64 + 4 * lq;
                const float* mixp = args.in[I_SHIFT];
                const f32x4 mix_r = *(const f32x4*)(mixp + c4), mix_k = *(const f32x4*)(mixp + 512 + c4), mix_v = *(const f32x4*)(mixp + 1024 + c4);
                const f32x4 kkc = *(const f32x4*)(args.in[I_KK] + c4), kac = *(const f32x4*)(args.in[I_KA] + c4);
                struct LSet { u32x2 rc, rp, kc, kp, vc, vp, e, a; float iv; };
                LSet s0, s1;
                const bf16* ubase = URW + (size_t)b * LP * RWW + c4; const bf16* ebase = Eb + (size_t)b * LP * 512 + c4; const bf16* abase = Ab + (size_t)b * LP * 512 + c4; const float* ibase = INV + (size_t)b * LP * 8 + h;
                bf16* ybase = Y + (size_t)b * T * 512 + h * 64 + 16 * quarter + 4 * (lane >> 4);
                unsigned* halfflag = (unsigned*)(sm + SM_BAR) + SUBW + 64 * 7;
#define UNPK4_(w_) ((f32x4){bflo((w_).x), bfhi((w_).x), bflo((w_).y), bfhi((w_).y)})
#define SCAN_LOAD(S_, c_) do { const int p_ = (c_) * SC2 + 4 * lw + li; const int pm_ = p_ > 0 ? p_ - 1 : 0; const bf16* u_ = ubase + (size_t)p_ * RWW; const bf16* um_ = ubase + (size_t)pm_ * RWW; \
        S_.rc = *(const u32x2*)u_; S_.kc = *(const u32x2*)(u_ + 512); S_.vc = *(const u32x2*)(u_ + 1024); S_.rp = *(const u32x2*)um_; S_.kp = *(const u32x2*)(um_ + 512); S_.vp = *(const u32x2*)(um_ + 1024); \
        S_.e = *(const u32x2*)(ebase + (size_t)p_ * 512); S_.a = *(const u32x2*)(abase + (size_t)p_ * 512); S_.iv = ibase[(size_t)p_ * 8]; } while (0)
#define SCAN_PROC(S_, c_) do { const int p_ = (c_) * SC2 + 4 * lw + li; const float pz_ = p_ == 0 ? 0.f : 1.f;     \
        const f32x4 rc_ = UNPK4_(S_.rc), kc_ = UNPK4_(S_.kc), vc_ = UNPK4_(S_.vc), rp_ = UNPK4_(S_.rp) * pz_, kq_ = UNPK4_(S_.kp) * pz_, vp_ = UNPK4_(S_.vp) * pz_, e_ = UNPK4_(S_.e), a_ = UNPK4_(S_.a); \
        const f32x4 r_ = rc_ + (rp_ - rc_) * mix_r, k_ = kc_ + (kq_ - kc_) * mix_k, v_ = vc_ + (vp_ - vc_) * mix_v; \
        const f32x4 kk_ = k_ * kkc * S_.iv, kpv_ = k_ * ((a_ - 1.0f) * kac + 1.0f); \
        const f32x4 w_ = {__expf(-e_.x), __expf(-e_.y), __expf(-e_.z), __expf(-e_.w)}; \
        LAS float* dst_ = OP + ((c_) & 1) * (SC2 * OPF) + (4 * lw + li) * OPF + 4 * lq; \
        *(LAS f32x4*)dst_ = w_; *(LAS f32x4*)(dst_ + 64) = -kk_; *(LAS f32x4*)(dst_ + 128) = kk_ * a_; *(LAS f32x4*)(dst_ + 192) = kpv_; *(LAS f32x4*)(dst_ + 256) = v_; \
        *(LAS u32x2*)(RB + ((c_) & 1) * (SC2 * 64) + (4 * lw + li) * 64 + 4 * lq) = (u32x2){pk2(r_.x, r_.y), pk2(r_.z, r_.w)}; } while (0)
#define SCAN_YPASS(c_) do { _Pragma("unroll") for (int i_ = 0; i_ < 4; ++i_) { const int st_ = 4 * lw + i_, p_ = (c_) * SC2 + st_; \
        const LAS unsigned char* sp_ = SP + ((c_) & 1) * 36864 + (st_ * 16 + (lane & 15)) * 144 + 16 * (lane >> 4); const LAS unsigned short* rb_ = RB + ((c_) & 1) * (SC2 * 64) + st_ * 64 + 8 * (lane >> 4); \
        f32x4 acc_ = {0.f, 0.f, 0.f, 0.f}; \
        acc_ = mfma16(*(const LAS bf16x8*)sp_, *(const LAS bf16x8*)rb_, acc_); acc_ = mfma16(*(const LAS bf16x8*)(sp_ + 64), *(const LAS bf16x8*)(rb_ + 32), acc_); \
        if ((lane & 15) == 0 && p_ >= NMETA) *(u32x2*)(ybase + (size_t)(p_ - NMETA) * 512) = (u32x2){pk2(acc_.x, acc_.y), pk2(acc_.z, acc_.w)}; } } while (0)
                SCAN_LOAD(s0, 0); SCAN_LOAD(s1, 1); SCAN_PROC(s0, 0); SCAN_LOAD(s0, 2);
                __syncthreads();
                for (int c = 0; c < NC2; c += 2) {
                    if (c == CF + 2 && wave == 4 && lane == 0) {
                        __builtin_amdgcn_fence(__ATOMIC_RELEASE, "agent"); asm volatile("s_waitcnt vmcnt(0)" ::: "memory");
                        __hip_atomic_fetch_add(halfflag, 1u, __ATOMIC_RELAXED, __HIP_MEMORY_SCOPE_AGENT);
                    }
                    if (c >= 1) SCAN_YPASS(c - 1);
                    if (c + 1 < NC2) { SCAN_PROC(s1, c + 1); if (c + 3 < NC2) SCAN_LOAD(s1, c + 3); }
                    __syncthreads();
                    if (c + 1 < NC2) {
                        SCAN_YPASS(c);
                        if (c == CF) asm volatile("s_waitcnt vmcnt(0)" ::: "memory");
                        if (c + 2 < NC2) { SCAN_PROC(s0, c + 2); if (c + 4 < NC2) SCAN_LOAD(s0, c + 4); }
                        __syncthreads();
                    }
                }
                SCAN_YPASS(NC2 - 1);
#undef SCAN_LOAD
#undef UNPK4_
#undef SCAN_PROC
#undef SCAN_YPASS
            } else {
                const int rr = lane >> 4, kq = lane & 15, vrow = 16 * quarter + 4 * wave + rr;
                f32x4 S = {0.f, 0.f, 0.f, 0.f};
                __builtin_amdgcn_s_setprio(3);
                __syncthreads();
                for (int c = 0; c < NC2; ++c) {
                    const LAS float* cb = OP + (c & 1) * (SC2 * OPF);
                    LAS unsigned char* spw = SP + (c & 1) * 36864 + (4 * wave + rr) * 144 + 8 * kq;
                    f32x4 w = ((const LAS f32x4*)cb)[kq], an = ((const LAS f32x4*)(cb + 64))[kq], bv = ((const LAS f32x4*)(cb + 128))[kq], kp = ((const LAS f32x4*)(cb + 192))[kq];
                    float vv = cb[256 + vrow];
#define SB_ __builtin_amdgcn_sched_barrier(0)
#pragma unroll
                    for (int st = 0; st < SC2; ++st) {
                        const bool more = st + 1 < SC2;
                        const LAS float* sp = cb + (more ? st + 1 : st) * OPF;
                        f32x4 nw = w, nan_ = an, nbv = bv, nkp = kp; float nvv = vv;
                        f32x2 t = S.zw * an.zw; SB_;
                        t = S.xy * an.xy + t; SB_;
                        f32x2 u01 = kp.xy * vv; SB_;
                        float x = t.x + t.y; SB_;
                        f32x2 u23 = kp.zw * vv; SB_;
                        u01 = S.xy * w.xy + u01; SB_;
                        x += dpp_f(x, 0); SB_;
                        u23 = S.zw * w.zw + u23; SB_;
                        if (more) nw = ((const LAS f32x4*)sp)[kq]; SB_;
                        x += dpp_f(x, 1); SB_;
                        if (more) nan_ = ((const LAS f32x4*)(sp + 64))[kq]; SB_;
                        if (more) nbv = ((const LAS f32x4*)(sp + 128))[kq]; SB_;
                        x += dpp_f(x, 2); SB_;
                        if (more) nkp = ((const LAS f32x4*)(sp + 192))[kq]; SB_;
                        if (more) nvv = sp[256 + vrow]; SB_;
                        x += dpp_f(x, 3); SB_;
                        S.xy = bv.xy * x + u01; SB_;
                        S.zw = bv.zw * x + u23; SB_;
                        *(LAS u32x2*)(spw + st * 2304) = (u32x2){pk2(S.x, S.y), pk2(S.z, S.w)}; SB_;
                        w = nw; an = nan_; bv = nbv; kp = nkp; vv = nvv;
                    }
#undef SB_
                    __syncthreads();
                }
                __builtin_amdgcn_s_setprio(0);
            }
            __syncthreads();
        }
        if (bx >= 64) {
            const float lam = misc[0];
            LAS unsigned* shu = (LAS unsigned*)(lds + LDS_MISC);
            const int c = wave >> 2, qg = wave & 3, r32 = lane & 31, hh = lane >> 5;
            for (;;) {
                if (tid == 0) shu[0] = atomicAdd(qctr, 1u);
                __syncthreads();
                const unsigned un = shu[0];
                if (un >= 512u) break;
                const int qi = (un < 16u * NT0) ? (2 * NT0 - 1) - (int)(un >> 3) : 63 - (int)((un - 16u * NT0) >> 3), bh = (int)(un & 7u), b = bh >> 2, h = bh & 3;
                const int qbase = NMETA + 128 * qi + 32 * qg, qpos = qbase + r32;
                const bf16* qrow = Qb + ((size_t)bh * VP + qpos) * 128 + c * 64 + 8 * hh;
                bf16x8 qf[4];
#pragma unroll
                for (int s = 0; s < 4; ++s) qf[s] = *(const bf16x8*)(qrow + 16 * s);
                f32x16 o[4];
#pragma unroll
                for (int d = 0; d < 4; ++d)
#pragma unroll
                    for (int e = 0; e < 16; ++e) o[d][e] = 0.f;
                float mrun = -1e30f, lsum = 0.f;
                const int ntiles = 2 * qi + 3;
                const bf16* ksrc[2]; const bf16* vsrc[2]; int kdst[2], vdst[2];
#pragma unroll
                for (int ii = 0; ii < 2; ++ii) { const int id = tid + NTHR * ii;
                    ksrc[ii] = Kb + ((size_t)bh * VP + (id >> 4)) * 128 + (id & 15) * 8; kdst[ii] = (id >> 4) * 272 + (id & 15) * 16;
                    vsrc[ii] = Vt + ((size_t)bh * 128 + (id >> 3)) * VP + (id & 7) * 8; vdst[ii] = ATT_KB + (id >> 3) * 136 + (id & 7) * 16; }
                u32x4 kr[2], vr[2];
#define ATT_LOAD(j_) do { _Pragma("unroll") for (int ii = 0; ii < 2; ++ii) { kr[ii] = *(const u32x4*)(ksrc[ii] + (size_t)(j_) * 64 * 128); vr[ii] = *(const u32x4*)(vsrc[ii] + (j_) * 64); } } while (0)
#define ATT_WRITE(j_) do { LAS unsigned char* bb_ = lds + ((j_) & 1) * ATT_BUF; _Pragma("unroll") for (int ii = 0; ii < 2; ++ii) { *(LAS u32x4*)(bb_ + kdst[ii]) = kr[ii]; \
        *(LAS u32x2*)(bb_ + vdst[ii]) = (u32x2){vr[ii].x, vr[ii].y}; *(LAS u32x2*)(bb_ + vdst[ii] + 8) = (u32x2){vr[ii].z, vr[ii].w}; } } while (0)
                ATT_LOAD(0); ATT_WRITE(0);
                __syncthreads();
                for (int j = 0; j < ntiles; ++j) {
                    if (j + 1 < ntiles) ATT_LOAD(j + 1);
                    if (64 * j <= qbase + 31) {
                        const LAS unsigned char* kb_ = lds + (j & 1) * ATT_BUF + r32 * 272 + c * 128 + hh * 16;
                        const LAS unsigned char* vb_ = lds + (j & 1) * ATT_BUF + ATT_KB + r32 * 136 + hh * 8;
                        f32x16 s0, s1;
#pragma unroll
                        for (int e = 0; e < 16; ++e) { s0[e] = 0.f; s1[e] = 0.f; }
#pragma unroll
                        for (int s = 0; s < 4; ++s) { s0 = mfma32(*(const LAS bf16x8*)(kb_ + s * 32), qf[s], s0); s1 = mfma32(*(const LAS bf16x8*)(kb_ + 32 * 272 + s * 32), qf[s], s1); }
                        if (64 * j + 63 > qbase) {
#pragma unroll
                            for (int e = 0; e < 16; ++e) { const int key = 64 * j + (e & 3) + 8 * (e >> 2) + 4 * hh; if (key > qpos) s0[e] = -1e30f; if (key + 32 > qpos) s1[e] = -1e30f; }
                        }
                        float tm = fmaxf(s0[0], s1[0]);
#pragma unroll
                        for (int e = 1; e < 16; ++e) tm = fmaxf(tm, fmaxf(s0[e], s1[e]));
                        tm = fmaxf(tm, __shfl_xor(tm, 32));
                        const float mnew = fmaxf(mrun, tm), alpha = __builtin_amdgcn_exp2f(mrun - mnew); mrun = mnew;
                        float rsum = 0.f;
#pragma unroll
                        for (int e = 0; e < 16; ++e) { s0[e] = __builtin_amdgcn_exp2f(s0[e] - mnew); s1[e] = __builtin_amdgcn_exp2f(s1[e] - mnew); rsum += s0[e] + s1[e]; }
                        lsum = lsum * alpha + rsum;
                        if (__builtin_amdgcn_ballot_w64(alpha != 1.0f) != 0ull) {
#pragma unroll
                            for (int d = 0; d < 4; ++d) o[d] = o[d] * alpha;
                        }
                        bf16x8 pf[4];
#pragma unroll
                        for (int s = 0; s < 4; ++s) { u32x4 w;
                            if (s < 2) { w.x = pk2(s0[8 * s], s0[8 * s + 1]); w.y = pk2(s0[8 * s + 2], s0[8 * s + 3]); w.z = pk2(s0[8 * s + 4], s0[8 * s + 5]); w.w = pk2(s0[8 * s + 6], s0[8 * s + 7]); }
                            else { const int t = s - 2; w.x = pk2(s1[8 * t], s1[8 * t + 1]); w.y = pk2(s1[8 * t + 2], s1[8 * t + 3]); w.z = pk2(s1[8 * t + 4], s1[8 * t + 5]); w.w = pk2(s1[8 * t + 6], s1[8 * t + 7]); }
                            pf[s] = __builtin_bit_cast(bf16x8, w); }
#pragma unroll
                        for (int d = 0; d < 4; ++d)
#pragma unroll
                            for (int s = 0; s < 4; ++s) {
                                const u32x2 lo = *(const LAS u32x2*)(vb_ + d * 32 * 136 + s * 32), hi = *(const LAS u32x2*)(vb_ + d * 32 * 136 + s * 32 + 16);
                                const u32x4 vv = {lo.x, lo.y, hi.x, hi.y};
                                o[d] = mfma32(__builtin_bit_cast(bf16x8, vv), pf[s], o[d]);
                            }
                    }
                    if (j + 1 < ntiles) ATT_WRITE(j + 1);
                    __syncthreads();
                }
#undef ATT_LOAD
#undef ATT_WRITE
                lsum += __shfl_xor(lsum, 32);
                const float inv = 1.0f / lsum;
                LAS float* X = (LAS float*)lds;
                if (c == 1) {
#pragma unroll
                    for (int d = 0; d < 4; ++d)
#pragma unroll
                        for (int e = 0; e < 16; ++e) X[((qg * 4 + d) * 16 + e) * 64 + lane] = o[d][e] * inv;
                }
                __syncthreads();
                if (c == 0) {
                    float sq = 0.f;
#pragma unroll
                    for (int d = 0; d < 4; ++d)
#pragma unroll
                        for (int e = 0; e < 16; ++e) { const float v = o[d][e] * inv - lam * X[((qg * 4 + d) * 16 + e) * 64 + lane]; o[d][e] = v; sq += v * v; }
                    sq += __shfl_xor(sq, 32);
                    const float rn = rsqrtf(sq * (1.0f / 128) + NORM_EPS) * 0.8f;
                    bf16* orow = XB + (size_t)(b * T + 128 * qi + 32 * qg + r32) * D + h * 128;
#pragma unroll
                    for (int d = 0; d < 4; ++d)
#pragma unroll
                        for (int g4 = 0; g4 < 4; ++g4) {
                            const int dv0 = 32 * d + 8 * g4 + 4 * hh;
                            const f32x4 sl = *(const f32x4*)(args.in[I_SUBLN] + dv0);
                            u32x2 w; w.x = pk2(o[d][4 * g4] * rn * sl.x, o[d][4 * g4 + 1] * rn * sl.y); w.y = pk2(o[d][4 * g4 + 2] * rn * sl.z, o[d][4 * g4 + 3] * rn * sl.w);
                            *(u32x2*)(orow + dv0) = w;
                        }
                }
                __syncthreads();
            }
        }
        if (bx >= 64) {
            LAS float* scr = (LAS float*)(lds + wave * 16640);
            constexpr int IT_G = (D / 64) * (FF / 64), IT_D = (FF / 64) * (D / 64), NIT = 2 * IT_G + IT_D;
            for (int it = (bx - 64) * NWAVES + wave; it < NIT; it += (G - 64) * NWAVES) {
                int r = it;
                if (r < IT_G) { transpose_item(args.in[I_F2G], D, FF, W2A, args.in[I_F2N], 1, scr, r, lane); continue; } r -= IT_G;
                if (r < IT_G) { transpose_item(args.in[I_F2U], D, FF, W2A, args.in[I_F2N], 2, scr, r, lane); continue; } r -= IT_G;
                transpose_item(args.in[I_F2D], FF, D, W2D, nullptr, 0, scr, r, lane);
            }
            unsigned* subw = (unsigned*)(sm + SM_BAR) + SUBW;
            XcdBarrier xsub; xsub.bar = (unsigned*)(sm + SM_BAR) + 4096; xsub.x = xbar.x; xsub.st = (volatile LAS unsigned*)(lds + LDS_MISC + 72); const unsigned GS = (unsigned)(G - 64);
            xcd_barrier(xsub, GS);
            wait_flag(subw + 64 * 7, 64u);
            TAIL_HALF(0, G - 64, bx - 64, xcd_barrier(xsub, GS), xcd_barrier(xsub, GS));
        }
    }
    xcd_barrier(xbar);

    TAIL_HALF(1, G, bx, xcd_barrier(xbar), xcd_barrier(xbar));
    xcd_barrier(xbar);
    {
        pg8::Gemm g{TC, W2D, M, D, FF}; pg8::StaticOrder S; S.init(M, D, G, bx);
        EpiRes E{out, out, nullptr, nullptr, 0.5f, 0, 3};
        pg8::gemm_phase<EpiRes, pg8::StaticOrder, PG8_ALIGN, PG8_SP2>(lds, g, S, E);
    }
}

extern "C" void kernel_launch(void* const* d_in, const int* in_sizes, int n_in, void* d_out, int out_size, void* d_ws, size_t ws_size, hipStream_t stream) {
    static int grid = 0;
    if (grid == 0) {
        if (n_in != 31 || out_size != M * D || ws_size < WS_END) { fprintf(stderr, "kernel_launch: unexpected shapes (n_in %d out %d ws %zu)\n", n_in, out_size, ws_size); grid = -1; return; }
        int dev = 0, cus = 0, per_cu = 0;
        (void)hipGetDevice(&dev); (void)hipDeviceGetAttribute(&cus, hipDeviceAttributeMultiprocessorCount, dev);
        if (hipFuncSetAttribute((const void*)fwd_kernel, hipFuncAttributeMaxDynamicSharedMemorySize, LDS_BYTES) != hipSuccess) { fprintf(stderr, "kernel_launch: hipFuncSetAttribute failed\n"); grid = -1; return; }
        if (hipOccupancyMaxActiveBlocksPerMultiprocessor(&per_cu, (const void*)fwd_kernel, NTHR, LDS_BYTES) != hipSuccess || per_cu < 1) { fprintf(stderr, "kernel_launch: occupancy query says %d\n", per_cu); per_cu = 1; }
        (void)hipGetLastError();
        grid = cus;
        if (grid > cus * per_cu) grid = cus * per_cu;
        if (grid > 256) grid = 256;
    }
    if (grid < 0) return;
    Args a{};
    for (int i = 0; i < 31; ++i) a.in[i] = (const float*)d_in[i];
    a.out = (float*)d_out; a.ws = (unsigned char*)d_ws;
    (void)hipMemsetAsync((unsigned char*)d_ws + WS_SMALL + SM_BAR, 0, 32768, stream);
    void* kargs[] = {&a};
    hipError_t e = hipLaunchCooperativeKernel((const void*)fwd_kernel, dim3(grid), dim3(NTHR), kargs, LDS_BYTES, stream);
    if (e != hipSuccess) fprintf(stderr, "cooperative launch failed: %s (grid %d)\n", hipGetErrorString(e), grid);
}
```

```cpp
#include <hip/hip_runtime.h>
#include <hip/hip_cooperative_groups.h>
#include <cstdio>
#include <cstdint>
namespace cg = cooperative_groups;
namespace pg8 {
#define PG8_LAS __attribute__((address_space(3)))
typedef unsigned short bf16_t;
typedef short bf16x8 __attribute__((ext_vector_type(8)));
typedef float f32x4 __attribute__((ext_vector_type(4)));
typedef unsigned u32x4 __attribute__((ext_vector_type(4)));
constexpr int BM = 256, BK = 64, HALF = 128, HTB = HALF * BK * 2  , STAGE_BYTES = 8 * HTB, NXCD = 8, WGM = 8;

__host__ __device__ __forceinline__ int lds_byte(int r, int c) { const int st = (r >> 4) * 2 + (c >> 5), rr = r & 15, cc = c & 31, ob = rr * 64 + cc * 2; return st * 1024 + (ob ^ (((ob >> 9) & 1) << 5)); }
__host__ __device__ __forceinline__ void stage_rc(int b, int& R, int& C) { const int st = b / 1024, sb = b % 1024, swz = sb ^ (((sb >> 9) & 1) << 5); R = (st >> 1) * 16 + swz / 64; C = (st & 1) * 32 + (swz % 64) / 2; }
__host__ __device__ __forceinline__ int perm32(int rho) { const int n = rho >> 4, i = rho & 15; return 8 * (i >> 2) + 4 * n + (i & 3); }

struct Unit { int pm, pn; };
struct Gemm { const bf16_t* A; const bf16_t* Bt; int M, N, K; };

struct StaticOrder {
    int nM, nN, nwg, G, c;
    __host__ __device__ void init(int M, int N, int G_, int c_) { nM = M / BM; nN = N / BM; nwg = nM * nN; G = G_; c = c_; }
    __host__ __device__ bool next(int i, Unit& u) const {
        const long L = (long)i * G + c; if (L >= nwg) return false;
        int wgid = (int)L; { const int q = nwg / NXCD, r = nwg % NXCD, xcd = wgid % NXCD, off = wgid / NXCD; wgid = (xcd < r ? xcd * (q + 1) : r * (q + 1) + (xcd - r) * q) + off; }
        const int nig = WGM * nN, gid = wgid / nig, fm = gid * WGM, gsz = (nM - fm) < WGM ? (nM - fm) : WGM;
        u.pm = fm + ((wgid % nig) % gsz); u.pn = (wgid % nig) / gsz; return true;
    }
    __device__ __forceinline__ void a_ready(const Unit&) const {}
    __device__ __forceinline__ void done(const Unit&) const {}
};
__device__ __forceinline__ unsigned cvt_pk_bf16(float lo, float hi) { unsigned r; asm volatile("v_cvt_pk_bf16_f32 %0, %1, %2" : "=v"(r) : "v"(lo), "v"(hi)); return r; }
template <class Epi, class Sched, bool ALIGN_EPI = false, bool SP2 = false>
__device__ __forceinline__ void gemm_phase(PG8_LAS unsigned char* lds, const Gemm g, const Sched& S, const Epi& E) {
    const int tid = threadIdx.x, wid = __builtin_amdgcn_readfirstlane(tid >> 6), lane = tid & 63, wr = wid >> 2, wc = wid & 3, fr = lane & 15, fq = lane >> 4;
    const int K = g.K, nt = K / BK;
    unsigned voffA[2], voffB[2];
#pragma unroll
    for (int i = 0; i < 2; ++i) { int R, C; stage_rc(tid * 16 + i * 8192, R, C); const int Rb = Epi::PERM ? ((R & ~31) + perm32(R & 31)) : R;
        voffA[i] = (unsigned)(R * K + C) * 2u; voffB[i] = (unsigned)(Rb * K + C) * 2u; }
    const size_t kstep = (size_t)(BK * 2);
    const size_t hstep = (size_t)HALF * K * 2;
    const size_t tstep = 2 * hstep;
    const unsigned ldsw = (unsigned)wid * 1024u;
    const int aoff = lds_byte(wr * 64 + fr, fq * 8), boff = lds_byte(wc * 32 + fr, fq * 8);
#define PG8_SA(b, h) (((b) * 2 + (h)) * HTB)
#define PG8_SB(b, h) ((4 + (b) * 2 + (h)) * HTB)
#define PG8_STAGE(bufoff, gbase, voff) do { _Pragma("unroll") for (int _i = 0; _i < 2; ++_i) \
        __builtin_amdgcn_global_load_lds((const unsigned*)((const char*)(gbase) + (voff)[_i]), (PG8_LAS unsigned*)(lds + (bufoff) + ldsw + _i * 8192), 16, 0, 0); } while (0)
#define PG8_LDA(dst, b, h) do { _Pragma("unroll") for (int m = 0; m < 4; ++m) _Pragma("unroll") for (int k = 0; k < 2; ++k) dst[m][k] = *(const PG8_LAS bf16x8*)(lds + PG8_SA(b, h) + aoff + m * 2048 + k * 1024); } while (0)
#define PG8_LDB(dst, b, h) do { _Pragma("unroll") for (int n = 0; n < 2; ++n) _Pragma("unroll") for (int k = 0; k < 2; ++k) dst[n][k] = *(const PG8_LAS bf16x8*)(lds + PG8_SB(b, h) + boff + n * 2048 + k * 1024); } while (0)
#define PG8_MMA(ai, bj, At, Bt) do { __builtin_amdgcn_s_setprio(1); _Pragma("unroll") for (int m = 0; m < 4; ++m) _Pragma("unroll") for (int n = 0; n < 2; ++n) _Pragma("unroll") for (int k = 0; k < 2; ++k) \
        acc[ai][bj][m][n] = __builtin_amdgcn_mfma_f32_16x16x32_bf16(Bt[n][k], At[m][k], acc[ai][bj][m][n], 0, 0, 0); __builtin_amdgcn_s_setprio(0); } while (0)
#define PG8_WAIT_V(n) asm volatile("s_waitcnt vmcnt(" #n ")" ::: "memory")
#define PG8_WAIT_L(n) asm volatile("s_waitcnt lgkmcnt(" #n ")" ::: "memory")
#define PG8_BAR __builtin_amdgcn_s_barrier()
#define PG8_SCHED __builtin_amdgcn_sched_barrier(0)
    Unit cur, nxt; int ui = 0;
    if (!S.next(0, cur)) return;
    f32x4 acc[2][2][4][2];
#pragma unroll
    for (int a = 0; a < 2; ++a)
#pragma unroll
        for (int b = 0; b < 2; ++b)
#pragma unroll
            for (int m = 0; m < 4; ++m)
#pragma unroll
                for (int n = 0; n < 2; ++n) acc[a][b][m][n] = (f32x4){0.f, 0.f, 0.f, 0.f};
    bf16x8 At[4][2], B0[2][2], B1[2][2];
    const char* cA = (const char*)g.A + (size_t)cur.pm * tstep; const char* cB = (const char*)g.Bt + (size_t)cur.pn * tstep;
    S.a_ready(cur);
    if constexpr (SP2) {
        PG8_STAGE(PG8_SB(0, 0), cB, voffB); PG8_STAGE(PG8_SB(0, 1), cB + hstep, voffB); PG8_STAGE(PG8_SA(0, 0), cA, voffA); PG8_STAGE(PG8_SA(0, 1), cA + hstep, voffA);
        if (wr == 1) PG8_BAR;
        PG8_WAIT_V(2); PG8_BAR;
        PG8_STAGE(PG8_SB(1, 0), cB + kstep, voffB); PG8_STAGE(PG8_SA(1, 0), cA + kstep, voffA); PG8_STAGE(PG8_SB(1, 1), cB + hstep + kstep, voffB);
        PG8_WAIT_V(6); PG8_BAR;
    } else {
        PG8_STAGE(PG8_SB(0, 0), cB, voffB); PG8_STAGE(PG8_SA(0, 0), cA, voffA); PG8_STAGE(PG8_SB(0, 1), cB + hstep, voffB); PG8_STAGE(PG8_SA(0, 1), cA + hstep, voffA);
        if (wr == 1) PG8_BAR;
        PG8_WAIT_V(4); PG8_BAR;
        PG8_STAGE(PG8_SB(1, 0), cB + kstep, voffB); PG8_STAGE(PG8_SA(1, 0), cA + kstep, voffA); PG8_STAGE(PG8_SB(1, 1), cB + hstep + kstep, voffB);
        PG8_WAIT_V(6); PG8_BAR;
    }
    for (;;) {
        const bool has_next = S.next(ui + 1, nxt);
        const char* nA = has_next ? (const char*)g.A + (size_t)nxt.pm * tstep : cA; const char* nB = has_next ? (const char*)g.Bt + (size_t)nxt.pn * tstep : cB;
        for (int t = 0; t < nt; t += 2) {
            const bool last = (t == nt - 2);
            const char* a1 = cA + (size_t)(t + 1) * kstep;
            const char* a2 = last ? nA : cA + (size_t)(t + 2) * kstep; const char* b2 = last ? nB : cB + (size_t)(t + 2) * kstep;
            const char* a3 = a2 + kstep; const char* b3 = b2 + kstep;
            if (last && has_next) S.a_ready(nxt);
            if constexpr (SP2) {
            PG8_LDB(B0, 0, 0); PG8_LDB(B1, 0, 1); PG8_SCHED; PG8_LDA(At, 0, 0); PG8_STAGE(PG8_SA(1, 1), a1 + hstep, voffA);
            PG8_WAIT_V(8); PG8_WAIT_L(0); PG8_BAR; PG8_MMA(0, 0, At, B0); PG8_MMA(0, 1, At, B1); PG8_BAR; PG8_SCHED;
            PG8_LDA(At, 0, 1); PG8_STAGE(PG8_SB(0, 0), b2, voffB); PG8_STAGE(PG8_SB(0, 1), b2 + hstep, voffB); PG8_STAGE(PG8_SA(0, 0), a2, voffA);
            PG8_WAIT_V(8); PG8_WAIT_L(0); PG8_BAR; PG8_MMA(1, 0, At, B0); PG8_MMA(1, 1, At, B1); PG8_BAR; PG8_SCHED;
            PG8_LDB(B0, 1, 0); PG8_LDB(B1, 1, 1); PG8_SCHED; PG8_LDA(At, 1, 0); PG8_STAGE(PG8_SA(0, 1), a2 + hstep, voffA);
            PG8_WAIT_V(8); PG8_WAIT_L(0); PG8_BAR; PG8_MMA(0, 0, At, B0); PG8_MMA(0, 1, At, B1); PG8_BAR; PG8_SCHED;
            PG8_LDA(At, 1, 1); PG8_STAGE(PG8_SB(1, 0), b3, voffB); PG8_STAGE(PG8_SB(1, 1), b3 + hstep, voffB); PG8_STAGE(PG8_SA(1, 0), a3, voffA);
            PG8_WAIT_V(8); PG8_WAIT_L(0); PG8_BAR; PG8_MMA(1, 0, At, B0); PG8_MMA(1, 1, At, B1); PG8_BAR; PG8_SCHED;
            } else {
            PG8_LDB(B0, 0, 0); PG8_SCHED; PG8_LDA(At, 0, 0); PG8_STAGE(PG8_SA(1, 1), a1 + hstep, voffA);
            PG8_WAIT_L(8); PG8_BAR; PG8_WAIT_L(0); PG8_MMA(0, 0, At, B0); PG8_BAR; PG8_SCHED;
            PG8_LDB(B1, 0, 1); PG8_STAGE(PG8_SB(0, 0), b2, voffB);
            PG8_BAR; PG8_WAIT_L(0); PG8_MMA(0, 1, At, B1); PG8_BAR;
            PG8_LDA(At, 0, 1); PG8_STAGE(PG8_SA(0, 0), a2, voffA);
            PG8_BAR; PG8_WAIT_L(0); PG8_MMA(1, 0, At, B0); PG8_BAR; PG8_SCHED;
            PG8_STAGE(PG8_SB(0, 1), b2 + hstep, voffB);
            PG8_WAIT_V(6); PG8_BAR; PG8_MMA(1, 1, At, B1); PG8_BAR;
            PG8_LDB(B0, 1, 0); PG8_SCHED; PG8_LDA(At, 1, 0); PG8_STAGE(PG8_SA(0, 1), a2 + hstep, voffA);
            PG8_WAIT_L(8); PG8_BAR; PG8_WAIT_L(0); PG8_MMA(0, 0, At, B0); PG8_BAR; PG8_SCHED;
            PG8_LDB(B1, 1, 1); PG8_STAGE(PG8_SB(1, 0), b3, voffB);
            PG8_BAR; PG8_WAIT_L(0); PG8_MMA(0, 1, At, B1); PG8_BAR;
            PG8_LDA(At, 1, 1); PG8_STAGE(PG8_SA(1, 0), a3, voffA);
            PG8_BAR; PG8_WAIT_L(0); PG8_MMA(1, 0, At, B0); PG8_BAR; PG8_SCHED;
            PG8_STAGE(PG8_SB(1, 1), b3 + hstep, voffB);
            PG8_WAIT_V(6); PG8_BAR; PG8_MMA(1, 1, At, B1); PG8_BAR;
            }
        }
        if constexpr (ALIGN_EPI) { if (wr == 0) PG8_BAR; }
        if constexpr (!Epi::AFTER_DRAIN) { E(acc, cur, wr, wc, fr, fq); S.done(cur); }
        if (!has_next) break;
#pragma unroll
        for (int a = 0; a < 2; ++a)
#pragma unroll
            for (int b = 0; b < 2; ++b)
#pragma unroll
                for (int m = 0; m < 4; ++m)
#pragma unroll
                    for (int n = 0; n < 2; ++n) acc[a][b][m][n] = (f32x4){0.f, 0.f, 0.f, 0.f};
        cur = nxt; cA = nA; cB = nB; ++ui;
        if constexpr (ALIGN_EPI) { if (wr == 1) PG8_BAR; }
    }
    PG8_WAIT_V(0);
    if constexpr (!ALIGN_EPI) { if (wr == 0) PG8_BAR; }
    PG8_BAR;
    if constexpr (Epi::AFTER_DRAIN) { E.fused(acc, cur, wr, wc, fr, fq, lds, wid, lane); S.done(cur); }
#undef PG8_SA
#undef PG8_SB
#undef PG8_STAGE
#undef PG8_LDA
#undef PG8_LDB
#undef PG8_MMA
#undef PG8_WAIT_V
#undef PG8_WAIT_L
#undef PG8_BAR
#undef PG8_SCHED
}
}
#define PG8_SP2 true
#define PG8_ALIGN true
#define LAS __attribute__((address_space(3)))
typedef unsigned short bf16;
typedef short bf16x8 __attribute__((ext_vector_type(8)));
typedef short s16x4 __attribute__((ext_vector_type(4)));
typedef float f32x4 __attribute__((ext_vector_type(4)));
typedef float f32x2 __attribute__((ext_vector_type(2)));
typedef float f32x16 __attribute__((ext_vector_type(16)));
typedef unsigned u32x4 __attribute__((ext_vector_type(4)));
typedef unsigned u32x2 __attribute__((ext_vector_type(2)));

constexpr int NWAVES = 8, NTHR = 512;
constexpr int BATCH = 2, T = 8192, D = 1024, FF = 2816, NMETA = 16, LP = 8208, M = BATCH * T, PR = BATCH * LP;
constexpr int NIN = 3360, NINP = 3584, DAW = 1536, RWW = 1824, VP = 8256;
constexpr float NORM_EPS = 1e-6f, GN_EPS = 64e-5f;
constexpr size_t MiB = 1u << 20;
constexpr size_t WS_XB = 0, WS_T = 32 * MiB, WS_URW = 32 * MiB, WS_UDA = 90 * MiB, WS_Y = 90 * MiB;
constexpr int NT0 = 21, NT1 = 32 - NT0;
constexpr size_t WS_Q = 287 * MiB / 2, QKV_BYTES = (size_t)BATCH * 4 * VP * 128 * 2, WS_K = WS_Q + QKV_BYTES, WS_VT = WS_K + QKV_BYTES;
constexpr size_t WS_W1A = 139 * MiB, WS_W1D = 150 * MiB, WS_WIN = 156 * MiB, WS_XB2 = 106 * MiB  , WS_TC = 287 * MiB / 2  , WS_W2A = 127 * MiB, WS_W2D = 138 * MiB;
constexpr size_t WS_E = 403 * MiB / 2, WS_A = 871 * MiB / 4, WS_G = 234 * MiB;
constexpr size_t WS_WOUT = 1001 * MiB / 4, WS_LORA = 505 * MiB / 2, WS_SMALL = 253 * MiB, WS_END = 255 * MiB;
static_assert(WS_VT + QKV_BYTES <= WS_E && (size_t)PR * RWW * 2 <= (WS_UDA - WS_URW) && (size_t)PR * DAW * 2 <= (WS_Q - WS_UDA) && WS_E + (size_t)PR * 512 * 2 <= WS_A && WS_A + (size_t)PR * 512 * 2 <= WS_G && WS_G + (size_t)PR * 512 * 2 <= WS_WOUT, "ws map");
static_assert(WS_TC + (size_t)M * FF * 2 <= WS_WOUT && WS_TC + (size_t)(2 * NT0 * 256) * FF * 2 <= WS_E && WS_Y + (size_t)M * 512 * 2 <= WS_XB2 && WS_XB2 + (size_t)(2 * NT0 * 256) * D * 2 <= WS_W2A && WS_W2A + (size_t)2 * FF * D * 2 <= WS_W2D && WS_W2D + (size_t)FF * D * 2 <= WS_Q, "tail ws map");
constexpr size_t SM_SSQ0 = 0, SM_SSQ1 = 65536, SM_SSQ2 = 131072, SM_BETA = 196608  , SM_XBM = 786432, SM_XBM2 = 819200, SM_TM = 851968  , SM_SSQM0 = 950272, SM_SSQM1 = 950528, SM_MISC = 950784;
constexpr int SUBW = 3584;
constexpr size_t SM_BAR = 983040;

__device__ __forceinline__ unsigned f2bf(float f) { unsigned u = __builtin_bit_cast(unsigned, f); return (u + 0x7fffu + ((u >> 16) & 1u)) >> 16; }
typedef __bf16 bf16x2_t __attribute__((ext_vector_type(2)));
__device__ __forceinline__ unsigned pk2(float lo, float hi) { const f32x2 v = {lo, hi}; return __builtin_bit_cast(unsigned, __builtin_convertvector(v, bf16x2_t)); }
__device__ __forceinline__ float bf2f(unsigned short b) { return __builtin_bit_cast(float, (unsigned)b << 16); }
__device__ __forceinline__ float bflo(unsigned w) { return __builtin_bit_cast(float, w << 16); }
__device__ __forceinline__ float bfhi(unsigned w) { return __builtin_bit_cast(float, w & 0xffff0000u); }
__device__ __forceinline__ float wave_sum(float v) {
#pragma unroll
    for (int o = 1; o < 64; o <<= 1) v += __shfl_xor(v, o);
    return v;
}
__device__ __forceinline__ float sigmoidf_(float x) { return __builtin_amdgcn_rcpf(1.0f + __expf(-x)); }
__device__ __forceinline__ u32x4 pack8(const float* v) { u32x4 w; w.x = pk2(v[0], v[1]); w.y = pk2(v[2], v[3]); w.z = pk2(v[4], v[5]); w.w = pk2(v[6], v[7]); return w; }
__device__ __forceinline__ void unpack8(u32x4 w, float* v) { v[0] = bflo(w.x); v[1] = bfhi(w.x); v[2] = bflo(w.y); v[3] = bfhi(w.y); v[4] = bflo(w.z); v[5] = bfhi(w.z); v[6] = bflo(w.w); v[7] = bfhi(w.w); }

struct Args {
    const float* in[31];
    float* out; unsigned char* ws;
};
enum { I_X = 0, I_META, I_F1N, I_F1G, I_F1U, I_F1D, I_MIXN, I_WIN, I_QN, I_KN, I_LQ1, I_LK1, I_LQ2, I_LK2, I_SUBLN, I_SHIFT, I_W0, I_W2, I_A0, I_A2, I_G2, I_KK, I_KA, I_RK, I_LNW, I_LNB, I_WOUT,
       I_F2N, I_F2G, I_F2U, I_F2D };

__device__ __forceinline__ int amap_tile(int k, int half) { const int n = half ? NT1 : NT0, base = half ? NT0 : 0; return k < n ? base + k : 32 + base + (k - n); }
__device__ __forceinline__ int cmap_tile(int pm, int half) { const int n = half ? NT1 : NT0, base = half ? NT0 : 0; return pm < 32 ? pm - base : n + (pm - 32 - base); }
struct EpiSwiglu {
    static constexpr bool PERM = true, AFTER_DRAIN = false;
    bf16* Tout; const float* ssq; int half, mode;
    __device__ __forceinline__ void operator()(const pg8::f32x4 (&acc)[2][2][4][2], const pg8::Unit& u, int wr, int wc, int fr, int fq) const {
        const int tA = mode == 1 ? amap_tile(u.pm, half) : u.pm;
        const int row0 = u.pm * 256 + wr * 64 + fr, row0A = tA * 256 + wr * 64 + fr, hc0 = u.pn * 128 + wc * 32 + 8 * fq;
#pragma unroll
        for (int ai = 0; ai < 2; ++ai)
#pragma unroll
            for (int m = 0; m < 4; ++m) {
                const int row = row0 + ai * 128 + m * 16;
                const float rs = rsqrtf(ssq[row0A + ai * 128 + m * 16] * (1.0f / D) + NORM_EPS);
                float t[8];
#pragma unroll
                for (int n = 0; n < 2; ++n)
#pragma unroll
                    for (int e = 0; e < 4; ++e) { const float g = acc[ai][0][m][n][e] * rs, up = acc[ai][1][m][n][e] * rs; t[4 * n + e] = g * sigmoidf_(g) * up; }
                *(u32x4*)(Tout + (size_t)row * FF + hc0) = pack8(t);
            }
    }
};
struct EpiRes {
    static constexpr bool PERM = true, AFTER_DRAIN = false;
    const float* base; float* out; bf16* xb; float* ssq; float scale; int half, mode;
    __device__ __forceinline__ void operator()(const pg8::f32x4 (&acc)[2][2][4][2], const pg8::Unit& u, int wr, int wc, int fr, int fq) const {
        const int tA = mode == 2 ? amap_tile(u.pm, half) : (mode == 3 ? (u.pm < 2 * NT0 ? amap_tile(u.pm, 0) : amap_tile(u.pm - 2 * NT0, 1)) : u.pm), tC = mode == 1 ? cmap_tile(u.pm, half) : u.pm;
        const int row0 = tA * 256 + wr * 64 + fr, row0C = tC * 256 + wr * 64 + fr, col0 = u.pn * 256 + wc * 32 + 8 * fq;
#pragma unroll
        for (int ai = 0; ai < 2; ++ai)
#pragma unroll
            for (int m = 0; m < 4; ++m) {
                const int row = row0 + ai * 128 + m * 16, rowC = row0C + ai * 128 + m * 16; float s = 0.f;
#pragma unroll
                for (int bj = 0; bj < 2; ++bj) {
                    const size_t o = (size_t)row * D + col0 + bj * 128, oC = (size_t)rowC * D + col0 + bj * 128;
                    const f32x4 b0 = *(const f32x4*)(base + o), b1 = *(const f32x4*)(base + o + 4);
                    const f32x4 h0 = b0 + acc[ai][bj][m][0] * scale, h1 = b1 + acc[ai][bj][m][1] * scale;
                    *(f32x4*)(out + o) = h0; *(f32x4*)(out + o + 4) = h1;
                    if (xb) { u32x4 w; w.x = pk2(h0[0], h0[1]); w.y = pk2(h0[2], h0[3]); w.z = pk2(h1[0], h1[1]); w.w = pk2(h1[2], h1[3]); *(u32x4*)(xb + oC) = w; }
                    s += (h0[0] * h0[0] + h0[1] * h0[1]) + (h0[2] * h0[2] + h0[3] * h0[3]) + (h1[0] * h1[0] + h1[1] * h1[1]) + (h1[2] * h1[2] + h1[3] * h1[3]);
                }
                if (ssq) { s += __shfl_xor(s, 16); s += __shfl_xor(s, 32); if (fq == 0) atomicAdd(ssq + row, s); }
            }
    }
};
struct HalfOrder {
    pg8::StaticOrder so; int half, actual;
    __device__ __forceinline__ void init(int N, int G_, int c_, int half_, int actual_) { so.init((half_ ? 2 * NT1 : 2 * NT0) * 256, N, G_, c_); half = half_; actual = actual_; }
    __device__ __forceinline__ bool next(int i, pg8::Unit& u) const { if (!so.next(i, u)) return false; if (actual) u.pm = amap_tile(u.pm, half); return true; }
    __device__ __forceinline__ void a_ready(const pg8::Unit&) const {}
    __device__ __forceinline__ void done(const pg8::Unit&) const {}
};
struct EpiU {
    static constexpr bool PERM = true, AFTER_DRAIN = false;
    bf16* uda; bf16* urw; const float* ssq;
    __device__ __forceinline__ void operator()(const pg8::f32x4 (&acc)[2][2][4][2], const pg8::Unit& u, int wr, int wc, int fr, int fq) const {
        const int row0 = u.pm * 256 + wr * 64 + fr, col0 = u.pn * 256 + wc * 32 + 8 * fq;
#pragma unroll
        for (int ai = 0; ai < 2; ++ai)
#pragma unroll
            for (int m = 0; m < 4; ++m) {
                const int row = row0 + ai * 128 + m * 16;
                const int pr = (row >> 13) * LP + NMETA + (row & 8191);
                const float rs = rsqrtf(ssq[row] * (1.0f / D) + NORM_EPS);
#pragma unroll
                for (int bj = 0; bj < 2; ++bj) {
                    const int c = col0 + bj * 128;
                    if (c < NIN) {
                        float t[8];
#pragma unroll
                        for (int n = 0; n < 2; ++n)
#pragma unroll
                            for (int e = 0; e < 4; ++e) t[4 * n + e] = acc[ai][bj][m][n][e] * rs;
                        bf16* dst = (c < DAW) ? (uda + (size_t)pr * DAW + c) : (urw + (size_t)pr * RWW + (c - DAW));
                        *(u32x4*)dst = pack8(t);
                    }
                }
            }
    }
};

__device__ __forceinline__ f32x4 mfma16(bf16x8 a, bf16x8 b, f32x4 c) { return __builtin_amdgcn_mfma_f32_16x16x32_bf16(a, b, c, 0, 0, 0); }
__device__ __forceinline__ f32x16 mfma32(bf16x8 a, bf16x8 b, f32x16 c) { return __builtin_amdgcn_mfma_f32_32x32x16_bf16(a, b, c, 0, 0, 0); }
__device__ __forceinline__ f32x4 mm16(const bf16* A, int lda, const bf16* Bt, int ldb, int K, int lane) {
    const int r = lane & 15, q = lane >> 4;
    const bf16x8* ap = (const bf16x8*)(A + (size_t)r * lda + 8 * q);
    const bf16x8* bp = (const bf16x8*)(Bt + (size_t)r * ldb + 8 * q);
    f32x4 acc = {0.f, 0.f, 0.f, 0.f};
#pragma unroll 8
    for (int kk = 0; kk < K / 32; ++kk) acc = mfma16(ap[4 * kk], bp[4 * kk], acc);
    return acc;
}
__device__ __forceinline__ void transpose_item(const float* W, int K, int N, bf16* WT, const float* gain, int mode, LAS float* scr, int item, int lane) {
    const int nblk = (N + 63) / 64, kb = item / nblk, nb = item % nblk, k0 = 64 * kb, n0 = 64 * nb;
    const int r4 = lane >> 4, c4 = (lane & 15) * 4;
    const bool colok = n0 + c4 < N;
#pragma unroll
    for (int i = 0; i < 16; ++i) {
        const int kk = r4 + 4 * i;
        f32x4 v = {0.f, 0.f, 0.f, 0.f};
        if (colok) v = *(const f32x4*)(W + (size_t)(k0 + kk) * N + n0 + c4);
        if (gain) v = v * gain[k0 + kk];
        LAS float* d = scr + kk * 65 + c4; d[0] = v.x; d[1] = v.y; d[2] = v.z; d[3] = v.w;
    }
    asm volatile("s_waitcnt lgkmcnt(0)" ::: "memory");
    const int c = lane & 7;
#pragma unroll
    for (int j = 0; j < 8; ++j) {
        const int nl = (lane >> 3) + 8 * j, n = n0 + nl; const LAS float* s = scr + (8 * c) * 65 + nl;
        const int orow = (mode == 0) ? n : ((n >> 7) * 256 + (n & 127) + (mode == 2 ? 128 : 0));
        u32x4 o; o.x = pk2(s[0 * 65], s[1 * 65]); o.y = pk2(s[2 * 65], s[3 * 65]); o.z = pk2(s[4 * 65], s[5 * 65]); o.w = pk2(s[6 * 65], s[7 * 65]);
        if (n < N) *(u32x4*)(WT + (size_t)orow * K + k0 + 8 * c) = o;
    }
    asm volatile("s_waitcnt lgkmcnt(0)" ::: "memory");
}
__device__ __forceinline__ void row_to_bf16(const float* xrow, bf16* orow, float* ssq_out, int lane) {
    const f32x4* xr = (const f32x4*)xrow + lane; f32x4 v[4]; float s = 0.f;
#pragma unroll
    for (int j = 0; j < 4; ++j) { v[j] = xr[64 * j]; s += (v[j].x * v[j].x + v[j].y * v[j].y) + (v[j].z * v[j].z + v[j].w * v[j].w); }
    s = wave_sum(s); if (lane == 0) *ssq_out = s;
    u32x2* o8 = (u32x2*)orow + lane;
#pragma unroll
    for (int j = 0; j < 4; ++j) { u32x2 w; w.x = pk2(v[j].x, v[j].y); w.y = pk2(v[j].z, v[j].w); o8[64 * j] = w; }
}
__device__ __forceinline__ float dpp_f(float x, int ctrl_sel) {
    const int xi = __builtin_bit_cast(int, x); int r;
    if (ctrl_sel == 0) r = __builtin_amdgcn_update_dpp(0, xi, 0xB1, 0xF, 0xF, true);
    else if (ctrl_sel == 1) r = __builtin_amdgcn_update_dpp(0, xi, 0x4E, 0xF, 0xF, true);
    else if (ctrl_sel == 2) r = __builtin_amdgcn_update_dpp(0, xi, 0x141, 0xF, 0xF, true);
    else r = __builtin_amdgcn_update_dpp(0, xi, 0x140, 0xF, 0xF, true);
    return __builtin_bit_cast(float, r);
}
__device__ __forceinline__ float fmul_s(float a, float b) { float r; asm("v_mul_f32_e32 %0, %1, %2" : "=v"(r) : "v"(a), "v"(b)); return r; }
__device__ __forceinline__ float fadd_s(float a, float b) { float r; asm("v_add_f32_e32 %0, %1, %2" : "=v"(r) : "v"(a), "v"(b)); return r; }
__device__ __forceinline__ float fsub_s(float a, float b) { float r; asm("v_sub_f32_e32 %0, %1, %2" : "=v"(r) : "v"(a), "v"(b)); return r; }
__device__ __forceinline__ float ffma_s(float a, float b, float c) { float r; asm("v_fma_f32 %0, %1, %2, %3" : "=v"(r) : "v"(a), "v"(b), "v"(c)); return r; }
__device__ __forceinline__ float sum16(float x) { x += dpp_f(x, 0); x += dpp_f(x, 1); x += dpp_f(x, 2); x += dpp_f(x, 3); return x; }

#define XB_TMO      128
#define XB_XCNT(j)  (256  + 64 * (j))
#define XB_XSUB(j)  (1280 + 64 * (j))
#define XB_XGEN(j)  (2304 + 64 * (j))
#define XB_TOP      3328
#define XB_TOPGEN   3392
#define XCD_BAR_WORDS 3456
#define XB_SPIN_CAP (1u << 18)

__device__ __forceinline__ unsigned xb_ld(unsigned* p)              { return __hip_atomic_load(p, __ATOMIC_RELAXED, __HIP_MEMORY_SCOPE_AGENT); }
__device__ __forceinline__ unsigned xb_add(unsigned* p, unsigned v) { return __hip_atomic_fetch_add(p, v, __ATOMIC_RELAXED, __HIP_MEMORY_SCOPE_AGENT); }
__device__ __forceinline__ unsigned xb_xcc_id() { return (unsigned)__builtin_amdgcn_s_getreg((3 << 11) | 20) & 0xFu; }
#define XB_SPIN(cond, bar) do { unsigned _sp = 0; while (cond) { __builtin_amdgcn_s_sleep(1); \
    if ((++_sp & 255u) == 0u) { if (xb_ld(&(bar)[XB_TMO])) break; if (_sp > XB_SPIN_CAP) { atomicAdd(&(bar)[XB_TMO], 1u); break; } } } } while (0)

struct XcdBarrier {
    unsigned* bar; unsigned x;
    volatile LAS unsigned* st;
};

__device__ __forceinline__ XcdBarrier xcd_barrier_post(unsigned* bar, volatile LAS unsigned* st) {
    XcdBarrier b; b.bar = bar; b.x = xb_xcc_id(); b.st = st;
    if (threadIdx.x == 0) (void)xb_add(&bar[XB_XCNT(b.x)], 1u);
    return b;
}
__device__ __forceinline__ void xcd_barrier_complete(unsigned* bar, unsigned x, unsigned& nloc, unsigned& nx, unsigned gsz) {
    const unsigned G = gsz;
    unsigned sum, cnt, mine, sp = 0u;
    for (;;) {
        sum = 0u; cnt = 0u; mine = 0u;
#pragma unroll
        for (unsigned j = 0; j < 16; ++j) { const unsigned c = xb_ld(&bar[XB_XCNT(j)]); sum += c; cnt += (c > 0u) ? 1u : 0u; mine = (j == x) ? c : mine; }
        if (sum == G) break;
        __builtin_amdgcn_s_sleep(1);
        if ((++sp & 255u) == 0u) { if (xb_ld(&bar[XB_TMO])) break; if (sp > XB_SPIN_CAP) { atomicAdd(&bar[XB_TMO], 1u); break; } }
    }
    nloc = mine > 0u ? mine : 1u; nx = cnt > 0u ? cnt : 1u;
}

__device__ __forceinline__ void xcd_barrier(const XcdBarrier& b, unsigned gsz = 0u) {
    asm volatile("s_waitcnt vmcnt(0)" ::: "memory");
    __syncthreads();
    if (threadIdx.x == 0) {
        unsigned* bar = b.bar;
        __builtin_amdgcn_s_waitcnt(0);
        unsigned nloc = b.st[0], nx = b.st[1];
        if (nloc == 0u) { xcd_barrier_complete(bar, b.x, nloc, nx, gsz ? gsz : gridDim.x); b.st[0] = nloc; b.st[1] = nx; }
        const unsigned old = xb_add(&bar[XB_XSUB(b.x)], 1u);
        const unsigned gen = old / nloc;
        if (old + 1u == (gen + 1u) * nloc) {
            __builtin_amdgcn_fence(__ATOMIC_RELEASE, "agent");
            asm volatile("s_waitcnt vmcnt(0)" ::: "memory");
            const unsigned og = xb_add(&bar[XB_TOP], 1u);
            const unsigned tg = og / nx;
            if (og + 1u == (tg + 1u) * nx) xb_add(&bar[XB_TOPGEN], 1u);
            else XB_SPIN(xb_ld(&bar[XB_TOPGEN]) == tg, bar);
            __builtin_amdgcn_fence(__ATOMIC_ACQUIRE, "agent");
            xb_add(&bar[XB_XGEN(b.x)], 1u);
            asm volatile("s_waitcnt vmcnt(0)" ::: "memory");
        } else {
            XB_SPIN(xb_ld(&bar[XB_XGEN(b.x)]) == gen, bar);
            __builtin_amdgcn_fence(__ATOMIC_ACQUIRE, "agent");
            asm volatile("s_waitcnt vmcnt(0)" ::: "memory");
        }
    }
    __syncthreads();
}

__device__ __forceinline__ void p6_half(const bf16* URW, const bf16* Ab, const bf16* Gb, const bf16* Y, bf16* XB, const float* mixp, const float* ka, const float* rk, const float* lnwp, const float* lnbp,
                                        int half, int wi, int nw, int lane) {
    const int c0 = 8 * lane;
    float mr[8], mk[8], mv[8], kac[8], rkc[8], lnw[8], lnb[8];
#pragma unroll
    for (int j = 0; j < 8; ++j) { mr[j] = mixp[c0 + j]; mk[j] = mixp[512 + c0 + j]; mv[j] = mixp[1024 + c0 + j]; kac[j] = ka[c0 + j]; rkc[j] = rk[c0 + j]; lnw[j] = lnwp[c0 + j]; lnb[j] = lnbp[c0 + j]; }
    for (int r = wi; r < (half ? 2 * NT1 : 2 * NT0) * 256; r += nw) {
        const int m = amap_tile(r >> 8, half) * 256 + (r & 255);
        const int b = m >> 13, t = m & 8191, pr = b * LP + NMETA + t;
        const bf16* cur = URW + (size_t)pr * RWW + c0; const bf16* prv = cur - RWW;
        float rc[8], rp[8], kc[8], kp[8], vc[8], vp[8], a8[8], g8[8], y[8];
        unpack8(*(const u32x4*)cur, rc); unpack8(*(const u32x4*)prv, rp); unpack8(*(const u32x4*)(cur + 512), kc); unpack8(*(const u32x4*)(prv + 512), kp);
        unpack8(*(const u32x4*)(cur + 1024), vc); unpack8(*(const u32x4*)(prv + 1024), vp);
        unpack8(*(const u32x4*)(Ab + (size_t)pr * 512 + c0), a8); unpack8(*(const u32x4*)(Gb + (size_t)pr * 512 + c0), g8);
        unpack8(*(const u32x4*)(Y + (size_t)m * 512 + c0), y);
        float s = 0.f, beta = 0.f;
#pragma unroll
        for (int j = 0; j < 8; ++j) { s += y[j]; const float r_ = rc[j] + (rp[j] - rc[j]) * mr[j], k_ = kc[j] + (kp[j] - kc[j]) * mk[j]; beta += r_ * (k_ * (1.0f + (a8[j] - 1.0f) * kac[j])) * rkc[j]; }
        s += __shfl_xor(s, 1); s += __shfl_xor(s, 2); s += __shfl_xor(s, 4);
        beta += __shfl_xor(beta, 1); beta += __shfl_xor(beta, 2); beta += __shfl_xor(beta, 4);
        const float mu = s * (1.0f / 64); float q = 0.f;
#pragma unroll
        for (int j = 0; j < 8; ++j) { y[j] -= mu; q += y[j] * y[j]; }
        q += __shfl_xor(q, 1); q += __shfl_xor(q, 2); q += __shfl_xor(q, 4);
        const float rstd = rsqrtf(q * (1.0f / 64) + GN_EPS);
        float o[8];
#pragma unroll
        for (int j = 0; j < 8; ++j) { const float v_ = vc[j] + (vp[j] - vc[j]) * mv[j]; o[j] = (y[j] * rstd * lnw[j] + lnb[j] + beta * v_) * g8[j]; }
        *(u32x4*)(XB + (size_t)m * D + 512 + c0) = pack8(o);
    }
}
#define TAIL_HALF(HALF_, GS_, CI_, BAR1_, BAR2_) do { \
        p6_half(URW, Ab, Gb, Y, XB, args.in[I_SHIFT], args.in[I_KA], args.in[I_RK], args.in[I_LNW], args.in[I_LNB], (HALF_), (CI_) * NWAVES + wave, (GS_) * NWAVES, lane); \
        BAR1_; \
        { pg8::Gemm g{XB, WOUT, M / 2, D, D}; HalfOrder S; S.init(D, (GS_), (CI_), (HALF_), 1); EpiRes E{out, out, XB2, ssq2, 1.0f, (HALF_), 1}; \
          pg8::gemm_phase<EpiRes, HalfOrder, PG8_ALIGN, PG8_SP2>(lds, g, S, E); } \
        BAR2_; \
        { pg8::Gemm g{XB2, W2A, M / 2, 2 * FF, D}; HalfOrder S; S.init(2 * FF, (GS_), (CI_), (HALF_), 0); EpiSwiglu E{TC + (size_t)((HALF_) ? 2 * NT0 * 256 : 0) * FF, ssq2, (HALF_), 1}; \
          pg8::gemm_phase<EpiSwiglu, HalfOrder, PG8_ALIGN, PG8_SP2>(lds, g, S, E); } \
    } while (0)
__device__ __forceinline__ void sub_barrier(unsigned* ctr, unsigned target) {
    asm volatile("s_waitcnt vmcnt(0)" ::: "memory");
    __syncthreads();
    if (threadIdx.x == 0) {
        __builtin_amdgcn_fence(__ATOMIC_RELEASE, "agent"); asm volatile("s_waitcnt vmcnt(0)" ::: "memory");
        __hip_atomic_fetch_add(ctr, 1u, __ATOMIC_RELAXED, __HIP_MEMORY_SCOPE_AGENT);
        unsigned sp = 0;
        while (__hip_atomic_load(ctr, __ATOMIC_RELAXED, __HIP_MEMORY_SCOPE_AGENT) < target) { __builtin_amdgcn_s_sleep(2); if (++sp > (1u << 22)) break; }
        __builtin_amdgcn_fence(__ATOMIC_ACQUIRE, "agent"); asm volatile("s_waitcnt vmcnt(0)" ::: "memory");
    }
    __syncthreads();
}
__device__ __forceinline__ void wait_flag(unsigned* ctr, unsigned target) {
    if (threadIdx.x == 0) {
        unsigned sp = 0;
        while (__hip_atomic_load(ctr, __ATOMIC_RELAXED, __HIP_MEMORY_SCOPE_AGENT) < target) { __builtin_amdgcn_s_sleep(4); if (++sp > (1u << 22)) break; }
        __builtin_amdgcn_fence(__ATOMIC_ACQUIRE, "agent"); asm volatile("s_waitcnt vmcnt(0)" ::: "memory");
    }
    __syncthreads();
}
constexpr int LDS_BYTES = 147456;
constexpr int ATT_KB = 64 * 272, ATT_VB = 128 * 136, ATT_BUF = ATT_KB + ATT_VB;
constexpr int LDS_MISC = 143360;
constexpr int SCAN_STEP_F = 384, SCAN_CH = 32;

__global__ void __launch_bounds__(NTHR, 2) fwd_kernel(Args args) {
    extern __shared__ __attribute__((aligned(16))) unsigned char lds_raw[];
    LAS unsigned char* lds = (LAS unsigned char*)lds_raw;
    const int tid = threadIdx.x, lane = tid & 63, wave = __builtin_amdgcn_readfirstlane(tid >> 6);
    const int G = gridDim.x, bx = blockIdx.x;
    const int gw = bx * NWAVES + wave, NGW = G * NWAVES;
    unsigned char* ws = args.ws;
    bf16* XB = (bf16*)(ws + WS_XB); bf16* TB = (bf16*)(ws + WS_T); bf16* URW = (bf16*)(ws + WS_URW); bf16* UDA = (bf16*)(ws + WS_UDA); bf16* Y = (bf16*)(ws + WS_Y); bf16* TC = (bf16*)(ws + WS_TC);
    bf16* Qb = (bf16*)(ws + WS_Q); bf16* Kb = (bf16*)(ws + WS_K); bf16* Vt = (bf16*)(ws + WS_VT);
    bf16* W1A = (bf16*)(ws + WS_W1A); bf16* W1D = (bf16*)(ws + WS_W1D); bf16* WIN = (bf16*)(ws + WS_WIN); bf16* XB2 = (bf16*)(ws + WS_XB2);
    bf16* W2A = (bf16*)(ws + WS_W2A); bf16* W2D = (bf16*)(ws + WS_W2D);
    bf16* Eb = (bf16*)(ws + WS_E); bf16* Ab = (bf16*)(ws + WS_A); bf16* Gb = (bf16*)(ws + WS_G);
    bf16* WOUT = (bf16*)(ws + WS_WOUT);
    bf16* W2T = (bf16*)(ws + WS_LORA); bf16* A2T = W2T + 512 * 64; bf16* G2T = A2T + 512 * 64;
    unsigned char* sm = ws + WS_SMALL;
    float* ssq0 = (float*)(sm + SM_SSQ0); float* ssq1 = (float*)(sm + SM_SSQ1); float* ssq2 = (float*)(sm + SM_SSQ2); float* INV = (float*)(sm + SM_BETA);
    bf16* XBM = (bf16*)(sm + SM_XBM); bf16* XBM2 = (bf16*)(sm + SM_XBM2); bf16* TM = (bf16*)(sm + SM_TM);
    float* ssqm0 = (float*)(sm + SM_SSQM0); float* ssqm1 = (float*)(sm + SM_SSQM1); float* misc = (float*)(sm + SM_MISC); unsigned* qctr = (unsigned*)(misc + 16);
    const float* x = args.in[I_X];
    float* out = args.out;
    if (tid < 4) ((LAS unsigned*)(lds + LDS_MISC + 64))[tid] = 0u;
    __syncthreads();
    const XcdBarrier xbar = xcd_barrier_post((unsigned*)(sm + SM_BAR), (volatile LAS unsigned*)(lds + LDS_MISC + 64));
    if (bx >= 64 && tid == 0) (void)xb_add(&((unsigned*)(sm + SM_BAR) + 4096)[XB_XCNT(xbar.x)], 1u);

    {
        LAS float* scr = (LAS float*)(lds + wave * 16640);
        constexpr int IT_G = (D / 64) * (FF / 64);
        for (int it = gw; it < 2 * IT_G; it += NGW) {
            if (it < IT_G) transpose_item(args.in[I_F1G], D, FF, W1A, args.in[I_F1N], 1, scr, it, lane);
            else transpose_item(args.in[I_F1U], D, FF, W1A, args.in[I_F1N], 2, scr, it - IT_G, lane);
        }
        for (int m = gw; m < M; m += NGW) row_to_bf16(x + (size_t)m * D, XB + (size_t)m * D, ssq0 + m, lane);
        if (gw < NMETA) row_to_bf16(args.in[I_META] + (size_t)gw * D, XBM + (size_t)gw * D, ssqm0 + gw, lane);
        const int gt = bx * NTHR + tid, NGT = G * NTHR;
        for (int i = gt; i < M; i += NGT) { ssq1[i] = 0.f; ssq2[i] = 0.f; }
        if (gt < 16) ssqm1[gt] = 0.f;
        if (gt == 0) { qctr[0] = 0u; qctr[1] = 0u; }
        for (int i = gt; i < 512 * 64; i += NGT) { const int n = i >> 6, k = i & 63; W2T[i] = (bf16)f2bf(args.in[I_W2][k * 512 + n]); A2T[i] = (bf16)f2bf(args.in[I_A2][k * 512 + n]); }
        for (int i = gt; i < 512 * 160; i += NGT) { const int n = i / 160, k = i % 160; G2T[i] = (bf16)f2bf(args.in[I_G2][k * 512 + n]); }
        if (gw == 0) {
            const float s1 = wave_sum(args.in[I_LQ1][lane] * args.in[I_LK1][lane]), s2 = wave_sum(args.in[I_LQ2][lane] * args.in[I_LK2][lane]);
            if (lane == 0) misc[0] = expf(s1) - expf(s2) + 0.2f;
        }
    }
    xcd_barrier(xbar);

    {
        const int mw1 = (G == 256) ? (bx >= 128 ? (bx - 128) * NWAVES + wave : (1 << 30)) : gw, ms1 = (G == 256) ? 128 * NWAVES : NGW;
        for (int hc = mw1; hc < FF / 16; hc += ms1) {
            const int grow = (hc >> 3) * 256 + (hc & 7) * 16;
            const f32x4 ag = mm16(XBM, D, W1A + (size_t)grow * D, D, D, lane), au = mm16(XBM, D, W1A + (size_t)(grow + 128) * D, D, D, lane);
#pragma unroll
            for (int e = 0; e < 4; ++e) { const int row = 4 * (lane >> 4) + e; const float rs = rsqrtf(ssqm0[row] * (1.0f / D) + NORM_EPS); const float g = ag[e] * rs, up = au[e] * rs;
                TM[row * FF + hc * 16 + (lane & 15)] = (bf16)f2bf(g * sigmoidf_(g) * up); }
        }
        pg8::Gemm g{XB, W1A, M, 2 * FF, D}; pg8::StaticOrder S; S.init(M, 2 * FF, G, bx);
        EpiSwiglu E{TB, ssq0, 0, 0};
        pg8::gemm_phase<EpiSwiglu, pg8::StaticOrder, PG8_ALIGN, PG8_SP2>(lds, g, S, E);
        if (G == 256 ? bx >= 128 : true) {
            LAS float* scr = (LAS float*)(lds + wave * 16640);
            constexpr int IT_D = (FF / 64) * (D / 64), IT_IN = (D / 64) * ((NIN + 63) / 64), IT_O = (D / 64) * (D / 64), NIT = IT_D + IT_IN + IT_O;
            const int nb = (G == 256) ? 128 : G, b0 = (G == 256) ? 128 : 0;
            for (int it = (bx - b0) * NWAVES + wave; it < NIT; it += nb * NWAVES) {
                int r = it;
                if (r < IT_D) { transpose_item(args.in[I_F1D], FF, D, W1D, nullptr, 0, scr, r, lane); continue; } r -= IT_D;
                if (r < IT_IN) { transpose_item(args.in[I_WIN], D, NIN, WIN, args.in[I_MIXN], 0, scr, r, lane); continue; } r -= IT_IN;
                transpose_item(args.in[I_WOUT], D, D, WOUT, nullptr, 0, scr, r, lane);
            }
        }
    }
    xcd_barrier(xbar);

    {
        for (int cb = bx; cb < D / 16; cb += G) {
            f32x4 a = mm16(TM + 352 * wave, FF, W1D + (size_t)cb * 16 * FF + 352 * wave, FF, 352, lane);
            LAS f32x4* red = (LAS f32x4*)lds;
            red[wave * 64 + lane] = a;
            __syncthreads();
            if (wave == 0) {
#pragma unroll
                for (int w8 = 1; w8 < 8; ++w8) a += red[w8 * 64 + lane];
#pragma unroll
                for (int e = 0; e < 4; ++e) { const int row = 4 * (lane >> 4) + e, col = cb * 16 + (lane & 15); const float h = args.in[I_META][row * D + col] + 0.5f * a[e];
                    XBM2[row * D + col] = (bf16)f2bf(h); float s = h * h; s += __shfl_xor(s, 1); s += __shfl_xor(s, 2); s += __shfl_xor(s, 4); s += __shfl_xor(s, 8);
                    if ((lane & 15) == 0) atomicAdd(ssqm1 + row, s); }
            }
            __syncthreads();
        }
        pg8::Gemm g{TB, W1D, M, D, FF}; pg8::StaticOrder S; S.init(M, D, G, bx);
        EpiRes E{x, out, XB, ssq1, 0.5f, 0, 0};
        pg8::gemm_phase<EpiRes, pg8::StaticOrder, PG8_ALIGN, PG8_SP2>(lds, g, S, E);
    }
    xcd_barrier(xbar);

    {
        const int mw3 = (G == 256) ? (bx >= 128 ? (bx - 128) * NWAVES + wave : (1 << 30)) : gw, ms3 = (G == 256) ? 128 * NWAVES : NGW;
        for (int cb = mw3; cb < NIN / 16; cb += ms3) {
            const f32x4 a = mm16(XBM2, D, WIN + (size_t)cb * 16 * D, D, D, lane);
#pragma unroll
            for (int e = 0; e < 4; ++e) { const int row = 4 * (lane >> 4) + e, col = cb * 16 + (lane & 15); const float rs = rsqrtf(ssqm1[row] * (1.0f / D) + NORM_EPS);
                const bf16 v = (bf16)f2bf(a[e] * rs);
#pragma unroll
                for (int b = 0; b < BATCH; ++b) { const int pr = b * LP + row; if (col < DAW) UDA[(size_t)pr * DAW + col] = v; else URW[(size_t)pr * RWW + col - DAW] = v; } }
        }
        pg8::Gemm g{XB, WIN, M, NINP, D}; pg8::StaticOrder S; S.init(M, NINP, G, bx);
        EpiU E{UDA, URW, ssq1};
        pg8::gemm_phase<EpiU, pg8::StaticOrder, PG8_ALIGN, PG8_SP2>(lds, g, S, E);
    }
    xcd_barrier(xbar);

    constexpr int PFXG = 65, PFX = PFXG * 16;
    unsigned* p4flag = (unsigned*)(sm + SM_BAR) + SUBW + 64 * 6;
    { constexpr int pass = 0;
        const int wg0 = pass ? bx - 64 : bx, nwg = pass ? G - 64 : G;
        int zo = 0; asm volatile("" : "+s"(zo));
        if (pass == 0) {
            const int e8 = lane & 7, d0 = e8 * 8, grp = lane >> 3, hh = grp >> 1, cc = grp & 1;
            float qn[8], kn[8];
#pragma unroll
            for (int j = 0; j < 8; ++j) { qn[j] = args.in[I_QN][d0 + j + zo]; kn[j] = args.in[I_KN][d0 + j + zo]; }
            float kmix[8], kkc8[8];
#pragma unroll
            for (int j = 0; j < 8; ++j) { kmix[j] = args.in[I_SHIFT][512 + 8 * lane + j + zo]; kkc8[j] = args.in[I_KK][8 * lane + j + zo]; }
            const double invf[8] = {1.0, 0.19392274474868576, 0.03760603093086393, 0.007292664737217109, 0.001414213562373095, 0.0002742481756762073, 5.318295896944988e-05, 1.031338537721246e-05};
            const int np = LP, p00 = 0;
            for (int i = wg0 * NWAVES + wave; i < BATCH * np; i += nwg * NWAVES) {
                const int b = i / np, p = p00 + (i - b * np), pr = b * LP + p;
                const bf16* urow = UDA + (size_t)pr * DAW;
                float q[8], k[8];
                unpack8(*(const u32x4*)(urow + 8 * lane), q); unpack8(*(const u32x4*)(urow + 512 + 8 * lane), k);
                float sq = 0.f, sk = 0.f;
#pragma unroll
                for (int j = 0; j < 8; ++j) { sq += q[j] * q[j]; sk += k[j] * k[j]; }
                sq += __shfl_xor(sq, 1); sq += __shfl_xor(sq, 2); sq += __shfl_xor(sq, 4);
                sk += __shfl_xor(sk, 1); sk += __shfl_xor(sk, 2); sk += __shfl_xor(sk, 4);
                const float rq = rsqrtf(sq * (1.0f / 64) + NORM_EPS), rk = rsqrtf(sk * (1.0f / 64) + NORM_EPS);
#pragma unroll
                for (int j = 0; j < 8; ++j) { q[j] *= rq * qn[j]; k[j] *= rk * kn[j]; }
#pragma unroll
                for (int j = 0; j < 8; ++j) {
                    const float qo = __shfl_xor(q[j], 1), ko = __shfl_xor(k[j], 1);
                    if (e8 < 2) {
                        double rev = (double)p * invf[j] * 0.15915494309189535; rev -= floor(rev);
                        const float rf = (float)rev, cs = __builtin_amdgcn_cosf(rf), sn = __builtin_amdgcn_sinf(rf);
                        if (e8 == 0) { q[j] = q[j] * cs - qo * sn; k[j] = k[j] * cs - ko * sn; }
                        else         { q[j] = q[j] * cs + qo * sn; k[j] = k[j] * cs + ko * sn; }
                    }
                }
#pragma unroll
                for (int j = 0; j < 8; ++j) q[j] *= 0.18033688011112042f;
                const size_t o = ((size_t)(b * 4 + hh) * VP + p) * 128 + cc * 64 + d0;
                *(u32x4*)(Qb + o) = pack8(q); *(u32x4*)(Kb + o) = pack8(k);
                {
                    const bf16* rrow = URW + (size_t)pr * RWW + 512 + 8 * lane;
                    float kc[8], kp8[8];
                    unpack8(*(const u32x4*)rrow, kc);
                    if (p > 0) unpack8(*(const u32x4*)(rrow - RWW), kp8); else {
#pragma unroll
                        for (int j = 0; j < 8; ++j) kp8[j] = 0.f; }
                    float ss = 0.f;
#pragma unroll
                    for (int j = 0; j < 8; ++j) { const float kv = (kc[j] + (kp8[j] - kc[j]) * kmix[j]) * kkc8[j]; ss += kv * kv; }
                    ss += __shfl_xor(ss, 1); ss += __shfl_xor(ss, 2); ss += __shfl_xor(ss, 4);
                    if (e8 == 0) INV[(size_t)pr * 8 + grp] = 1.0f / fmaxf(sqrtf(ss), 1e-12f);
                }
            }
        }
        if (pass == 0) {
            LAS unsigned short* tile = (LAS unsigned short*)lds;
            for (int it = wg0; it < BATCH * (VP / 64); it += nwg) {
                const int b = it / (VP / 64), p0 = (it % (VP / 64)) * 64;
#pragma unroll
                for (int i = 0; i < 8; ++i) {
                    const int id = tid + NTHR * i, row = id >> 6, c16 = id & 63;
                    u32x4 v = {0u, 0u, 0u, 0u};
                    if (p0 + row < LP) v = *(const u32x4*)(UDA + (size_t)(b * LP + p0 + row) * DAW + 1024 + c16 * 8);
                    *(LAS u32x4*)(tile + row * 520 + c16 * 8) = v;
                }
                __syncthreads();
                {
                    unsigned w[32];
#pragma unroll
                    for (int pp = 0; pp < 32; ++pp) w[pp] = (unsigned)tile[(2 * pp) * 520 + tid] | ((unsigned)tile[(2 * pp + 1) * 520 + tid] << 16);
                    u32x4* dst = (u32x4*)(Vt + ((size_t)(b * 4 + (tid >> 7)) * 128 + (tid & 127)) * VP + p0);
#pragma unroll
                    for (int i = 0; i < 8; ++i) { u32x4 o; o.x = w[4 * i]; o.y = w[4 * i + 1]; o.z = w[4 * i + 2]; o.w = w[4 * i + 3]; dst[i] = o; }
                }
                __syncthreads();
            }
        }
        {
            const int r16 = lane & 15, q4 = lane >> 4;
            const float* mixp = args.in[I_SHIFT];
            const int ng = pass ? LP / 16 - PFXG : PFXG, g00 = pass ? PFXG : 0;
            for (int it2 = wave * nwg + wg0; it2 < 2 * BATCH * ng; it2 += nwg * NWAVES) {
                const int j2 = it2 >> 1, b2 = j2 / ng, rg = b2 * (LP / 16) + g00 + (j2 - b2 * ng), cb0 = (it2 & 1) * 16;
                const int pr = rg * 16 + r16, p = pr % LP;
                const bf16* cur = URW + (size_t)pr * RWW; const bf16* prv = cur - RWW;
                bf16x8 Aw[2], Aa[2], Ag[5];
#pragma unroll
                for (int s = 0; s < 9; ++s) {
                    const int col = (s < 2) ? (1536 + 32 * s + 8 * q4) : (s < 4) ? (1600 + 32 * (s - 2) + 8 * q4) : (1664 + 32 * (s - 4) + 8 * q4);
                    float c8[8], p8[8];
                    unpack8(*(const u32x4*)(cur + col), c8);
                    if (p > 0) unpack8(*(const u32x4*)(prv + col), p8); else {
#pragma unroll
                        for (int j = 0; j < 8; ++j) p8[j] = 0.f; }
#pragma unroll
                    for (int j = 0; j < 8; ++j) { float v = c8[j] + (p8[j] - c8[j]) * mixp[col + j];
                        if (s < 2) v = tanhf(v); else if (s >= 4) v = sigmoidf_(v);
                        c8[j] = v; }
                    const u32x4 w = pack8(c8); const bf16x8 f = __builtin_bit_cast(bf16x8, w);
                    if (s < 2) Aw[s] = f; else if (s < 4) Aa[s - 2] = f; else Ag[s - 4] = f;
                }
                for (int cb = cb0; cb < cb0 + 16; ++cb) {
                    const int n = cb * 16 + r16;
                    f32x4 aw = {0.f, 0.f, 0.f, 0.f}, aa = aw, ag = aw;
#pragma unroll
                    for (int s = 0; s < 2; ++s) { aw = mfma16(Aw[s], *(const bf16x8*)(W2T + n * 64 + 32 * s + 8 * q4), aw); aa = mfma16(Aa[s], *(const bf16x8*)(A2T + n * 64 + 32 * s + 8 * q4), aa); }
#pragma unroll
                    for (int s = 0; s < 5; ++s) ag = mfma16(Ag[s], *(const bf16x8*)(G2T + n * 160 + 32 * s + 8 * q4), ag);
                    const float w0 = args.in[I_W0][n], a0 = args.in[I_A0][n];
#pragma unroll
                    for (int e = 0; e < 4; ++e) {
                        const size_t o = (size_t)(rg * 16 + 4 * q4 + e) * 512 + n;
                        Eb[o] = (bf16)f2bf(0.6065306597126334f * sigmoidf_(w0 + aw[e]));
                        Ab[o] = (bf16)f2bf(sigmoidf_(a0 + aa[e]));
                        Gb[o] = (bf16)f2bf(ag[e]);
                    }
                }
            }
        }
        if (pass == 1) {
            asm volatile("s_waitcnt vmcnt(0)" ::: "memory");
            __syncthreads();
            if (tid == 0) { __builtin_amdgcn_fence(__ATOMIC_RELEASE, "agent"); asm volatile("s_waitcnt vmcnt(0)" ::: "memory"); __hip_atomic_fetch_add(p4flag, 1u, __ATOMIC_RELAXED, __HIP_MEMORY_SCOPE_AGENT); }
        }
    }
    xcd_barrier(xbar);
    if (bx >= 64) { constexpr int pass = 1;
        const int wg0 = pass ? bx - 64 : bx, nwg = pass ? G - 64 : G;
        int zo = 0; asm volatile("" : "+s"(zo));
        if (pass == 0) {
            const int e8 = lane & 7, d0 = e8 * 8, grp = lane >> 3, hh = grp >> 1, cc = grp & 1;
            float qn[8], kn[8];
#pragma unroll
            for (int j = 0; j < 8; ++j) { qn[j] = args.in[I_QN][d0 + j + zo]; kn[j] = args.in[I_KN][d0 + j + zo]; }
            float kmix[8], kkc8[8];
#pragma unroll
            for (int j = 0; j < 8; ++j) { kmix[j] = args.in[I_SHIFT][512 + 8 * lane + j + zo]; kkc8[j] = args.in[I_KK][8 * lane + j + zo]; }
            const double invf[8] = {1.0, 0.19392274474868576, 0.03760603093086393, 0.007292664737217109, 0.001414213562373095, 0.0002742481756762073, 5.318295896944988e-05, 1.031338537721246e-05};
            const int np = LP, p00 = 0;
            for (int i = wg0 * NWAVES + wave; i < BATCH * np; i += nwg * NWAVES) {
                const int b = i / np, p = p00 + (i - b * np), pr = b * LP + p;
                const bf16* urow = UDA + (size_t)pr * DAW;
                float q[8], k[8];
                unpack8(*(const u32x4*)(urow + 8 * lane), q); unpack8(*(const u32x4*)(urow + 512 + 8 * lane), k);
                float sq = 0.f, sk = 0.f;
#pragma unroll
                for (int j = 0; j < 8; ++j) { sq += q[j] * q[j]; sk += k[j] * k[j]; }
                sq += __shfl_xor(sq, 1); sq += __shfl_xor(sq, 2); sq += __shfl_xor(sq, 4);
                sk += __shfl_xor(sk, 1); sk += __shfl_xor(sk, 2); sk += __shfl_xor(sk, 4);
                const float rq = rsqrtf(sq * (1.0f / 64) + NORM_EPS), rk = rsqrtf(sk * (1.0f / 64) + NORM_EPS);
#pragma unroll
                for (int j = 0; j < 8; ++j) { q[j] *= rq * qn[j]; k[j] *= rk * kn[j]; }
#pragma unroll
                for (int j = 0; j < 8; ++j) {
                    const float qo = __shfl_xor(q[j], 1), ko = __shfl_xor(k[j], 1);
                    if (e8 < 2) {
                        double rev = (double)p * invf[j] * 0.15915494309189535; rev -= floor(rev);
                        const float rf = (float)rev, cs = __builtin_amdgcn_cosf(rf), sn = __builtin_amdgcn_sinf(rf);
                        if (e8 == 0) { q[j] = q[j] * cs - qo * sn; k[j] = k[j] * cs - ko * sn; }
                        else         { q[j] = q[j] * cs + qo * sn; k[j] = k[j] * cs + ko * sn; }
                    }
                }
#pragma unroll
                for (int j = 0; j < 8; ++j) q[j] *= 0.18033688011112042f;
                const size_t o = ((size_t)(b * 4 + hh) * VP + p) * 128 + cc * 64 + d0;
                *(u32x4*)(Qb + o) = pack8(q); *(u32x4*)(Kb + o) = pack8(k);
                {
                    const bf16* rrow = URW + (size_t)pr * RWW + 512 + 8 * lane;
                    float kc[8], kp8[8];
                    unpack8(*(const u32x4*)rrow, kc);
                    if (p > 0) unpack8(*(const u32x4*)(rrow - RWW), kp8); else {
#pragma unroll
                        for (int j = 0; j < 8; ++j) kp8[j] = 0.f; }
                    float ss = 0.f;
#pragma unroll
                    for (int j = 0; j < 8; ++j) { const float kv = (kc[j] + (kp8[j] - kc[j]) * kmix[j]) * kkc8[j]; ss += kv * kv; }
                    ss += __shfl_xor(ss, 1); ss += __shfl_xor(ss, 2); ss += __shfl_xor(ss, 4);
                    if (e8 == 0) INV[(size_t)pr * 8 + grp] = 1.0f / fmaxf(sqrtf(ss), 1e-12f);
                }
            }
        }
        if (pass == 0) {
            LAS unsigned short* tile = (LAS unsigned short*)lds;
            for (int it = wg0; it < BATCH * (VP / 64); it += nwg) {
                const int b = it / (VP / 64), p0 = (it % (VP / 64)) * 64;
#pragma unroll
                for (int i = 0; i < 8; ++i) {
                    const int id = tid + NTHR * i, row = id >> 6, c16 = id & 63;
                    u32x4 v = {0u, 0u, 0u, 0u};
                    if (p0 + row < LP) v = *(const u32x4*)(UDA + (size_t)(b * LP + p0 + row) * DAW + 1024 + c16 * 8);
                    *(LAS u32x4*)(tile + row * 520 + c16 * 8) = v;
                }
                __syncthreads();
                {
                    unsigned w[32];
#pragma unroll
                    for (int pp = 0; pp < 32; ++pp) w[pp] = (unsigned)tile[(2 * pp) * 520 + tid] | ((unsigned)tile[(2 * pp + 1) * 520 + tid] << 16);
                    u32x4* dst = (u32x4*)(Vt + ((size_t)(b * 4 + (tid >> 7)) * 128 + (tid & 127)) * VP + p0);
#pragma unroll
                    for (int i = 0; i < 8; ++i) { u32x4 o; o.x = w[4 * i]; o.y = w[4 * i + 1]; o.z = w[4 * i + 2]; o.w = w[4 * i + 3]; dst[i] = o; }
                }
                __syncthreads();
            }
        }
        {
            const int r16 = lane & 15, q4 = lane >> 4;
            const float* mixp = args.in[I_SHIFT];
            const int ng = pass ? LP / 16 - PFXG : PFXG, g00 = pass ? PFXG : 0;
            for (int it2 = wave * nwg + wg0; it2 < 2 * BATCH * ng; it2 += nwg * NWAVES) {
                const int j2 = it2 >> 1, b2 = j2 / ng, rg = b2 * (LP / 16) + g00 + (j2 - b2 * ng), cb0 = (it2 & 1) * 16;
                const int pr = rg * 16 + r16, p = pr % LP;
                const bf16* cur = URW + (size_t)pr * RWW; const bf16* prv = cur - RWW;
                bf16x8 Aw[2], Aa[2], Ag[5];
#pragma unroll
                for (int s = 0; s < 9; ++s) {
                    const int col = (s < 2) ? (1536 + 32 * s + 8 * q4) : (s < 4) ? (1600 + 32 * (s - 2) + 8 * q4) : (1664 + 32 * (s - 4) + 8 * q4);
                    float c8[8], p8[8];
                    unpack8(*(const u32x4*)(cur + col), c8);
                    if (p > 0) unpack8(*(const u32x4*)(prv + col), p8); else {
#pragma unroll
                        for (int j = 0; j < 8; ++j) p8[j] = 0.f; }
#pragma unroll
                    for (int j = 0; j < 8; ++j) { float v = c8[j] + (p8[j] - c8[j]) * mixp[col + j];
                        if (s < 2) v = tanhf(v); else if (s >= 4) v = sigmoidf_(v);
                        c8[j] = v; }
                    const u32x4 w = pack8(c8); const bf16x8 f = __builtin_bit_cast(bf16x8, w);
                    if (s < 2) Aw[s] = f; else if (s < 4) Aa[s - 2] = f; else Ag[s - 4] = f;
                }
                for (int cb = cb0; cb < cb0 + 16; ++cb) {
                    const int n = cb * 16 + r16;
                    f32x4 aw = {0.f, 0.f, 0.f, 0.f}, aa = aw, ag = aw;
#pragma unroll
                    for (int s = 0; s < 2; ++s) { aw = mfma16(Aw[s], *(const bf16x8*)(W2T + n * 64 + 32 * s + 8 * q4), aw); aa = mfma16(Aa[s], *(const bf16x8*)(A2T + n * 64 + 32 * s + 8 * q4), aa); }
#pragma unroll
                    for (int s = 0; s < 5; ++s) ag = mfma16(Ag[s], *(const bf16x8*)(G2T + n * 160 + 32 * s + 8 * q4), ag);
                    const float w0 = args.in[I_W0][n], a0 = args.in[I_A0][n];
#pragma unroll
                    for (int e = 0; e < 4; ++e) {
                        const size_t o = (size_t)(rg * 16 + 4 * q4 + e) * 512 + n;
                        Eb[o] = (bf16)f2bf(0.6065306597126334f * sigmoidf_(w0 + aw[e]));
                        Ab[o] = (bf16)f2bf(sigmoidf_(a0 + aa[e]));
                        Gb[o] = (bf16)f2bf(ag[e]);
                    }
                }
            }
        }
        if (pass == 1) {
            asm volatile("s_waitcnt vmcnt(0)" ::: "memory");
            __syncthreads();
            if (tid == 0) { __builtin_amdgcn_fence(__ATOMIC_RELEASE, "agent"); asm volatile("s_waitcnt vmcnt(0)" ::: "memory"); __hip_atomic_fetch_add(p4flag, 1u, __ATOMIC_RELAXED, __HIP_MEMORY_SCOPE_AGENT); }
        }
    }

    {
        if (bx < 64) {
            const int chain = bx >> 2, quarter = bx & 3, b = chain >> 3, h = chain & 7;
            constexpr int SC2 = 16, OPF = 320, NC2 = LP / SC2;
            static_assert(NC2 * SC2 == LP && (NC2 & 1) == 1, "chunking");
            constexpr int CF = (NMETA + NT0 * 256) / SC2 - 1;
            static_assert((CF & 1) == 0 && (NMETA + NT0 * 256) % SC2 == 0, "flag chunk must be handled in the second half of a loop iteration");
            LAS float* OP = (LAS float*)lds;
            LAS unsigned short* RB = (LAS unsigned short*)(lds + 40960);
            LAS unsigned char* SP = lds + 45056;
            if (wave >= 4) {
                const int lw = wave - 4, li = lane >> 4, lq = lane & 15, c4 = h * 64 + 4 * lq;
                const float* mixp = args.in[I_SHIFT];
                const f32x4 mix_r = *(const f32x4*)(mixp + c4), mix_k = *(const f32x4*)(mixp + 512 + c4), mix_v = *(const f32x4*)(mixp + 1024 + c4);
                const f32x4 kkc = *(const f32x4*)(args.in[I_KK] + c4), kac = *(const f32x4*)(args.in[I_KA] + c4);
                struct LSet { u32x2 rc, rp, kc, kp, vc, vp, e, a; float iv; };
                LSet s0, s1;
                const bf16* ubase = URW + (size_t)b * LP * RWW + c4; const bf16* ebase = Eb + (size_t)b * LP * 512 + c4; const bf16* abase = Ab + (size_t)b * LP * 512 + c4; const float* ibase = INV + (size_t)b * LP * 8 + h;
                bf16* ybase = Y + (size_t)b * T * 512 + h * 64 + 16 * quarter + 4 * (lane >> 4);
                unsigned* halfflag = (unsigned*)(sm + SM_BAR) + SUBW + 64 * 7;
#define UNPK4_(w_) ((f32x4){bflo((w_).x), bfhi((w_).x), bflo((w_).y), bfhi((w_).y)})
#define SCAN_LOAD(S_, c_) do { const int p_ = (c_) * SC2 + 4 * lw + li; const int pm_ = p_ > 0 ? p_ - 1 : 0; const bf16* u_ = ubase + (size_t)p_ * RWW; const bf16* um_ = ubase + (size_t)pm_ * RWW; \
        S_.rc = *(const u32x2*)u_; S_.kc = *(const u32x2*)(u_ + 512); S_.vc = *(const u32x2*)(u_ + 1024); S_.rp = *(const u32x2*)um_; S_.kp = *(const u32x2*)(um_ + 512); S_.vp = *(const u32x2*)(um_ + 1024); \
        S_.e = *(const u32x2*)(ebase + (size_t)p_ * 512); S_.a = *(const u32x2*)(abase + (size_t)p_ * 512); S_.iv = ibase[(size_t)p_ * 8]; } while (0)
#define SCAN_PROC(S_, c_) do { const int p_ = (c_) * SC2 + 4 * lw + li; const float pz_ = p_ == 0 ? 0.f : 1.f;     \
        const f32x4 rc_ = UNPK4_(S_.rc), kc_ = UNPK4_(S_.kc), vc_ = UNPK4_(S_.vc), rp_ = UNPK4_(S_.rp) * pz_, kq_ = UNPK4_(S_.kp) * pz_, vp_ = UNPK4_(S_.vp) * pz_, e_ = UNPK4_(S_.e), a_ = UNPK4_(S_.a); \
        const f32x4 r_ = rc_ + (rp_ - rc_) * mix_r, k_ = kc_ + (kq_ - kc_) * mix_k, v_ = vc_ + (vp_ - vc_) * mix_v; \
        const f32x4 kk_ = k_ * kkc * S_.iv, kpv_ = k_ * ((a_ - 1.0f) * kac + 1.0f); \
        const f32x4 w_ = {__expf(-e_.x), __expf(-e_.y), __expf(-e_.z), __expf(-e_.w)}; \
        LAS float* dst_ = OP + ((c_) & 1) * (SC2 * OPF) + (4 * lw + li) * OPF + 4 * lq; \
        *(LAS f32x4*)dst_ = w_; *(LAS f32x4*)(dst_ + 64) = -kk_; *(LAS f32x4*)(dst_ + 128) = kk_ * a_; *(LAS f32x4*)(dst_ + 192) = kpv_; *(LAS f32x4*)(dst_ + 256) = v_; \
        *(LAS u32x2*)(RB + ((c_) & 1) * (SC2 * 64) + (4 * lw + li) * 64 + 4 * lq) = (u32x2){pk2(r_.x, r_.y), pk2(r_.z, r_.w)}; } while (0)
#define SCAN_YPASS(c_) do { _Pragma("unroll") for (int i_ = 0; i_ < 4; ++i_) { const int st_ = 4 * lw + i_, p_ = (c_) * SC2 + st_; \
        const LAS unsigned char* sp_ = SP + ((c_) & 1) * 36864 + (st_ * 16 + (lane & 15)) * 144 + 16 * (lane >> 4); const LAS unsigned short* rb_ = RB + ((c_) & 1) * (SC2 * 64) + st_ * 64 + 8 * (lane >> 4); \
        f32x4 acc_ = {0.f, 0.f, 0.f, 0.f}; \
        acc_ = mfma16(*(const LAS bf16x8*)sp_, *(const LAS bf16x8*)rb_, acc_); acc_ = mfma16(*(const LAS bf16x8*)(sp_ + 64), *(const LAS bf16x8*)(rb_ + 32), acc_); \
        if ((lane & 15) == 0 && p_ >= NMETA) *(u32x2*)(ybase + (size_t)(p_ - NMETA) * 512) = (u32x2){pk2(acc_.x, acc_.y), pk2(acc_.z, acc_.w)}; } } while (0)
                SCAN_LOAD(s0, 0); SCAN_LOAD(s1, 1); SCAN_PROC(s0, 0); SCAN_LOAD(s0, 2);
                __syncthreads();
                static_assert(((PFXG - 3) & 1) == 0 && PFXG - 3 > 0, "flag wait chunk");
                for (int c = 0; c < NC2; c += 2) {
                    if (c == PFXG - 3) {
                        unsigned sp4 = 0;
                        while (__hip_atomic_load(p4flag, __ATOMIC_RELAXED, __HIP_MEMORY_SCOPE_AGENT) < (unsigned)(G - 64)) { __builtin_amdgcn_s_sleep(2); if (++sp4 > (1u << 22)) break; }
                        __builtin_amdgcn_fence(__ATOMIC_ACQUIRE, "agent");
                    }
                    if (c == CF + 2 && wave == 4 && lane == 0) {
                        __builtin_amdgcn_fence(__ATOMIC_RELEASE, "agent"); asm volatile("s_waitcnt vmcnt(0)" ::: "memory");
                        __hip_atomic_fetch_add(halfflag, 1u, __ATOMIC_RELAXED, __HIP_MEMORY_SCOPE_AGENT);
                    }
                    if (c >= 1) SCAN_YPASS(c - 1);
                    if (c + 1 < NC2) { SCAN_PROC(s1, c + 1); if (c + 3 < NC2) SCAN_LOAD(s1, c + 3); }
                    __syncthreads();
                    if (c + 1 < NC2) {
                        SCAN_YPASS(c);
                        if (c == CF) asm volatile("s_waitcnt vmcnt(0)" ::: "memory");
                        if (c + 2 < NC2) { SCAN_PROC(s0, c + 2); if (c + 4 < NC2) SCAN_LOAD(s0, c + 4); }
                        __syncthreads();
                    }
                }
                SCAN_YPASS(NC2 - 1);
#undef SCAN_LOAD
#undef UNPK4_
#undef SCAN_PROC
#undef SCAN_YPASS
            } else {
                const int rr = lane >> 4, kq = lane & 15, vrow = 16 * quarter + 4 * wave + rr;
                f32x4 S = {0.f, 0.f, 0.f, 0.f};
                __builtin_amdgcn_s_setprio(3);
                __syncthreads();
                for (int c = 0; c < NC2; ++c) {
                    const LAS float* cb = OP + (c & 1) * (SC2 * OPF);
                    LAS unsigned char* spw = SP + (c & 1) * 36864 + (4 * wave + rr) * 144 + 8 * kq;
                    f32x4 w = ((const LAS f32x4*)cb)[kq], an = ((const LAS f32x4*)(cb + 64))[kq], bv = ((const LAS f32x4*)(cb + 128))[kq], kp = ((const LAS f32x4*)(cb + 192))[kq];
                    float vv = cb[256 + vrow];
#define SB_ __builtin_amdgcn_sched_barrier(0)
#pragma unroll
                    for (int st = 0; st < SC2; ++st) {
                        const bool more = st + 1 < SC2;
                        const LAS float* sp = cb + (more ? st + 1 : st) * OPF;
                        f32x4 nw = w, nan_ = an, nbv = bv, nkp = kp; float nvv = vv;
                        f32x2 t = S.zw * an.zw; SB_;
                        t = S.xy * an.xy + t; SB_;
                        f32x2 u01 = kp.xy * vv; SB_;
                        float x = t.x + t.y; SB_;
                        f32x2 u23 = kp.zw * vv; SB_;
                        u01 = S.xy * w.xy + u01; SB_;
                        x += dpp_f(x, 0); SB_;
                        u23 = S.zw * w.zw + u23; SB_;
                        if (more) nw = ((const LAS f32x4*)sp)[kq]; SB_;
                        x += dpp_f(x, 1); SB_;
                        if (more) nan_ = ((const LAS f32x4*)(sp + 64))[kq]; SB_;
                        if (more) nbv = ((const LAS f32x4*)(sp + 128))[kq]; SB_;
                        x += dpp_f(x, 2); SB_;
                        if (more) nkp = ((const LAS f32x4*)(sp + 192))[kq]; SB_;
                        if (more) nvv = sp[256 + vrow]; SB_;
                        x += dpp_f(x, 3); SB_;
                        S.xy = bv.xy * x + u01; SB_;
                        S.zw = bv.zw * x + u23; SB_;
                        *(LAS u32x2*)(spw + st * 2304) = (u32x2){pk2(S.x, S.y), pk2(S.z, S.w)}; SB_;
                        w = nw; an = nan_; bv = nbv; kp = nkp; vv = nvv;
                    }
#undef SB_
                    __syncthreads();
                }
                __builtin_amdgcn_s_setprio(0);
            }
            __syncthreads();
        }
        if (bx >= 64) {
            const float lam = misc[0];
            LAS unsigned* shu = (LAS unsigned*)(lds + LDS_MISC);
            const int c = wave >> 2, qg = wave & 3, r32 = lane & 31, hh = lane >> 5;
            for (;;) {
                if (tid == 0) shu[0] = atomicAdd(qctr, 1u);
                __syncthreads();
                const unsigned un = shu[0];
                if (un >= 512u) break;
                const int qi = (un < 16u * NT0) ? (2 * NT0 - 1) - (int)(un >> 3) : 63 - (int)((un - 16u * NT0) >> 3), bh = (int)(un & 7u), b = bh >> 2, h = bh & 3;
                const int qbase = NMETA + 128 * qi + 32 * qg, qpos = qbase + r32;
                const bf16* qrow = Qb + ((size_t)bh * VP + qpos) * 128 + c * 64 + 8 * hh;
                bf16x8 qf[4];
#pragma unroll
                for (int s = 0; s < 4; ++s) qf[s] = *(const bf16x8*)(qrow + 16 * s);
                f32x16 o[4];
#pragma unroll
                for (int d = 0; d < 4; ++d)
#pragma unroll
                    for (int e = 0; e < 16; ++e) o[d][e] = 0.f;
                float mrun = -1e30f, lsum = 0.f;
                const int ntiles = 2 * qi + 3;
                const bf16* ksrc[2]; const bf16* vsrc[2]; int kdst[2], vdst[2];
#pragma unroll
                for (int ii = 0; ii < 2; ++ii) { const int id = tid + NTHR * ii;
                    ksrc[ii] = Kb + ((size_t)bh * VP + (id >> 4)) * 128 + (id & 15) * 8; kdst[ii] = (id >> 4) * 272 + (id & 15) * 16;
                    vsrc[ii] = Vt + ((size_t)bh * 128 + (id >> 3)) * VP + (id & 7) * 8; vdst[ii] = ATT_KB + (id >> 3) * 136 + (id & 7) * 16; }
                u32x4 kr[2], vr[2];
#define ATT_LOAD(j_) do { _Pragma("unroll") for (int ii = 0; ii < 2; ++ii) { kr[ii] = *(const u32x4*)(ksrc[ii] + (size_t)(j_) * 64 * 128); vr[ii] = *(const u32x4*)(vsrc[ii] + (j_) * 64); } } while (0)
#define ATT_WRITE(j_) do { LAS unsigned char* bb_ = lds + ((j_) & 1) * ATT_BUF; _Pragma("unroll") for (int ii = 0; ii < 2; ++ii) { *(LAS u32x4*)(bb_ + kdst[ii]) = kr[ii]; \
        *(LAS u32x2*)(bb_ + vdst[ii]) = (u32x2){vr[ii].x, vr[ii].y}; *(LAS u32x2*)(bb_ + vdst[ii] + 8) = (u32x2){vr[ii].z, vr[ii].w}; } } while (0)
                ATT_LOAD(0); ATT_WRITE(0);
                __syncthreads();
                for (int j = 0; j < ntiles; ++j) {
                    if (j + 1 < ntiles) ATT_LOAD(j + 1);
                    if (64 * j <= qbase + 31) {
                        const LAS unsigned char* kb_ = lds + (j & 1) * ATT_BUF + r32 * 272 + c * 128 + hh * 16;
                        const LAS unsigned char* vb_ = lds + (j & 1) * ATT_BUF + ATT_KB + r32 * 136 + hh * 8;
                        f32x16 s0, s1;
#pragma unroll
                        for (int e = 0; e < 16; ++e) { s0[e] = 0.f; s1[e] = 0.f; }
#pragma unroll
                        for (int s = 0; s < 4; ++s) { s0 = mfma32(*(const LAS bf16x8*)(kb_ + s * 32), qf[s], s0); s1 = mfma32(*(const LAS bf16x8*)(kb_ + 32 * 272 + s * 32), qf[s], s1); }
                        if (64 * j + 63 > qbase) {
#pragma unroll
                            for (int e = 0; e < 16; ++e) { const int key = 64 * j + (e & 3) + 8 * (e >> 2) + 4 * hh; if (key > qpos) s0[e] = -1e30f; if (key + 32 > qpos) s1[e] = -1e30f; }
                        }
                        float tm = fmaxf(s0[0], s1[0]);
#pragma unroll
                        for (int e = 1; e < 16; ++e) tm = fmaxf(tm, fmaxf(s0[e], s1[e]));
                        tm = fmaxf(tm, __shfl_xor(tm, 32));
                        const float mnew = fmaxf(mrun, tm), alpha = __builtin_amdgcn_exp2f(mrun - mnew); mrun = mnew;
                        float rsum = 0.f;
#pragma unroll
                        for (int e = 0; e < 16; ++e) { s0[e] = __builtin_amdgcn_exp2f(s0[e] - mnew); s1[e] = __builtin_amdgcn_exp2f(s1[e] - mnew); rsum += s0[e] + s1[e]; }
                        lsum = lsum * alpha + rsum;
                        if (__builtin_amdgcn_ballot_w64(alpha != 1.0f) != 0ull) {
#pragma unroll
                            for (int d = 0; d < 4; ++d) o[d] = o[d] * alpha;
                        }
                        bf16x8 pf[4];
#pragma unroll
                        for (int s = 0; s < 4; ++s) { u32x4 w;
                            if (s < 2) { w.x = pk2(s0[8 * s], s0[8 * s + 1]); w.y = pk2(s0[8 * s + 2], s0[8 * s + 3]); w.z = pk2(s0[8 * s + 4], s0[8 * s + 5]); w.w = pk2(s0[8 * s + 6], s0[8 * s + 7]); }
                            else { const int t = s - 2; w.x = pk2(s1[8 * t], s1[8 * t + 1]); w.y = pk2(s1[8 * t + 2], s1[8 * t + 3]); w.z = pk2(s1[8 * t + 4], s1[8 * t + 5]); w.w = pk2(s1[8 * t + 6], s1[8 * t + 7]); }
                            pf[s] = __builtin_bit_cast(bf16x8, w); }
#pragma unroll
                        for (int d = 0; d < 4; ++d)
#pragma unroll
                            for (int s = 0; s < 4; ++s) {
                                const u32x2 lo = *(const LAS u32x2*)(vb_ + d * 32 * 136 + s * 32), hi = *(const LAS u32x2*)(vb_ + d * 32 * 136 + s * 32 + 16);
                                const u32x4 vv = {lo.x, lo.y, hi.x, hi.y};
                                o[d] = mfma32(__builtin_bit_cast(bf16x8, vv), pf[s], o[d]);
                            }
                    }
                    if (j + 1 < ntiles) ATT_WRITE(j + 1);
                    __syncthreads();
                }
#undef ATT_LOAD
#undef ATT_WRITE
                lsum += __shfl_xor(lsum, 32);
                const float inv = 1.0f / lsum;
                LAS float* X = (LAS float*)lds;
                if (c == 1) {
#pragma unroll
                    for (int d = 0; d < 4; ++d)
#pragma unroll
                        for (int e = 0; e < 16; ++e) X[((qg * 4 + d) * 16 + e) * 64 + lane] = o[d][e] * inv;
                }
                __syncthreads();
                if (c == 0) {
                    float sq = 0.f;
#pragma unroll
                    for (int d = 0; d < 4; ++d)
#pragma unroll
                        for (int e = 0; e < 16; ++e) { const float v = o[d][e] * inv - lam * X[((qg * 4 + d) * 16 + e) * 64 + lane]; o[d][e] = v; sq += v * v; }
                    sq += __shfl_xor(sq, 32);
                    const float rn = rsqrtf(sq * (1.0f / 128) + NORM_EPS) * 0.8f;
                    bf16* orow = XB + (size_t)(b * T + 128 * qi + 32 * qg + r32) * D + h * 128;
#pragma unroll
                    for (int d = 0; d < 4; ++d)
#pragma unroll
                        for (int g4 = 0; g4 < 4; ++g4) {
                            const int dv0 = 32 * d + 8 * g4 + 4 * hh;
                            const f32x4 sl = *(const f32x4*)(args.in[I_SUBLN] + dv0);
                            u32x2 w; w.x = pk2(o[d][4 * g4] * rn * sl.x, o[d][4 * g4 + 1] * rn * sl.y); w.y = pk2(o[d][4 * g4 + 2] * rn * sl.z, o[d][4 * g4 + 3] * rn * sl.w);
                            *(u32x2*)(orow + dv0) = w;
                        }
                }
                __syncthreads();
            }
        }
        if (bx >= 64) {
            LAS float* scr = (LAS float*)(lds + wave * 16640);
            constexpr int IT_G = (D / 64) * (FF / 64), IT_D = (FF / 64) * (D / 64), NIT = 2 * IT_G + IT_D;
            for (int it = (bx - 64) * NWAVES + wave; it < NIT; it += (G - 64) * NWAVES) {
                int r = it;
                if (r < IT_G) { transpose_item(args.in[I_F2G], D, FF, W2A, args.in[I_F2N], 1, scr, r, lane); continue; } r -= IT_G;
                if (r < IT_G) { transpose_item(args.in[I_F2U], D, FF, W2A, args.in[I_F2N], 2, scr, r, lane); continue; } r -= IT_G;
                transpose_item(args.in[I_F2D], FF, D, W2D, nullptr, 0, scr, r, lane);
            }
            unsigned* subw = (unsigned*)(sm + SM_BAR) + SUBW;
            XcdBarrier xsub; xsub.bar = (unsigned*)(sm + SM_BAR) + 4096; xsub.x = xbar.x; xsub.st = (volatile LAS unsigned*)(lds + LDS_MISC + 72); const unsigned GS = (unsigned)(G - 64);
            xcd_barrier(xsub, GS);
            wait_flag(subw + 64 * 7, 64u);
            TAIL_HALF(0, G - 64, bx - 64, xcd_barrier(xsub, GS), xcd_barrier(xsub, GS));
        }
    }
    xcd_barrier(xbar);

    TAIL_HALF(1, G, bx, xcd_barrier(xbar), xcd_barrier(xbar));
    xcd_barrier(xbar);
    {
        pg8::Gemm g{TC, W2D, M, D, FF}; pg8::StaticOrder S; S.init(M, D, G, bx);
        EpiRes E{out, out, nullptr, nullptr, 0.5f, 0, 3};
        pg8::gemm_phase<EpiRes, pg8::StaticOrder, PG8_ALIGN, PG8_SP2>(lds, g, S, E);
    }
}

extern "C" void kernel_launch(void* const* d_in, const int* in_sizes, int n_in, void* d_out, int out_size, void* d_ws, size_t ws_size, hipStream_t stream) {
    static int grid = 0;
    if (grid == 0) {
        if (n_in != 31 || out_size != M * D || ws_size < WS_END) { fprintf(stderr, "kernel_launch: unexpected shapes (n_in %d out %d ws %zu)\n", n_in, out_size, ws_size); grid = -1; return; }
        int dev = 0, cus = 0, per_cu = 0;
        (void)hipGetDevice(&dev); (void)hipDeviceGetAttribute(&cus, hipDeviceAttributeMultiprocessorCount, dev);
        if (hipFuncSetAttribute((const void*)fwd_kernel, hipFuncAttributeMaxDynamicSharedMemorySize, LDS_BYTES) != hipSuccess) { fprintf(stderr, "kernel_launch: hipFuncSetAttribute failed\n"); grid = -1; return; }
        if (hipOccupancyMaxActiveBlocksPerMultiprocessor(&per_cu, (const void*)fwd_kernel, NTHR, LDS_BYTES) != hipSuccess || per_cu < 1) { fprintf(stderr, "kernel_launch: occupancy query says %d\n", per_cu); per_cu = 1; }
        (void)hipGetLastError();
        grid = cus;
        if (grid > cus * per_cu) grid = cus * per_cu;
        if (grid > 256) grid = 256;
    }
    if (grid < 0) return;
    Args a{};
    for (int i = 0; i < 31; ++i) a.in[i] = (const float*)d_in[i];
    a.out = (float*)d_out; a.ws = (unsigned char*)d_ws;
    (void)hipMemsetAsync((unsigned char*)d_ws + WS_SMALL + SM_BAR, 0, 32768, stream);
    void* kargs[] = {&a};
    hipError_t e = hipLaunchCooperativeKernel((const void*)fwd_kernel, dim3(grid), dim3(NTHR), kargs, LDS_BYTES, stream);
    if (e != hipSuccess) fprintf(stderr, "cooperative launch failed: %s (grid %d)\n", hipGetErrorString(e), grid);
}
```

```cpp
#include <hip/hip_runtime.h>
#include <hip/hip_cooperative_groups.h>
#include <cstdio>
#include <cstdint>
namespace cg = cooperative_groups;
namespace pg8 {
#define PG8_LAS __attribute__((address_space(3)))
typedef unsigned short bf16_t;
typedef short bf16x8 __attribute__((ext_vector_type(8)));
typedef float f32x4 __attribute__((ext_vector_type(4)));
typedef unsigned u32x4 __attribute__((ext_vector_type(4)));
constexpr int BM = 256, BK = 64, HALF = 128, HTB = HALF * BK * 2  , STAGE_BYTES = 8 * HTB, NXCD = 8, WGM = 8;

__host__ __device__ __forceinline__ int lds_byte(int r, int c) { const int st = (r >> 4) * 2 + (c >> 5), rr = r & 15, cc = c & 31, ob = rr * 64 + cc * 2; return st * 1024 + (ob ^ (((ob >> 9) & 1) << 5)); }
__host__ __device__ __forceinline__ void stage_rc(int b, int& R, int& C) { const int st = b / 1024, sb = b % 1024, swz = sb ^ (((sb >> 9) & 1) << 5); R = (st >> 1) * 16 + swz / 64; C = (st & 1) * 32 + (swz % 64) / 2; }
__host__ __device__ __forceinline__ int perm32(int rho) { const int n = rho >> 4, i = rho & 15; return 8 * (i >> 2) + 4 * n + (i & 3); }

struct Unit { int pm, pn; };
struct Gemm { const bf16_t* A; const bf16_t* Bt; int M, N, K; };

struct StaticOrder {
    int nM, nN, nwg, G, c;
    __host__ __device__ void init(int M, int N, int G_, int c_) { nM = M / BM; nN = N / BM; nwg = nM * nN; G = G_; c = c_; }
    __host__ __device__ bool next(int i, Unit& u) const {
        const long L = (long)i * G + c; if (L >= nwg) return false;
        int wgid = (int)L; { const int q = nwg / NXCD, r = nwg % NXCD, xcd = wgid % NXCD, off = wgid / NXCD; wgid = (xcd < r ? xcd * (q + 1) : r * (q + 1) + (xcd - r) * q) + off; }
        const int nig = WGM * nN, gid = wgid / nig, fm = gid * WGM, gsz = (nM - fm) < WGM ? (nM - fm) : WGM;
        u.pm = fm + ((wgid % nig) % gsz); u.pn = (wgid % nig) / gsz; return true;
    }
    __device__ __forceinline__ void a_ready(const Unit&) const {}
    __device__ __forceinline__ void done(const Unit&) const {}
};
__device__ __forceinline__ unsigned cvt_pk_bf16(float lo, float hi) { unsigned r; asm volatile("v_cvt_pk_bf16_f32 %0, %1, %2" : "=v"(r) : "v"(lo), "v"(hi)); return r; }
template <class Epi, class Sched, bool ALIGN_EPI = false, bool SP2 = false>
__device__ __forceinline__ void gemm_phase(PG8_LAS unsigned char* lds, const Gemm g, const Sched& S, const Epi& E) {
    const int tid = threadIdx.x, wid = __builtin_amdgcn_readfirstlane(tid >> 6), lane = tid & 63, wr = wid >> 2, wc = wid & 3, fr = lane & 15, fq = lane >> 4;
    const int K = g.K, nt = K / BK;
    unsigned voffA[2], voffB[2];
#pragma unroll
    for (int i = 0; i < 2; ++i) { int R, C; stage_rc(tid * 16 + i * 8192, R, C); const int Rb = Epi::PERM ? ((R & ~31) + perm32(R & 31)) : R;
        voffA[i] = (unsigned)(R * K + C) * 2u; voffB[i] = (unsigned)(Rb * K + C) * 2u; }
    const size_t kstep = (size_t)(BK * 2);
    const size_t hstep = (size_t)HALF * K * 2;
    const size_t tstep = 2 * hstep;
    const unsigned ldsw = (unsigned)wid * 1024u;
    const int aoff = lds_byte(wr * 64 + fr, fq * 8), boff = lds_byte(wc * 32 + fr, fq * 8);
#define PG8_SA(b, h) (((b) * 2 + (h)) * HTB)
#define PG8_SB(b, h) ((4 + (b) * 2 + (h)) * HTB)
#define PG8_STAGE(bufoff, gbase, voff) do { _Pragma("unroll") for (int _i = 0; _i < 2; ++_i) \
        __builtin_amdgcn_global_load_lds((const unsigned*)((const char*)(gbase) + (voff)[_i]), (PG8_LAS unsigned*)(lds + (bufoff) + ldsw + _i * 8192), 16, 0, 0); } while (0)
#define PG8_LDA(dst, b, h) do { _Pragma("unroll") for (int m = 0; m < 4; ++m) _Pragma("unroll") for (int k = 0; k < 2; ++k) dst[m][k] = *(const PG8_LAS bf16x8*)(lds + PG8_SA(b, h) + aoff + m * 2048 + k * 1024); } while (0)
#define PG8_LDB(dst, b, h) do { _Pragma("unroll") for (int n = 0; n < 2; ++n) _Pragma("unroll") for (int k = 0; k < 2; ++k) dst[n][k] = *(const PG8_LAS bf16x8*)(lds + PG8_SB(b, h) + boff + n * 2048 + k * 1024); } while (0)
#define PG8_MMA(ai, bj, At, Bt) do { __builtin_amdgcn_s_setprio(1); _Pragma("unroll") for (int m = 0; m < 4; ++m) _Pragma("unroll") for (int n = 0; n < 2; ++n) _Pragma("unroll") for (int k = 0; k < 2; ++k) \
        acc[ai][bj][m][n] = __builtin_amdgcn_mfma_f32_16x16x32_bf16(Bt[n][k], At[m][k], acc[ai][bj][m][n], 0, 0, 0); __builtin_amdgcn_s_setprio(0); } while (0)
#define PG8_WAIT_V(n) asm volatile("s_waitcnt vmcnt(" #n ")" ::: "memory")
#define PG8_WAIT_L(n) asm volatile("s_waitcnt lgkmcnt(" #n ")" ::: "memory")
#define PG8_BAR __builtin_amdgcn_s_barrier()
#define PG8_SCHED __builtin_amdgcn_sched_barrier(0)
    Unit cur, nxt; int ui = 0;
    if (!S.next(0, cur)) return;
    f32x4 acc[2][2][4][2];
#pragma unroll
    for (int a = 0; a < 2; ++a)
#pragma unroll
        for (int b = 0; b < 2; ++b)
#pragma unroll
            for (int m = 0; m < 4; ++m)
#pragma unroll
                for (int n = 0; n < 2; ++n) acc[a][b][m][n] = (f32x4){0.f, 0.f, 0.f, 0.f};
    bf16x8 At[4][2], B0[2][2], B1[2][2];
    const char* cA = (const char*)g.A + (size_t)cur.pm * tstep; const char* cB = (const char*)g.Bt + (size_t)cur.pn * tstep;
    S.a_ready(cur);
    if constexpr (SP2) {
        PG8_STAGE(PG8_SB(0, 0), cB, voffB); PG8_STAGE(PG8_SB(0, 1), cB + hstep, voffB); PG8_STAGE(PG8_SA(0, 0), cA, voffA); PG8_STAGE(PG8_SA(0, 1), cA + hstep, voffA);
        if (wr == 1) PG8_BAR;
        PG8_WAIT_V(2); PG8_BAR;
        PG8_STAGE(PG8_SB(1, 0), cB + kstep, voffB); PG8_STAGE(PG8_SA(1, 0), cA + kstep, voffA); PG8_STAGE(PG8_SB(1, 1), cB + hstep + kstep, voffB);
        PG8_WAIT_V(6); PG8_BAR;
    } else {
        PG8_STAGE(PG8_SB(0, 0), cB, voffB); PG8_STAGE(PG8_SA(0, 0), cA, voffA); PG8_STAGE(PG8_SB(0, 1), cB + hstep, voffB); PG8_STAGE(PG8_SA(0, 1), cA + hstep, voffA);
        if (wr == 1) PG8_BAR;
        PG8_WAIT_V(4); PG8_BAR;
        PG8_STAGE(PG8_SB(1, 0), cB + kstep, voffB); PG8_STAGE(PG8_SA(1, 0), cA + kstep, voffA); PG8_STAGE(PG8_SB(1, 1), cB + hstep + kstep, voffB);
        PG8_WAIT_V(6); PG8_BAR;
    }
    for (;;) {
        const bool has_next = S.next(ui + 1, nxt);
        const char* nA = has_next ? (const char*)g.A + (size_t)nxt.pm * tstep : cA; const char* nB = has_next ? (const char*)g.Bt + (size_t)nxt.pn * tstep : cB;
        for (int t = 0; t < nt; t += 2) {
            const bool last = (t == nt - 2);
            const char* a1 = cA + (size_t)(t + 1) * kstep;
            const char* a2 = last ? nA : cA + (size_t)(t + 2) * kstep; const char* b2 = last ? nB : cB + (size_t)(t + 2) * kstep;
            const char* a3 = a2 + kstep; const char* b3 = b2 + kstep;
            if (last && has_next) S.a_ready(nxt);
            if constexpr (SP2) {
            PG8_LDB(B0, 0, 0); PG8_LDB(B1, 0, 1); PG8_SCHED; PG8_LDA(At, 0, 0); PG8_STAGE(PG8_SA(1, 1), a1 + hstep, voffA);
            PG8_WAIT_V(8); PG8_WAIT_L(0); PG8_BAR; PG8_MMA(0, 0, At, B0); PG8_MMA(0, 1, At, B1); PG8_BAR; PG8_SCHED;
            PG8_LDA(At, 0, 1); PG8_STAGE(PG8_SB(0, 0), b2, voffB); PG8_STAGE(PG8_SB(0, 1), b2 + hstep, voffB); PG8_STAGE(PG8_SA(0, 0), a2, voffA);
            PG8_WAIT_V(8); PG8_WAIT_L(0); PG8_BAR; PG8_MMA(1, 0, At, B0); PG8_MMA(1, 1, At, B1); PG8_BAR; PG8_SCHED;
            PG8_LDB(B0, 1, 0); PG8_LDB(B1, 1, 1); PG8_SCHED; PG8_LDA(At, 1, 0); PG8_STAGE(PG8_SA(0, 1), a2 + hstep, voffA);
            PG8_WAIT_V(8); PG8_WAIT_L(0); PG8_BAR; PG8_MMA(0, 0, At, B0); PG8_MMA(0, 1, At, B1); PG8_BAR; PG8_SCHED;
            PG8_LDA(At, 1, 1); PG8_STAGE(PG8_SB(1, 0), b3, voffB); PG8_STAGE(PG8_SB(1, 1), b3 + hstep, voffB); PG8_STAGE(PG8_SA(1, 0), a3, voffA);
            PG8_WAIT_V(8); PG8_WAIT_L(0); PG8_BAR; PG8_MMA(1, 0, At, B0); PG8_MMA(1, 1, At, B1); PG8_BAR; PG8_SCHED;
            } else {
            PG8_LDB(B0, 0, 0); PG8_SCHED; PG8_LDA(At, 0, 0); PG8_STAGE(PG8_SA(1, 1), a1 + hstep, voffA);
            PG8_WAIT_L(8); PG8_BAR; PG8_WAIT_L(0); PG8_MMA(0, 0, At, B0); PG8_BAR; PG8_SCHED;
            PG8_LDB(B1, 0, 1); PG8_STAGE(PG8_SB(0, 0), b2, voffB);
            PG8_BAR; PG8_WAIT_L(0); PG8_MMA(0, 1, At, B1); PG8_BAR;
            PG8_LDA(At, 0, 1); PG8_STAGE(PG8_SA(0, 0), a2, voffA);
            PG8_BAR; PG8_WAIT_L(0); PG8_MMA(1, 0, At, B0); PG8_BAR; PG8_SCHED;
            PG8_STAGE(PG8_SB(0, 1), b2 + hstep, voffB);
            PG8_WAIT_V(6); PG8_BAR; PG8_MMA(1, 1, At, B1); PG8_BAR;
            PG8_LDB(B0, 1, 0); PG8_SCHED; PG8_LDA(At, 1, 0); PG8_STAGE(PG8_SA(0, 1), a2 + hstep, voffA);
            PG8_WAIT_L(8); PG8_BAR; PG8_WAIT_L(0); PG8_MMA(0, 0, At, B0); PG8_BAR; PG8_SCHED;
            PG8_LDB(B1, 1, 1); PG8_STAGE(PG8_SB(1, 0), b3, voffB);
            PG8_BAR; PG8_WAIT_L(0); PG8_MMA(0, 1, At, B1); PG8_BAR;
            PG8_LDA(At, 1, 1); PG8_STAGE(PG8_SA(1, 0), a3, voffA);
            PG8_BAR; PG8_WAIT_L(0); PG8_MMA(1, 0, At, B0); PG8_BAR; PG8_SCHED;
            PG8_STAGE(PG8_SB(1, 1), b3 + hstep, voffB);
            PG8_WAIT_V(6); PG8_BAR; PG8_MMA(1, 1, At, B1); PG8_BAR;
            }
        }
        if constexpr (ALIGN_EPI) { if (wr == 0) PG8_BAR; }
        if constexpr (!Epi::AFTER_DRAIN) { E(acc, cur, wr, wc, fr, fq); S.done(cur); }
        if (!has_next) break;
#pragma unroll
        for (int a = 0; a < 2; ++a)
#pragma unroll
            for (int b = 0; b < 2; ++b)
#pragma unroll
                for (int m = 0; m < 4; ++m)
#pragma unroll
                    for (int n = 0; n < 2; ++n) acc[a][b][m][n] = (f32x4){0.f, 0.f, 0.f, 0.f};
        cur = nxt; cA = nA; cB = nB; ++ui;
        if constexpr (ALIGN_EPI) { if (wr == 1) PG8_BAR; }
    }
    PG8_WAIT_V(0);
    if constexpr (!ALIGN_EPI) { if (wr == 0) PG8_BAR; }
    PG8_BAR;
    if constexpr (Epi::AFTER_DRAIN) { E.fused(acc, cur, wr, wc, fr, fq, lds, wid, lane); S.done(cur); }
#undef PG8_SA
#undef PG8_SB
#undef PG8_STAGE
#undef PG8_LDA
#undef PG8_LDB
#undef PG8_MMA
#undef PG8_WAIT_V
#undef PG8_WAIT_L
#undef PG8_BAR
#undef PG8_SCHED
}
}
#define PG8_SP2 true
#define PG8_ALIGN true
#define LAS __attribute__((address_space(3)))
typedef unsigned short bf16;
typedef short bf16x8 __attribute__((ext_vector_type(8)));
typedef short s16x4 __attribute__((ext_vector_type(4)));
typedef float f32x4 __attribute__((ext_vector_type(4)));
typedef float f32x2 __attribute__((ext_vector_type(2)));
typedef float f32x16 __attribute__((ext_vector_type(16)));
typedef unsigned u32x4 __attribute__((ext_vector_type(4)));
typedef unsigned u32x2 __attribute__((ext_vector_type(2)));

constexpr int NWAVES = 8, NTHR = 512;
constexpr int BATCH = 2, T = 8192, D = 1024, FF = 2816, NMETA = 16, LP = 8208, M = BATCH * T, PR = BATCH * LP;
constexpr int NIN = 3360, NINP = 3584, DAW = 1536, RWW = 1824, VP = 8256;
constexpr float NORM_EPS = 1e-6f, GN_EPS = 64e-5f;
constexpr size_t MiB = 1u << 20;
constexpr size_t WS_XB = 0, WS_T = 32 * MiB, WS_URW = 32 * MiB, WS_UDA = 90 * MiB, WS_Y = 90 * MiB;
constexpr int NT0 = 21, NT1 = 32 - NT0;
constexpr size_t WS_Q = 287 * MiB / 2, QKV_BYTES = (size_t)BATCH * 4 * VP * 128 * 2, WS_K = WS_Q + QKV_BYTES, WS_VT = WS_K + QKV_BYTES;
constexpr size_t WS_W1A = 139 * MiB, WS_W1D = 150 * MiB, WS_WIN = 156 * MiB, WS_XB2 = 106 * MiB  , WS_TC = 287 * MiB / 2  , WS_W2A = 127 * MiB, WS_W2D = 138 * MiB;
constexpr size_t WS_E = 403 * MiB / 2, WS_A = 871 * MiB / 4, WS_G = 234 * MiB;
constexpr size_t WS_WOUT = 1001 * MiB / 4, WS_LORA = 505 * MiB / 2, WS_SMALL = 253 * MiB, WS_END = 255 * MiB;
static_assert(WS_VT + QKV_BYTES <= WS_E && (size_t)PR * RWW * 2 <= (WS_UDA - WS_URW) && (size_t)PR * DAW * 2 <= (WS_Q - WS_UDA) && WS_E + (size_t)PR * 512 * 2 <= WS_A && WS_A + (size_t)PR * 512 * 2 <= WS_G && WS_G + (size_t)PR * 512 * 2 <= WS_WOUT, "ws map");
static_assert(WS_TC + (size_t)M * FF * 2 <= WS_WOUT && WS_TC + (size_t)(2 * NT0 * 256) * FF * 2 <= WS_E && WS_Y + (size_t)M * 512 * 2 <= WS_XB2 && WS_XB2 + (size_t)(2 * NT0 * 256) * D * 2 <= WS_W2A && WS_W2A + (size_t)2 * FF * D * 2 <= WS_W2D && WS_W2D + (size_t)FF * D * 2 <= WS_Q, "tail ws map");
constexpr size_t SM_SSQ0 = 0, SM_SSQ1 = 65536, SM_SSQ2 = 131072, SM_BETA = 196608  , SM_XBM = 786432, SM_XBM2 = 819200, SM_TM = 851968  , SM_SSQM0 = 950272, SM_SSQM1 = 950528, SM_MISC = 950784;
constexpr int SUBW = 3584;
constexpr size_t SM_BAR = 983040;

__device__ __forceinline__ unsigned f2bf(float f) { unsigned u = __builtin_bit_cast(unsigned, f); return (u + 0x7fffu + ((u >> 16) & 1u)) >> 16; }
typedef __bf16 bf16x2_t __attribute__((ext_vector_type(2)));
__device__ __forceinline__ unsigned pk2(float lo, float hi) { const f32x2 v = {lo, hi}; return __builtin_bit_cast(unsigned, __builtin_convertvector(v, bf16x2_t)); }
__device__ __forceinline__ float bf2f(unsigned short b) { return __builtin_bit_cast(float, (unsigned)b << 16); }
__device__ __forceinline__ float bflo(unsigned w) { return __builtin_bit_cast(float, w << 16); }
__device__ __forceinline__ float bfhi(unsigned w) { return __builtin_bit_cast(float, w & 0xffff0000u); }
__device__ __forceinline__ float wave_sum(float v) {
#pragma unroll
    for (int o = 1; o < 64; o <<= 1) v += __shfl_xor(v, o);
    return v;
}
__device__ __forceinline__ float sigmoidf_(float x) { return __builtin_amdgcn_rcpf(1.0f + __expf(-x)); }
__device__ __forceinline__ u32x4 pack8(const float* v) { u32x4 w; w.x = pk2(v[0], v[1]); w.y = pk2(v[2], v[3]); w.z = pk2(v[4], v[5]); w.w = pk2(v[6], v[7]); return w; }
__device__ __forceinline__ void unpack8(u32x4 w, float* v) { v[0] = bflo(w.x); v[1] = bfhi(w.x); v[2] = bflo(w.y); v[3] = bfhi(w.y); v[4] = bflo(w.z); v[5] = bfhi(w.z); v[6] = bflo(w.w); v[7] = bfhi(w.w); }

struct Args {
    const float* in[31];
    float* out; unsigned char* ws;
};
enum { I_X = 0, I_META, I_F1N, I_F1G, I_F1U, I_F1D, I_MIXN, I_WIN, I_QN, I_KN, I_LQ1, I_LK1, I_LQ2, I_LK2, I_SUBLN, I_SHIFT, I_W0, I_W2, I_A0, I_A2, I_G2, I_KK, I_KA, I_RK, I_LNW, I_LNB, I_WOUT,
       I_F2N, I_F2G, I_F2U, I_F2D };

__device__ __forceinline__ int amap_tile(int k, int half) { const int n = half ? NT1 : NT0, base = half ? NT0 : 0; return k < n ? base + k : 32 + base + (k - n); }
__device__ __forceinline__ int cmap_tile(int pm, int half) { const int n = half ? NT1 : NT0, base = half ? NT0 : 0; return pm < 32 ? pm - base : n + (pm - 32 - base); }
struct EpiSwiglu {
    static constexpr bool PERM = true, AFTER_DRAIN = false;
    bf16* Tout; const float* ssq; int half, mode;
    __device__ __forceinline__ void operator()(const pg8::f32x4 (&acc)[2][2][4][2], const pg8::Unit& u, int wr, int wc, int fr, int fq) const {
        const int tA = mode == 1 ? amap_tile(u.pm, half) : u.pm;
        const int row0 = u.pm * 256 + wr * 64 + fr, row0A = tA * 256 + wr * 64 + fr, hc0 = u.pn * 128 + wc * 32 + 8 * fq;
#pragma unroll
        for (int ai = 0; ai < 2; ++ai)
#pragma unroll
            for (int m = 0; m < 4; ++m) {
                const int row = row0 + ai * 128 + m * 16;
                const float rs = rsqrtf(ssq[row0A + ai * 128 + m * 16] * (1.0f / D) + NORM_EPS);
                float t[8];
#pragma unroll
                for (int n = 0; n < 2; ++n)
#pragma unroll
                    for (int e = 0; e < 4; ++e) { const float g = acc[ai][0][m][n][e] * rs, up = acc[ai][1][m][n][e] * rs; t[4 * n + e] = g * sigmoidf_(g) * up; }
                *(u32x4*)(Tout + (size_t)row * FF + hc0) = pack8(t);
            }
    }
};
struct EpiRes {
    static constexpr bool PERM = true, AFTER_DRAIN = false;
    const float* base; float* out; bf16* xb; float* ssq; float scale; int half, mode;
    __device__ __forceinline__ void operator()(const pg8::f32x4 (&acc)[2][2][4][2], const pg8::Unit& u, int wr, int wc, int fr, int fq) const {
        const int tA = mode == 2 ? amap_tile(u.pm, half) : (mode == 3 ? (u.pm < 2 * NT0 ? amap_tile(u.pm, 0) : amap_tile(u.pm - 2 * NT0, 1)) : u.pm), tC = mode == 1 ? cmap_tile(u.pm, half) : u.pm;
        const int row0 = tA * 256 + wr * 64 + fr, row0C = tC * 256 + wr * 64 + fr, col0 = u.pn * 256 + wc * 32 + 8 * fq;
#pragma unroll
        for (int ai = 0; ai < 2; ++ai)
#pragma unroll
            for (int m = 0; m < 4; ++m) {
                const int row = row0 + ai * 128 + m * 16, rowC = row0C + ai * 128 + m * 16; float s = 0.f;
#pragma unroll
                for (int bj = 0; bj < 2; ++bj) {
                    const size_t o = (size_t)row * D + col0 + bj * 128, oC = (size_t)rowC * D + col0 + bj * 128;
                    const f32x4 b0 = *(const f32x4*)(base + o), b1 = *(const f32x4*)(base + o + 4);
                    const f32x4 h0 = b0 + acc[ai][bj][m][0] * scale, h1 = b1 + acc[ai][bj][m][1] * scale;
                    *(f32x4*)(out + o) = h0; *(f32x4*)(out + o + 4) = h1;
                    if (xb) { u32x4 w; w.x = pk2(h0[0], h0[1]); w.y = pk2(h0[2], h0[3]); w.z = pk2(h1[0], h1[1]); w.w = pk2(h1[2], h1[3]); *(u32x4*)(xb + oC) = w; }
                    s += (h0[0] * h0[0] + h0[1] * h0[1]) + (h0[2] * h0[2] + h0[3] * h0[3]) + (h1[0] * h1[0] + h1[1] * h1[1]) + (h1[2] * h1[2] + h1[3] * h1[3]);
                }
                if (ssq) { s += __shfl_xor(s, 16); s += __shfl_xor(s, 32); if (fq == 0) atomicAdd(ssq + row, s); }
            }
    }
};
struct HalfOrder {
    pg8::StaticOrder so; int half, actual;
    __device__ __forceinline__ void init(int N, int G_, int c_, int half_, int actual_) { so.init((half_ ? 2 * NT1 : 2 * NT0) * 256, N, G_, c_); half = half_; actual = actual_; }
    __device__ __forceinline__ bool next(int i, pg8::Unit& u) const { if (!so.next(i, u)) return false; if (actual) u.pm = amap_tile(u.pm, half); return true; }
    __device__ __forceinline__ void a_ready(const pg8::Unit&) const {}
    __device__ __forceinline__ void done(const pg8::Unit&) const {}
};
struct EpiU {
    static constexpr bool PERM = true, AFTER_DRAIN = false;
    bf16* uda; bf16* urw; const float* ssq;
    __device__ __forceinline__ void operator()(const pg8::f32x4 (&acc)[2][2][4][2], const pg8::Unit& u, int wr, int wc, int fr, int fq) const {
        const int row0 = u.pm * 256 + wr * 64 + fr, col0 = u.pn * 256 + wc * 32 + 8 * fq;
#pragma unroll
        for (int ai = 0; ai < 2; ++ai)
#pragma unroll
            for (int m = 0; m < 4; ++m) {
                const int row = row0 + ai * 128 + m * 16;
                const int pr = (row >> 13) * LP + NMETA + (row & 8191);
                const float rs = rsqrtf(ssq[row] * (1.0f / D) + NORM_EPS);
#pragma unroll
                for (int bj = 0; bj < 2; ++bj) {
                    const int c = col0 + bj * 128;
                    if (c < NIN) {
                        float t[8];
#pragma unroll
                        for (int n = 0; n < 2; ++n)
#pragma unroll
                            for (int e = 0; e < 4; ++e) t[4 * n + e] = acc[ai][bj][m][n][e] * rs;
                        bf16* dst = (c < DAW) ? (uda + (size_t)pr * DAW + c) : (urw + (size_t)pr * RWW + (c - DAW));
                        *(u32x4*)dst = pack8(t);
                    }
                }
            }
    }
};

__device__ __forceinline__ f32x4 mfma16(bf16x8 a, bf16x8 b, f32x4 c) { return __builtin_amdgcn_mfma_f32_16x16x32_bf16(a, b, c, 0, 0, 0); }
__device__ __forceinline__ f32x16 mfma32(bf16x8 a, bf16x8 b, f32x16 c) { return __builtin_amdgcn_mfma_f32_32x32x16_bf16(a, b, c, 0, 0, 0); }
__device__ __forceinline__ f32x4 mm16(const bf16* A, int lda, const bf16* Bt, int ldb, int K, int lane) {
    const int r = lane & 15, q = lane >> 4;
    const bf16x8* ap = (const bf16x8*)(A + (size_t)r * lda + 8 * q);
    const bf16x8* bp = (const bf16x8*)(Bt + (size_t)r * ldb + 8 * q);
    f32x4 acc = {0.f, 0.f, 0.f, 0.f};
#pragma unroll 8
    for (int kk = 0; kk < K / 32; ++kk) acc = mfma16(ap[4 * kk], bp[4 * kk], acc);
    return acc;
}
__device__ __forceinline__ void transpose_item(const float* W, int K, int N, bf16* WT, const float* gain, int mode, LAS float* scr, int item, int lane) {
    const int nblk = (N + 63) / 64, kb = item / nblk, nb = item % nblk, k0 = 64 * kb, n0 = 64 * nb;
    const int r4 = lane >> 4, c4 = (lane & 15) * 4;
    const bool colok = n0 + c4 < N;
#pragma unroll
    for (int i = 0; i < 16; ++i) {
        const int kk = r4 + 4 * i;
        f32x4 v = {0.f, 0.f, 0.f, 0.f};
        if (colok) v = *(const f32x4*)(W + (size_t)(k0 + kk) * N + n0 + c4);
        if (gain) v = v * gain[k0 + kk];
        LAS float* d = scr + kk * 65 + c4; d[0] = v.x; d[1] = v.y; d[2] = v.z; d[3] = v.w;
    }
    asm volatile("s_waitcnt lgkmcnt(0)" ::: "memory");
    const int c = lane & 7;
#pragma unroll
    for (int j = 0; j < 8; ++j) {
        const int nl = (lane >> 3) + 8 * j, n = n0 + nl; const LAS float* s = scr + (8 * c) * 65 + nl;
        const int orow = (mode == 0) ? n : ((n >> 7) * 256 + (n & 127) + (mode == 2 ? 128 : 0));
        u32x4 o; o.x = pk2(s[0 * 65], s[1 * 65]); o.y = pk2(s[2 * 65], s[3 * 65]); o.z = pk2(s[4 * 65], s[5 * 65]); o.w = pk2(s[6 * 65], s[7 * 65]);
        if (n < N) *(u32x4*)(WT + (size_t)orow * K + k0 + 8 * c) = o;
    }
    asm volatile("s_waitcnt lgkmcnt(0)" ::: "memory");
}
__device__ __forceinline__ void row_to_bf16(const float* xrow, bf16* orow, float* ssq_out, int lane) {
    const f32x4* xr = (const f32x4*)xrow + lane; f32x4 v[4]; float s = 0.f;
#pragma unroll
    for (int j = 0; j < 4; ++j) { v[j] = xr[64 * j]; s += (v[j].x * v[j].x + v[j].y * v[j].y) + (v[j].z * v[j].z + v[j].w * v[j].w); }
    s = wave_sum(s); if (lane == 0) *ssq_out = s;
    u32x2* o8 = (u32x2*)orow + lane;
#pragma unroll
    for (int j = 0; j < 4; ++j) { u32x2 w; w.x = pk2(v[j].x, v[j].y); w.y = pk2(v[j].z, v[j].w); o8[64 * j] = w; }
}
__device__ __forceinline__ float dpp_f(float x, int ctrl_sel) {
    const int xi = __builtin_bit_cast(int, x); int r;
    if (ctrl_sel == 0) r = __builtin_amdgcn_update_dpp(0, xi, 0xB1, 0xF, 0xF, true);
    else if (ctrl_sel == 1) r = __builtin_amdgcn_update_dpp(0, xi, 0x4E, 0xF, 0xF, true);
    else if (ctrl_sel == 2) r = __builtin_amdgcn_update_dpp(0, xi, 0x141, 0xF, 0xF, true);
    else r = __builtin_amdgcn_update_dpp(0, xi, 0x140, 0xF, 0xF, true);
    return __builtin_bit_cast(float, r);
}
__device__ __forceinline__ float fmul_s(float a, float b) { float r; asm("v_mul_f32_e32 %0, %1, %2" : "=v"(r) : "v"(a), "v"(b)); return r; }
__device__ __forceinline__ float fadd_s(float a, float b) { float r; asm("v_add_f32_e32 %0, %1, %2" : "=v"(r) : "v"(a), "v"(b)); return r; }
__device__ __forceinline__ float fsub_s(float a, float b) { float r; asm("v_sub_f32_e32 %0, %1, %2" : "=v"(r) : "v"(a), "v"(b)); return r; }
__device__ __forceinline__ float ffma_s(float a, float b, float c) { float r; asm("v_fma_f32 %0, %1, %2, %3" : "=v"(r) : "v"(a), "v"(b), "v"(c)); return r; }
__device__ __forceinline__ float sum16(float x) { x += dpp_f(x, 0); x += dpp_f(x, 1); x += dpp_f(x, 2); x += dpp_f(x, 3); return x; }

#define XB_TMO      128
#define XB_XCNT(j)  (256  + 64 * (j))
#define XB_XSUB(j)  (1280 + 64 * (j))
#define XB_XGEN(j)  (2304 + 64 * (j))
#define XB_TOP      3328
#define XB_TOPGEN   3392
#define XCD_BAR_WORDS 3456
#define XB_SPIN_CAP (1u << 18)

__device__ __forceinline__ unsigned xb_ld(unsigned* p)              { return __hip_atomic_load(p, __ATOMIC_RELAXED, __HIP_MEMORY_SCOPE_AGENT); }
__device__ __forceinline__ unsigned xb_add(unsigned* p, unsigned v) { return __hip_atomic_fetch_add(p, v, __ATOMIC_RELAXED, __HIP_MEMORY_SCOPE_AGENT); }
__device__ __forceinline__ unsigned xb_xcc_id() { return (unsigned)__builtin_amdgcn_s_getreg((3 << 11) | 20) & 0xFu; }
#define XB_SPIN(cond, bar) do { unsigned _sp = 0; while (cond) { __builtin_amdgcn_s_sleep(1); \
    if ((++_sp & 255u) == 0u) { if (xb_ld(&(bar)[XB_TMO])) break; if (_sp > XB_SPIN_CAP) { atomicAdd(&(bar)[XB_TMO], 1u); break; } } } } while (0)

struct XcdBarrier {
    unsigned* bar; unsigned x;
    volatile LAS unsigned* st;
};

__device__ __forceinline__ XcdBarrier xcd_barrier_post(unsigned* bar, volatile LAS unsigned* st) {
    XcdBarrier b; b.bar = bar; b.x = xb_xcc_id(); b.st = st;
    if (threadIdx.x == 0) (void)xb_add(&bar[XB_XCNT(b.x)], 1u);
    return b;
}
__device__ __forceinline__ void xcd_barrier_complete(unsigned* bar, unsigned x, unsigned& nloc, unsigned& nx, unsigned gsz) {
    const unsigned G = gsz;
    unsigned sum, cnt, mine, sp = 0u;
    for (;;) {
        sum = 0u; cnt = 0u; mine = 0u;
#pragma unroll
        for (unsigned j = 0; j < 16; ++j) { const unsigned c = xb_ld(&bar[XB_XCNT(j)]); sum += c; cnt += (c > 0u) ? 1u : 0u; mine = (j == x) ? c : mine; }
        if (sum == G) break;
        __builtin_amdgcn_s_sleep(1);
        if ((++sp & 255u) == 0u) { if (xb_ld(&bar[XB_TMO])) break; if (sp > XB_SPIN_CAP) { atomicAdd(&bar[XB_TMO], 1u); break; } }
    }
    nloc = mine > 0u ? mine : 1u; nx = cnt > 0u ? cnt : 1u;
}

__device__ __forceinline__ void xcd_barrier(const XcdBarrier& b, unsigned gsz = 0u) {
    asm volatile("s_waitcnt vmcnt(0)" ::: "memory");
    __syncthreads();
    if (threadIdx.x == 0) {
        unsigned* bar = b.bar;
        __builtin_amdgcn_s_waitcnt(0);
        unsigned nloc = b.st[0], nx = b.st[1];
        if (nloc == 0u) { xcd_barrier_complete(bar, b.x, nloc, nx, gsz ? gsz : gridDim.x); b.st[0] = nloc; b.st[1] = nx; }
        const unsigned old = xb_add(&bar[XB_XSUB(b.x)], 1u);
        const unsigned gen = old / nloc;
        if (old + 1u == (gen + 1u) * nloc) {
            __builtin_amdgcn_fence(__ATOMIC_RELEASE, "agent");
            asm volatile("s_waitcnt vmcnt(0)" ::: "memory");
            const unsigned og = xb_add(&bar[XB_TOP], 1u);
            const unsigned tg = og / nx;
            if (og + 1u == (tg + 1u) * nx) xb_add(&bar[XB_TOPGEN], 1u);
            else XB_SPIN(xb_ld(&bar[XB_TOPGEN]) == tg, bar);
            __builtin_amdgcn_fence(__ATOMIC_ACQUIRE, "agent");
            xb_add(&bar[XB_XGEN(b.x)], 1u);
            asm volatile("s_waitcnt vmcnt(0)" ::: "memory");
        } else {
            XB_SPIN(xb_ld(&bar[XB_XGEN(b.x)]) == gen, bar);
            __builtin_amdgcn_fence(__ATOMIC_ACQUIRE, "agent");
            asm volatile("s_waitcnt vmcnt(0)" ::: "memory");
        }
    }
    __syncthreads();
}

__device__ __forceinline__ void p6_half(const bf16* URW, const bf16* Ab, const bf16* Gb, const bf16* Y, bf16* XB, const float* mixp, const float* ka, const float* rk, const float* lnwp, const float* lnbp,
                                        int half, int wi, int nw, int lane) {
    const int c0 = 8 * lane;
    float mr[8], mk[8], mv[8], kac[8], rkc[8], lnw[8], lnb[8];
#pragma unroll
    for (int j = 0; j < 8; ++j) { mr[j] = mixp[c0 + j]; mk[j] = mixp[512 + c0 + j]; mv[j] = mixp[1024 + c0 + j]; kac[j] = ka[c0 + j]; rkc[j] = rk[c0 + j]; lnw[j] = lnwp[c0 + j]; lnb[j] = lnbp[c0 + j]; }
    for (int r = wi; r < (half ? 2 * NT1 : 2 * NT0) * 256; r += nw) {
        const int m = amap_tile(r >> 8, half) * 256 + (r & 255);
        const int b = m >> 13, t = m & 8191, pr = b * LP + NMETA + t;
        const bf16* cur = URW + (size_t)pr * RWW + c0; const bf16* prv = cur - RWW;
        float rc[8], rp[8], kc[8], kp[8], vc[8], vp[8], a8[8], g8[8], y[8];
        unpack8(*(const u32x4*)cur, rc); unpack8(*(const u32x4*)prv, rp); unpack8(*(const u32x4*)(cur + 512), kc); unpack8(*(const u32x4*)(prv + 512), kp);
        unpack8(*(const u32x4*)(cur + 1024), vc); unpack8(*(const u32x4*)(prv + 1024), vp);
        unpack8(*(const u32x4*)(Ab + (size_t)pr * 512 + c0), a8); unpack8(*(const u32x4*)(Gb + (size_t)pr * 512 + c0), g8);
        unpack8(*(const u32x4*)(Y + (size_t)m * 512 + c0), y);
        float s = 0.f, beta = 0.f;
#pragma unroll
        for (int j = 0; j < 8; ++j) { s += y[j]; const float r_ = rc[j] + (rp[j] - rc[j]) * mr[j], k_ = kc[j] + (kp[j] - kc[j]) * mk[j]; beta += r_ * (k_ * (1.0f + (a8[j] - 1.0f) * kac[j])) * rkc[j]; }
        s += __shfl_xor(s, 1); s += __shfl_xor(s, 2); s += __shfl_xor(s, 4);
        beta += __shfl_xor(beta, 1); beta += __shfl_xor(beta, 2); beta += __shfl_xor(beta, 4);
        const float mu = s * (1.0f / 64); float q = 0.f;
#pragma unroll
        for (int j = 0; j < 8; ++j) { y[j] -= mu; q += y[j] * y[j]; }
        q += __shfl_xor(q, 1); q += __shfl_xor(q, 2); q += __shfl_xor(q, 4);
        const float rstd = rsqrtf(q * (1.0f / 64) + GN_EPS);
        float o[8];
#pragma unroll
        for (int j = 0; j < 8; ++j) { const float v_ = vc[j] + (vp[j] - vc[j]) * mv[j]; o[j] = (y[j] * rstd * lnw[j] + lnb[j] + beta * v_) * g8[j]; }
        *(u32x4*)(XB + (size_t)m * D + 512 + c0) = pack8(o);
    }
}
#define TAIL_HALF(HALF_, GS_, CI_, BAR1_, BAR2_) do { \
        p6_half(URW, Ab, Gb, Y, XB, args.in[I_SHIFT], args.in[I_KA], args.in[I_RK], args.in[I_LNW], args.in[I_LNB], (HALF_), (CI_) * NWAVES + wave, (GS_) * NWAVES, lane); \
        BAR1_; \
        { pg8::Gemm g{XB, WOUT, M / 2, D, D}; HalfOrder S; S.init(D, (GS_), (CI_), (HALF_), 1); EpiRes E{out, out, XB2, ssq2, 1.0f, (HALF_), 1}; \
          pg8::gemm_phase<EpiRes, HalfOrder, PG8_ALIGN, PG8_SP2>(lds, g, S, E); } \
        BAR2_; \
        { pg8::Gemm g{XB2, W2A, M / 2, 2 * FF, D}; HalfOrder S; S.init(2 * FF, (GS_), (CI_), (HALF_), 0); EpiSwiglu E{TC + (size_t)((HALF_) ? 2 * NT0 * 256 : 0) * FF, ssq2, (HALF_), 1}; \
          pg8::gemm_phase<EpiSwiglu, HalfOrder, PG8_ALIGN, PG8_SP2>(lds, g, S, E); } \
    } while (0)
__device__ __forceinline__ void sub_barrier(unsigned* ctr, unsigned target) {
    asm volatile("s_waitcnt vmcnt(0)" ::: "memory");
    __syncthreads();
    if (threadIdx.x == 0) {
        __builtin_amdgcn_fence(__ATOMIC_RELEASE, "agent"); asm volatile("s_waitcnt vmcnt(0)" ::: "memory");
        __hip_atomic_fetch_add(ctr, 1u, __ATOMIC_RELAXED, __HIP_MEMORY_SCOPE_AGENT);
        unsigned sp = 0;
        while (__hip_atomic_load(ctr, __ATOMIC_RELAXED, __HIP_MEMORY_SCOPE_AGENT) < target) { __builtin_amdgcn_s_sleep(2); if (++sp > (1u << 22)) break; }
        __builtin_amdgcn_fence(__ATOMIC_ACQUIRE, "agent"); asm volatile("s_waitcnt vmcnt(0)" ::: "memory");
    }
    __syncthreads();
}
__device__ __forceinline__ void wait_flag(unsigned* ctr, unsigned target) {
    if (threadIdx.x == 0) {
        unsigned sp = 0;
        while (__hip_atomic_load(ctr, __ATOMIC_RELAXED, __HIP_MEMORY_SCOPE_AGENT) < target) { __builtin_amdgcn_s_sleep(4); if (++sp > (1u << 22)) break; }
        __builtin_amdgcn_fence(__ATOMIC_ACQUIRE, "agent"); asm volatile("s_waitcnt vmcnt(0)" ::: "memory");
    }
    __syncthreads();
}
constexpr int LDS_BYTES = 147456;
constexpr int ATT_KB = 64 * 272, ATT_VB = 128 * 136, ATT_BUF = ATT_KB + ATT_VB;
constexpr int LDS_MISC = 143360;
constexpr int SCAN_STEP_F = 384, SCAN_CH = 32;

__global__ void __launch_bounds__(NTHR, 2) fwd_kernel(Args args) {
    extern __shared__ __attribute__((aligned(16))) unsigned char lds_raw[];
    LAS unsigned char* lds = (LAS unsigned char*)lds_raw;
    const int tid = threadIdx.x, lane = tid & 63, wave = __builtin_amdgcn_readfirstlane(tid >> 6);
    const int G = gridDim.x, bx = blockIdx.x;
    const int gw = bx * NWAVES + wave, NGW = G * NWAVES;
    unsigned char* ws = args.ws;
    bf16* XB = (bf16*)(ws + WS_XB); bf16* TB = (bf16*)(ws + WS_T); bf16* URW = (bf16*)(ws + WS_URW); bf16* UDA = (bf16*)(ws + WS_UDA); bf16* Y = (bf16*)(ws + WS_Y); bf16* TC = (bf16*)(ws + WS_TC);
    bf16* Qb = (bf16*)(ws + WS_Q); bf16* Kb = (bf16*)(ws + WS_K); bf16* Vt = (bf16*)(ws + WS_VT);
    bf16* W1A = (bf16*)(ws + WS_W1A); bf16* W1D = (bf16*)(ws + WS_W1D); bf16* WIN = (bf16*)(ws + WS_WIN); bf16* XB2 = (bf16*)(ws + WS_XB2);
    bf16* W2A = (bf16*)(ws + WS_W2A); bf16* W2D = (bf16*)(ws + WS_W2D);
    bf16* Eb = (bf16*)(ws + WS_E); bf16* Ab = (bf16*)(ws + WS_A); bf16* Gb = (bf16*)(ws + WS_G);
    bf16* WOUT = (bf16*)(ws + WS_WOUT);
    bf16* W2T = (bf16*)(ws + WS_LORA); bf16* A2T = W2T + 512 * 64; bf16* G2T = A2T + 512 * 64;
    unsigned char* sm = ws + WS_SMALL;
    float* ssq0 = (float*)(sm + SM_SSQ0); float* ssq1 = (float*)(sm + SM_SSQ1); float* ssq2 = (float*)(sm + SM_SSQ2); float* INV = (float*)(sm + SM_BETA);
    bf16* XBM = (bf16*)(sm + SM_XBM); bf16* XBM2 = (bf16*)(sm + SM_XBM2); bf16* TM = (bf16*)(sm + SM_TM);
    float* ssqm0 = (float*)(sm + SM_SSQM0); float* ssqm1 = (float*)(sm + SM_SSQM1); float* misc = (float*)(sm + SM_MISC); unsigned* qctr = (unsigned*)(misc + 16);
    const float* x = args.in[I_X];
    float* out = args.out;
    if (tid < 4) ((LAS unsigned*)(lds + LDS_MISC + 64))[tid] = 0u;
    __syncthreads();
    const XcdBarrier xbar = xcd_barrier_post((unsigned*)(sm + SM_BAR), (volatile LAS unsigned*)(lds + LDS_MISC + 64));
    if (bx >= 64 && tid == 0) (void)xb_add(&((unsigned*)(sm + SM_BAR) + 4096)[XB_XCNT(xbar.x)], 1u);

    {
        LAS float* scr = (LAS float*)(lds + wave * 16640);
        constexpr int IT_G = (D / 64) * (FF / 64);
        for (int it = gw; it < 2 * IT_G; it += NGW) {
            if (it < IT_G) transpose_item(args.in[I_F1G], D, FF, W1A, args.in[I_F1N], 1, scr, it, lane);
            else transpose_item(args.in[I_F1U], D, FF, W1A, args.in[I_F1N], 2, scr, it - IT_G, lane);
        }
        for (int m = gw; m < M; m += NGW) row_to_bf16(x + (size_t)m * D, XB + (size_t)m * D, ssq0 + m, lane);
        if (gw < NMETA) row_to_bf16(args.in[I_META] + (size_t)gw * D, XBM + (size_t)gw * D, ssqm0 + gw, lane);
        const int gt = bx * NTHR + tid, NGT = G * NTHR;
        for (int i = gt; i < M; i += NGT) { ssq1[i] = 0.f; ssq2[i] = 0.f; }
        if (gt < 16) ssqm1[gt] = 0.f;
        if (gt == 0) { qctr[0] = 0u; qctr[1] = 0u; }
        for (int i = gt; i < 512 * 64; i += NGT) { const int n = i >> 6, k = i & 63; W2T[i] = (bf16)f2bf(args.in[I_W2][k * 512 + n]); A2T[i] = (bf16)f2bf(args.in[I_A2][k * 512 + n]); }
        for (int i = gt; i < 512 * 160; i += NGT) { const int n = i / 160, k = i % 160; G2T[i] = (bf16)f2bf(args.in[I_G2][k * 512 + n]); }
        if (gw == 0) {
            const float s1 = wave_sum(args.in[I_LQ1][lane] * args.in[I_LK1][lane]), s2 = wave_sum(args.in[I_LQ2][lane] * args.in[I_LK2][lane]);
            if (lane == 0) misc[0] = expf(s1) - expf(s2) + 0.2f;
        }
    }
    xcd_barrier(xbar);

    {
        const int mw1 = (G == 256) ? (bx >= 128 ? (bx - 128) * NWAVES + wave : (1 << 30)) : gw, ms1 = (G == 256) ? 128 * NWAVES : NGW;
        for (int hc = mw1; hc < FF / 16; hc += ms1) {
            const int grow = (hc >> 3) * 256 + (hc & 7) * 16;
            const f32x4 ag = mm16(XBM, D, W1A + (size_t)grow * D, D, D, lane), au = mm16(XBM, D, W1A + (size_t)(grow + 128) * D, D, D, lane);
#pragma unroll
            for (int e = 0; e < 4; ++e) { const int row = 4 * (lane >> 4) + e; const float rs = rsqrtf(ssqm0[row] * (1.0f / D) + NORM_EPS); const float g = ag[e] * rs, up = au[e] * rs;
                TM[row * FF + hc * 16 + (lane & 15)] = (bf16)f2bf(g * sigmoidf_(g) * up); }
        }
        pg8::Gemm g{XB, W1A, M, 2 * FF, D}; pg8::StaticOrder S; S.init(M, 2 * FF, G, bx);
        EpiSwiglu E{TB, ssq0, 0, 0};
        pg8::gemm_phase<EpiSwiglu, pg8::StaticOrder, PG8_ALIGN, PG8_SP2>(lds, g, S, E);
        if (G == 256 ? bx >= 128 : true) {
            LAS float* scr = (LAS float*)(lds + wave * 16640);
            constexpr int IT_D = (FF / 64) * (D / 64), IT_IN = (D / 64) * ((NIN + 63) / 64), IT_O = (D / 64) * (D / 64), NIT = IT_D + IT_IN + IT_O;
            const int nb = (G == 256) ? 128 : G, b0 = (G == 256) ? 128 : 0;
            for (int it = (bx - b0) * NWAVES + wave; it < NIT; it += nb * NWAVES) {
                int r = it;
                if (r < IT_D) { transpose_item(args.in[I_F1D], FF, D, W1D, nullptr, 0, scr, r, lane); continue; } r -= IT_D;
                if (r < IT_IN) { transpose_item(args.in[I_WIN], D, NIN, WIN, args.in[I_MIXN], 0, scr, r, lane); continue; } r -= IT_IN;
                transpose_item(args.in[I_WOUT], D, D, WOUT, nullptr, 0, scr, r, lane);
            }
        }
    }
    xcd_barrier(xbar);

    {
        for (int cb = bx; cb < D / 16; cb += G) {
            f32x4 a = mm16(TM + 352 * wave, FF, W1D + (size_t)cb * 16 * FF + 352 * wave, FF, 352, lane);
            LAS f32x4* red = (LAS f32x4*)lds;
            red[wave * 64 + lane] = a;
            __syncthreads();
            if (wave == 0) {
#pragma unroll
                for (int w8 = 1; w8 < 8; ++w8) a += red[w8 * 64 + lane];
#pragma unroll
                for (int e = 0; e < 4; ++e) { const int row = 4 * (lane >> 4) + e, col = cb * 16 + (lane & 15); const float h = args.in[I_META][row * D + col] + 0.5f * a[e];
                    XBM2[row * D + col] = (bf16)f2bf(h); float s = h * h; s += __shfl_xor(s, 1); s += __shfl_xor(s, 2); s += __shfl_xor(s, 4); s += __shfl_xor(s, 8);
                    if ((lane & 15) == 0) atomicAdd(ssqm1 + row, s); }
            }
            __syncthreads();
        }
        pg8::Gemm g{TB, W1D, M, D, FF}; pg8::StaticOrder S; S.init(M, D, G, bx);
        EpiRes E{x, out, XB, ssq1, 0.5f, 0, 0};
        pg8::gemm_phase<EpiRes, pg8::StaticOrder, PG8_ALIGN, PG8_SP2>(lds, g, S, E);
    }
    xcd_barrier(xbar);

    {
        const int mw3 = (G == 256) ? (bx >= 128 ? (bx - 128) * NWAVES + wave : (1 << 30)) : gw, ms3 = (G == 256) ? 128 * NWAVES : NGW;
        for (int cb = mw3; cb < NIN / 16; cb += ms3) {
            const f32x4 a = mm16(XBM2, D, WIN + (size_t)cb * 16 * D, D, D, lane);
#pragma unroll
            for (int e = 0; e < 4; ++e) { const int row = 4 * (lane >> 4) + e, col = cb * 16 + (lane & 15); const float rs = rsqrtf(ssqm1[row] * (1.0f / D) + NORM_EPS);
                const bf16 v = (bf16)f2bf(a[e] * rs);
#pragma unroll
                for (int b = 0; b < BATCH; ++b) { const int pr = b * LP + row; if (col < DAW) UDA[(size_t)pr * DAW + col] = v; else URW[(size_t)pr * RWW + col - DAW] = v; } }
        }
        pg8::Gemm g{XB, WIN, M, NINP, D}; pg8::StaticOrder S; S.init(M, NINP, G, bx);
        EpiU E{UDA, URW, ssq1};
        pg8::gemm_phase<EpiU, pg8::StaticOrder, PG8_ALIGN, PG8_SP2>(lds, g, S, E);
    }
    xcd_barrier(xbar);

    constexpr int PFXG = 65, PFX = PFXG * 16;
    unsigned* p4flag = (unsigned*)(sm + SM_BAR) + SUBW + 64 * 6;
    { constexpr int pass = 0;
        const int wg0 = pass ? bx - 64 : bx, nwg = pass ? G - 64 : G;
        int zo = 0; asm volatile("" : "+s"(zo));
        if (pass == 0) {
            const int e8 = lane & 7, d0 = e8 * 8, grp = lane >> 3, hh = grp >> 1, cc = grp & 1;
            float qn[8], kn[8];
#pragma unroll
            for (int j = 0; j < 8; ++j) { qn[j] = args.in[I_QN][d0 + j + zo]; kn[j] = args.in[I_KN][d0 + j + zo]; }
            float kmix[8], kkc8[8];
#pragma unroll
            for (int j = 0; j < 8; ++j) { kmix[j] = args.in[I_SHIFT][512 + 8 * lane + j + zo]; kkc8[j] = args.in[I_KK][8 * lane + j + zo]; }
            const double invf[8] = {1.0, 0.19392274474868576, 0.03760603093086393, 0.007292664737217109, 0.001414213562373095, 0.0002742481756762073, 5.318295896944988e-05, 1.031338537721246e-05};
            const int np = LP, p00 = 0;
            for (int i = (bx < 2) ? BATCH * np : (bx - 2) * NWAVES + wave; i < BATCH * np; i += (G - 2) * NWAVES) {
                const int b = i / np, p = p00 + (i - b * np), pr = b * LP + p;
                const bf16* urow = UDA + (size_t)pr * DAW;
                float q[8], k[8];
                unpack8(*(const u32x4*)(urow + 8 * lane), q); unpack8(*(const u32x4*)(urow + 512 + 8 * lane), k);
                float sq = 0.f, sk = 0.f;
#pragma unroll
                for (int j = 0; j < 8; ++j) { sq += q[j] * q[j]; sk += k[j] * k[j]; }
                sq += __shfl_xor(sq, 1); sq += __shfl_xor(sq, 2); sq += __shfl_xor(sq, 4);
                sk += __shfl_xor(sk, 1); sk += __shfl_xor(sk, 2); sk += __shfl_xor(sk, 4);
                const float rq = rsqrtf(sq * (1.0f / 64) + NORM_EPS), rk = rsqrtf(sk * (1.0f / 64) + NORM_EPS);
#pragma unroll
                for (int j = 0; j < 8; ++j) { q[j] *= rq * qn[j]; k[j] *= rk * kn[j]; }
#pragma unroll
                for (int j = 0; j < 8; ++j) {
                    const float qo = __shfl_xor(q[j], 1), ko = __shfl_xor(k[j], 1);
                    if (e8 < 2) {
                        double rev = (double)p * invf[j] * 0.15915494309189535; rev -= floor(rev);
                        const float rf = (float)rev, cs = __builtin_amdgcn_cosf(rf), sn = __builtin_amdgcn_sinf(rf);
                        if (e8 == 0) { q[j] = q[j] * cs - qo * sn; k[j] = k[j] * cs - ko * sn; }
                        else         { q[j] = q[j] * cs + qo * sn; k[j] = k[j] * cs + ko * sn; }
                    }
                }
#pragma unroll
                for (int j = 0; j < 8; ++j) q[j] *= 0.18033688011112042f;
                const size_t o = ((size_t)(b * 4 + hh) * VP + p) * 128 + cc * 64 + d0;
                *(u32x4*)(Qb + o) = pack8(q); *(u32x4*)(Kb + o) = pack8(k);
                {
                    const bf16* rrow = URW + (size_t)pr * RWW + 512 + 8 * lane;
                    float kc[8], kp8[8];
                    unpack8(*(const u32x4*)rrow, kc);
                    if (p > 0) unpack8(*(const u32x4*)(rrow - RWW), kp8); else {
#pragma unroll
                        for (int j = 0; j < 8; ++j) kp8[j] = 0.f; }
                    float ss = 0.f;
#pragma unroll
                    for (int j = 0; j < 8; ++j) { const float kv = (kc[j] + (kp8[j] - kc[j]) * kmix[j]) * kkc8[j]; ss += kv * kv; }
                    ss += __shfl_xor(ss, 1); ss += __shfl_xor(ss, 2); ss += __shfl_xor(ss, 4);
                    if (e8 == 0) INV[(size_t)pr * 8 + grp] = 1.0f / fmaxf(sqrtf(ss), 1e-12f);
                }
            }
        }
        if (pass == 0) {
            LAS unsigned short* tile = (LAS unsigned short*)lds;
            for (int it = wg0; it < BATCH * (VP / 64); it += nwg) {
                const int b = it / (VP / 64), p0 = (it % (VP / 64)) * 64;
#pragma unroll
                for (int i = 0; i < 8; ++i) {
                    const int id = tid + NTHR * i, row = id >> 6, c16 = id & 63;
                    u32x4 v = {0u, 0u, 0u, 0u};
                    if (p0 + row < LP) v = *(const u32x4*)(UDA + (size_t)(b * LP + p0 + row) * DAW + 1024 + c16 * 8);
                    *(LAS u32x4*)(tile + row * 520 + c16 * 8) = v;
                }
                __syncthreads();
                {
                    unsigned w[32];
#pragma unroll
                    for (int pp = 0; pp < 32; ++pp) w[pp] = (unsigned)tile[(2 * pp) * 520 + tid] | ((unsigned)tile[(2 * pp + 1) * 520 + tid] << 16);
                    u32x4* dst = (u32x4*)(Vt + ((size_t)(b * 4 + (tid >> 7)) * 128 + (tid & 127)) * VP + p0);
#pragma unroll
                    for (int i = 0; i < 8; ++i) { u32x4 o; o.x = w[4 * i]; o.y = w[4 * i + 1]; o.z = w[4 * i + 2]; o.w = w[4 * i + 3]; dst[i] = o; }
                }
                __syncthreads();
            }
        }
        {
            const int r16 = lane & 15, q4 = lane >> 4;
            const float* mixp = args.in[I_SHIFT];
            const int ng = pass ? LP / 16 - PFXG : PFXG, g00 = pass ? PFXG : 0;
            for (int it2 = wave * nwg + wg0; it2 < 2 * BATCH * ng; it2 += nwg * NWAVES) {
                const int j2 = it2 >> 1, b2 = j2 / ng, rg = b2 * (LP / 16) + g00 + (j2 - b2 * ng), cb0 = (it2 & 1) * 16;
                const int pr = rg * 16 + r16, p = pr % LP;
                const bf16* cur = URW + (size_t)pr * RWW; const bf16* prv = cur - RWW;
                bf16x8 Aw[2], Aa[2], Ag[5];
#pragma unroll
                for (int s = 0; s < 9; ++s) {
                    const int col = (s < 2) ? (1536 + 32 * s + 8 * q4) : (s < 4) ? (1600 + 32 * (s - 2) + 8 * q4) : (1664 + 32 * (s - 4) + 8 * q4);
                    float c8[8], p8[8];
                    unpack8(*(const u32x4*)(cur + col), c8);
                    if (p > 0) unpack8(*(const u32x4*)(prv + col), p8); else {
#pragma unroll
                        for (int j = 0; j < 8; ++j) p8[j] = 0.f; }
#pragma unroll
                    for (int j = 0; j < 8; ++j) { float v = c8[j] + (p8[j] - c8[j]) * mixp[col + j];
                        if (s < 2) v = tanhf(v); else if (s >= 4) v = sigmoidf_(v);
                        c8[j] = v; }
                    const u32x4 w = pack8(c8); const bf16x8 f = __builtin_bit_cast(bf16x8, w);
                    if (s < 2) Aw[s] = f; else if (s < 4) Aa[s - 2] = f; else Ag[s - 4] = f;
                }
                for (int cb = cb0; cb < cb0 + 16; ++cb) {
                    const int n = cb * 16 + r16;
                    f32x4 aw = {0.f, 0.f, 0.f, 0.f}, aa = aw, ag = aw;
#pragma unroll
                    for (int s = 0; s < 2; ++s) { aw = mfma16(Aw[s], *(const bf16x8*)(W2T + n * 64 + 32 * s + 8 * q4), aw); aa = mfma16(Aa[s], *(const bf16x8*)(A2T + n * 64 + 32 * s + 8 * q4), aa); }
#pragma unroll
                    for (int s = 0; s < 5; ++s) ag = mfma16(Ag[s], *(const bf16x8*)(G2T + n * 160 + 32 * s + 8 * q4), ag);
                    const float w0 = args.in[I_W0][n], a0 = args.in[I_A0][n];
#pragma unroll
                    for (int e = 0; e < 4; ++e) {
                        const size_t o = (size_t)(rg * 16 + 4 * q4 + e) * 512 + n;
                        Eb[o] = (bf16)f2bf(0.6065306597126334f * sigmoidf_(w0 + aw[e]));
                        Ab[o] = (bf16)f2bf(sigmoidf_(a0 + aa[e]));
                        Gb[o] = (bf16)f2bf(ag[e]);
                    }
                }
            }
        }
        if (pass == 1) {
            asm volatile("s_waitcnt vmcnt(0)" ::: "memory");
            __syncthreads();
            if (tid == 0) { __builtin_amdgcn_fence(__ATOMIC_RELEASE, "agent"); asm volatile("s_waitcnt vmcnt(0)" ::: "memory"); __hip_atomic_fetch_add(p4flag, 1u, __ATOMIC_RELAXED, __HIP_MEMORY_SCOPE_AGENT); }
        }
    }
    xcd_barrier(xbar);
    if (bx >= 64) { constexpr int pass = 1;
        const int wg0 = pass ? bx - 64 : bx, nwg = pass ? G - 64 : G;
        int zo = 0; asm volatile("" : "+s"(zo));
        if (pass == 0) {
            const int e8 = lane & 7, d0 = e8 * 8, grp = lane >> 3, hh = grp >> 1, cc = grp & 1;
            float qn[8], kn[8];
#pragma unroll
            for (int j = 0; j < 8; ++j) { qn[j] = args.in[I_QN][d0 + j + zo]; kn[j] = args.in[I_KN][d0 + j + zo]; }
            float kmix[8], kkc8[8];
#pragma unroll
            for (int j = 0; j < 8; ++j) { kmix[j] = args.in[I_SHIFT][512 + 8 * lane + j + zo]; kkc8[j] = args.in[I_KK][8 * lane + j + zo]; }
            const double invf[8] = {1.0, 0.19392274474868576, 0.03760603093086393, 0.007292664737217109, 0.001414213562373095, 0.0002742481756762073, 5.318295896944988e-05, 1.031338537721246e-05};
            const int np = LP, p00 = 0;
            for (int i = (bx < 2) ? BATCH * np : (bx - 2) * NWAVES + wave; i < BATCH * np; i += (G - 2) * NWAVES) {
                const int b = i / np, p = p00 + (i - b * np), pr = b * LP + p;
                const bf16* urow = UDA + (size_t)pr * DAW;
                float q[8], k[8];
                unpack8(*(const u32x4*)(urow + 8 * lane), q); unpack8(*(const u32x4*)(urow + 512 + 8 * lane), k);
                float sq = 0.f, sk = 0.f;
#pragma unroll
                for (int j = 0; j < 8; ++j) { sq += q[j] * q[j]; sk += k[j] * k[j]; }
                sq += __shfl_xor(sq, 1); sq += __shfl_xor(sq, 2); sq += __shfl_xor(sq, 4);
                sk += __shfl_xor(sk, 1); sk += __shfl_xor(sk, 2); sk += __shfl_xor(sk, 4);
                const float rq = rsqrtf(sq * (1.0f / 64) + NORM_EPS), rk = rsqrtf(sk * (1.0f / 64) + NORM_EPS);
#pragma unroll
                for (int j = 0; j < 8; ++j) { q[j] *= rq * qn[j]; k[j] *= rk * kn[j]; }
#pragma unroll
                for (int j = 0; j < 8; ++j) {
                    const float qo = __shfl_xor(q[j], 1), ko = __shfl_xor(k[j], 1);
                    if (e8 < 2) {
                        double rev = (double)p * invf[j] * 0.15915494309189535; rev -= floor(rev);
                        const float rf = (float)rev, cs = __builtin_amdgcn_cosf(rf), sn = __builtin_amdgcn_sinf(rf);
                        if (e8 == 0) { q[j] = q[j] * cs - qo * sn; k[j] = k[j] * cs - ko * sn; }
                        else         { q[j] = q[j] * cs + qo * sn; k[j] = k[j] * cs + ko * sn; }
                    }
                }
#pragma unroll
                for (int j = 0; j < 8; ++j) q[j] *= 0.18033688011112042f;
                const size_t o = ((size_t)(b * 4 + hh) * VP + p) * 128 + cc * 64 + d0;
                *(u32x4*)(Qb + o) = pack8(q); *(u32x4*)(Kb + o) = pack8(k);
                {
                    const bf16* rrow = URW + (size_t)pr * RWW + 512 + 8 * lane;
                    float kc[8], kp8[8];
                    unpack8(*(const u32x4*)rrow, kc);
                    if (p > 0) unpack8(*(const u32x4*)(rrow - RWW), kp8); else {
#pragma unroll
                        for (int j = 0; j < 8; ++j) kp8[j] = 0.f; }
                    float ss = 0.f;
#pragma unroll
                    for (int j = 0; j < 8; ++j) { const float kv = (kc[j] + (kp8[j] - kc[j]) * kmix[j]) * kkc8[j]; ss += kv * kv; }
                    ss += __shfl_xor(ss, 1); ss += __shfl_xor(ss, 2); ss += __shfl_xor(ss, 4);
                    if (e8 == 0) INV[(size_t)pr * 8 + grp] = 1.0f / fmaxf(sqrtf(ss), 1e-12f);
                }
            }
        }
        if (pass == 0) {
            LAS unsigned short* tile = (LAS unsigned short*)lds;
            for (int it = wg0; it < BATCH * (VP / 64); it += nwg) {
                const int b = it / (VP / 64), p0 = (it % (VP / 64)) * 64;
#pragma unroll
                for (int i = 0; i < 8; ++i) {
                    const int id = tid + NTHR * i, row = id >> 6, c16 = id & 63;
                    u32x4 v = {0u, 0u, 0u, 0u};
                    if (p0 + row < LP) v = *(const u32x4*)(UDA + (size_t)(b * LP + p0 + row) * DAW + 1024 + c16 * 8);
                    *(LAS u32x4*)(tile + row * 520 + c16 * 8) = v;
                }
                __syncthreads();
                {
                    unsigned w[32];
#pragma unroll
                    for (int pp = 0; pp < 32; ++pp) w[pp] = (unsigned)tile[(2 * pp) * 520 + tid] | ((unsigned)tile[(2 * pp + 1) * 520 + tid] << 16);
                    u32x4* dst = (u32x4*)(Vt + ((size_t)(b * 4 + (tid >> 7)) * 128 + (tid & 127)) * VP + p0);
#pragma unroll
                    for (int i = 0; i < 8; ++i) { u32x4 o; o.x = w[4 * i]; o.y = w[4 * i + 1]; o.z = w[4 * i + 2]; o.w = w[4 * i + 3]; dst[i] = o; }
                }
                __syncthreads();
            }
        }
        {
            const int r16 = lane & 15, q4 = lane >> 4;
            const float* mixp = args.in[I_SHIFT];
            const int ng = pass ? LP / 16 - PFXG : PFXG, g00 = pass ? PFXG : 0;
            for (int it2 = wave * nwg + wg0; it2 < 2 * BATCH * ng; it2 += nwg * NWAVES) {
                const int j2 = it2 >> 1, b2 = j2 / ng, rg = b2 * (LP / 16) + g00 + (j2 - b2 * ng), cb0 = (it2 & 1) * 16;
                const int pr = rg * 16 + r16, p = pr % LP;
                const bf16* cur = URW + (size_t)pr * RWW; const bf16* prv = cur - RWW;
                bf16x8 Aw[2], Aa[2], Ag[5];
#pragma unroll
                for (int s = 0; s < 9; ++s) {
                    const int col = (s < 2) ? (1536 + 32 * s + 8 * q4) : (s < 4) ? (1600 + 32 * (s - 2) + 8 * q4) : (1664 + 32 * (s - 4) + 8 * q4);
                    float c8[8], p8[8];
                    unpack8(*(const u32x4*)(cur + col), c8);
                    if (p > 0) unpack8(*(const u32x4*)(prv + col), p8); else {
#pragma unroll
                        for (int j = 0; j < 8; ++j) p8[j] = 0.f; }
#pragma unroll
                    for (int j = 0; j < 8; ++j) { float v = c8[j] + (p8[j] - c8[j]) * mixp[col + j];
                        if (s < 2) v = tanhf(v); else if (s >= 4) v = sigmoidf_(v);
                        c8[j] = v; }
                    const u32x4 w = pack8(c8); const bf16x8 f = __builtin_bit_cast(bf16x8, w);
                    if (s < 2) Aw[s] = f; else if (s < 4) Aa[s - 2] = f; else Ag[s - 4] = f;
                }
                for (int cb = cb0; cb < cb0 + 16; ++cb) {
                    const int n = cb * 16 + r16;
                    f32x4 aw = {0.f, 0.f, 0.f, 0.f}, aa = aw, ag = aw;
#pragma unroll
                    for (int s = 0; s < 2; ++s) { aw = mfma16(Aw[s], *(const bf16x8*)(W2T + n * 64 + 32 * s + 8 * q4), aw); aa = mfma16(Aa[s], *(const bf16x8*)(A2T + n * 64 + 32 * s + 8 * q4), aa); }
#pragma unroll
                    for (int s = 0; s < 5; ++s) ag = mfma16(Ag[s], *(const bf16x8*)(G2T + n * 160 + 32 * s + 8 * q4), ag);
                    const float w0 = args.in[I_W0][n], a0 = args.in[I_A0][n];
#pragma unroll
                    for (int e = 0; e < 4; ++e) {
                        const size_t o = (size_t)(rg * 16 + 4 * q4 + e) * 512 + n;
                        Eb[o] = (bf16)f2bf(0.6065306597126334f * sigmoidf_(w0 + aw[e]));
                        Ab[o] = (bf16)f2bf(sigmoidf_(a0 + aa[e]));
                        Gb[o] = (bf16)f2bf(ag[e]);
                    }
                }
            }
        }
        if (pass == 1) {
            asm volatile("s_waitcnt vmcnt(0)" ::: "memory");
            __syncthreads();
            if (tid == 0) { __builtin_amdgcn_fence(__ATOMIC_RELEASE, "agent"); asm volatile("s_waitcnt vmcnt(0)" ::: "memory"); __hip_atomic_fetch_add(p4flag, 1u, __ATOMIC_RELAXED, __HIP_MEMORY_SCOPE_AGENT); }
        }
    }

    {
        if (bx < 64) {
            const int chain = bx >> 2, quarter = bx & 3, b = chain >> 3, h = chain & 7;
            constexpr int SC2 = 16, OPF = 320, NC2 = LP / SC2;
            static_assert(NC2 * SC2 == LP && (NC2 & 1) == 1, "chunking");
            constexpr int CF = (NMETA + NT0 * 256) / SC2 - 1;
            static_assert((CF & 1) == 0 && (NMETA + NT0 * 256) % SC2 == 0, "flag chunk must be handled in the second half of a loop iteration");
            LAS float* OP = (LAS float*)lds;
            LAS unsigned short* RB = (LAS unsigned short*)(lds + 40960);
            LAS unsigned char* SP = lds + 45056;
            if (wave >= 4) {
                const int lw = wave - 4, li = lane >> 4, lq = lane & 15, c4 = h * 64 + 4 * lq;
                const float* mixp = args.in[I_SHIFT];
                const f32x4 mix_r = *(const f32x4*)(mixp + c4), mix_k = *(const f32x4*)(mixp + 512 + c4), mix_v = *(const f32x4*)(mixp + 1024 + c4);
                const f32x4 kkc = *(const f32x4*)(args.in[I_KK] + c4), kac = *(const f32x4*)(args.in[I_KA] + c4);
                struct LSet { u32x2 rc, rp, kc, kp, vc, vp, e, a; float iv; };
                LSet s0, s1;
                const bf16* ubase = URW + (size_t)b * LP * RWW + c4; const bf16* ebase = Eb + (size_t)b * LP * 512 + c4; const bf16* abase = Ab + (size_t)b * LP * 512 + c4; const float* ibase = INV + (size_t)b * LP * 8 + h;
                bf16* ybase = Y + (size_t)b * T * 512 + h * 64 + 16 * quarter + 4 * (lane >> 4);
                unsigned* halfflag = (unsigned*)(sm + SM_BAR) + SUBW + 64 * 7;
#define UNPK4_(w_) ((f32x4){bflo((w_).x), bfhi((w_).x), bflo((w_).y), bfhi((w_).y)})
#define SCAN_LOAD(S_, c_) do { const int p_ = (c_) * SC2 + 4 * lw + li; const int pm_ = p_ > 0 ? p_ - 1 : 0; const bf16* u_ = ubase + (size_t)p_ * RWW; const bf16* um_ = ubase + (size_t)pm_ * RWW; \
        S_.rc = *(const u32x2*)u_; S_.kc = *(const u32x2*)(u_ + 512); S_.vc = *(const u32x2*)(u_ + 1024); S_.rp = *(const u32x2*)um_; S_.kp = *(const u32x2*)(um_ + 512); S_.vp = *(const u32x2*)(um_ + 1024); \
        S_.e = *(const u32x2*)(ebase + (size_t)p_ * 512); S_.a = *(const u32x2*)(abase + (size_t)p_ * 512); S_.iv = ibase[(size_t)p_ * 8]; } while (0)
#define SCAN_PROC(S_, c_) do { const int p_ = (c_) * SC2 + 4 * lw + li; const float pz_ = p_ == 0 ? 0.f : 1.f;     \
        const f32x4 rc_ = UNPK4_(S_.rc), kc_ = UNPK4_(S_.kc), vc_ = UNPK4_(S_.vc), rp_ = UNPK4_(S_.rp) * pz_, kq_ = UNPK4_(S_.kp) * pz_, vp_ = UNPK4_(S_.vp) * pz_, e_ = UNPK4_(S_.e), a_ = UNPK4_(S_.a); \
        const f32x4 r_ = rc_ + (rp_ - rc_) * mix_r, k_ = kc_ + (kq_ - kc_) * mix_k, v_ = vc_ + (vp_ - vc_) * mix_v; \
        const f32x4 kk_ = k_ * kkc * S_.iv, kpv_ = k_ * ((a_ - 1.0f) * kac + 1.0f); \
        const f32x4 w_ = {__expf(-e_.x), __expf(-e_.y), __expf(-e_.z), __expf(-e_.w)}; \
        LAS float* dst_ = OP + ((c_) & 1) * (SC2 * OPF) + (4 * lw + li) * OPF + 4 * lq; \
        *(LAS f32x4*)dst_ = w_; *(LAS f32x4*)(dst_ + 64) = -kk_; *(LAS f32x4*)(dst_ + 128) = kk_ * a_; *(LAS f32x4*)(dst_ + 192) = kpv_; *(LAS f32x4*)(dst_ + 256) = v_; \
        *(LAS u32x2*)(RB + ((c_) & 1) * (SC2 * 64) + (4 * lw + li) * 64 + 4 * lq) = (u32x2){pk2(r_.x, r_.y), pk2(r_.z, r_.w)}; } while (0)
#define SCAN_YPASS(c_) do { _Pragma("unroll") for (int i_ = 0; i_ < 4; ++i_) { const int st_ = 4 * lw + i_, p_ = (c_) * SC2 + st_; \
        const LAS unsigned char* sp_ = SP + ((c_) & 1) * 36864 + (st_ * 16 + (lane & 15)) * 144 + 16 * (lane >> 4); const LAS unsigned short* rb_ = RB + ((c_) & 1) * (SC2 * 64) + st_ * 64 + 8 * (lane >> 4); \
        f32x4 acc_ = {0.f, 0.f, 0.f, 0.f}; \
        acc_ = mfma16(*(const LAS bf16x8*)sp_, *(const LAS bf16x8*)rb_, acc_); acc_ = mfma16(*(const LAS bf16x8*)(sp_ + 64), *(const LAS bf16x8*)(rb_ + 32), acc_); \
        if ((lane & 15) == 0 && p_ >= NMETA) *(u32x2*)(ybase + (size_t)(p_ - NMETA) * 512) = (u32x2){pk2(acc_.x, acc_.y), pk2(acc_.z, acc_.w)}; } } while (0)
                SCAN_LOAD(s0, 0); SCAN_LOAD(s1, 1); SCAN_PROC(s0, 0); SCAN_LOAD(s0, 2);
                __syncthreads();
                static_assert(((PFXG - 3) & 1) == 0 && PFXG - 3 > 0, "flag wait chunk");
                for (int c = 0; c < NC2; c += 2) {
                    if (c == PFXG - 3) {
                        unsigned sp4 = 0;
                        while (__hip_atomic_load(p4flag, __ATOMIC_RELAXED, __HIP_MEMORY_SCOPE_AGENT) < (unsigned)(G - 64)) { __builtin_amdgcn_s_sleep(2); if (++sp4 > (1u << 22)) break; }
                        __builtin_amdgcn_fence(__ATOMIC_ACQUIRE, "agent");
                    }
                    if (c == CF + 2 && wave == 4 && lane == 0) {
                        __builtin_amdgcn_fence(__ATOMIC_RELEASE, "agent"); asm volatile("s_waitcnt vmcnt(0)" ::: "memory");
                        __hip_atomic_fetch_add(halfflag, 1u, __ATOMIC_RELAXED, __HIP_MEMORY_SCOPE_AGENT);
                    }
                    if (c >= 1) SCAN_YPASS(c - 1);
                    if (c + 1 < NC2) { SCAN_PROC(s1, c + 1); if (c + 3 < NC2) SCAN_LOAD(s1, c + 3); }
                    __syncthreads();
                    if (c + 1 < NC2) {
                        SCAN_YPASS(c);
                        if (c == CF) asm volatile("s_waitcnt vmcnt(0)" ::: "memory");
                        if (c + 2 < NC2) { SCAN_PROC(s0, c + 2); if (c + 4 < NC2) SCAN_LOAD(s0, c + 4); }
                        __syncthreads();
                    }
                }
                SCAN_YPASS(NC2 - 1);
#undef SCAN_LOAD
#undef UNPK4_
#undef SCAN_PROC
#undef SCAN_YPASS
            } else {
                const int rr = lane >> 4, kq = lane & 15, vrow = 16 * quarter + 4 * wave + rr;
                f32x4 S = {0.f, 0.f, 0.f, 0.f};
                __builtin_amdgcn_s_setprio(3);
                __syncthreads();
                for (int c = 0; c < NC2; ++c) {
                    const LAS float* cb = OP + (c & 1) * (SC2 * OPF);
                    LAS unsigned char* spw = SP + (c & 1) * 36864 + (4 * wave + rr) * 144 + 8 * kq;
                    f32x4 w = ((const LAS f32x4*)cb)[kq], an = ((const LAS f32x4*)(cb + 64))[kq], bv = ((const LAS f32x4*)(cb + 128))[kq], kp = ((const LAS f32x4*)(cb + 192))[kq];
                    float vv = cb[256 + vrow];
#define SB_ __builtin_amdgcn_sched_barrier(0)
#pragma unroll
                    for (int st = 0; st < SC2; ++st) {
                        const bool more = st + 1 < SC2;
                        const LAS float* sp = cb + (more ? st + 1 : st) * OPF;
                        f32x4 nw = w, nan_ = an, nbv = bv, nkp = kp; float nvv = vv;
                        f32x2 t = S.zw * an.zw; SB_;
                        t = S.xy * an.xy + t; SB_;
                        f32x2 u01 = kp.xy * vv; SB_;
                        float x = t.x + t.y; SB_;
                        f32x2 u23 = kp.zw * vv; SB_;
                        u01 = S.xy * w.xy + u01; SB_;
                        x += dpp_f(x, 0); SB_;
                        u23 = S.zw * w.zw + u23; SB_;
                        if (more) nw = ((const LAS f32x4*)sp)[kq]; SB_;
                        x += dpp_f(x, 1); SB_;
                        if (more) nan_ = ((const LAS f32x4*)(sp + 64))[kq]; SB_;
                        if (more) nbv = ((const LAS f32x4*)(sp + 128))[kq]; SB_;
                        x += dpp_f(x, 2); SB_;
                        if (more) nkp = ((const LAS f32x4*)(sp + 192))[kq]; SB_;
                        if (more) nvv = sp[256 + vrow]; SB_;
                        x += dpp_f(x, 3); SB_;
                        S.xy = bv.xy * x + u01; SB_;
                        S.zw = bv.zw * x + u23; SB_;
                        *(LAS u32x2*)(spw + st * 2304) = (u32x2){pk2(S.x, S.y), pk2(S.z, S.w)}; SB_;
                        w = nw; an = nan_; bv = nbv; kp = nkp; vv = nvv;
                    }
#undef SB_
                    __syncthreads();
                }
                __builtin_amdgcn_s_setprio(0);
            }
            __syncthreads();
        }
        if (bx >= 64) {
            const float lam = misc[0];
            LAS unsigned* shu = (LAS unsigned*)(lds + LDS_MISC);
            const int c = wave >> 2, qg = wave & 3, r32 = lane & 31, hh = lane >> 5;
            for (;;) {
                if (tid == 0) shu[0] = atomicAdd(qctr, 1u);
                __syncthreads();
                const unsigned un = shu[0];
                if (un >= 512u) break;
                const int qi = (un < 16u * NT0) ? (2 * NT0 - 1) - (int)(un >> 3) : 63 - (int)((un - 16u * NT0) >> 3), bh = (int)(un & 7u), b = bh >> 2, h = bh & 3;
                const int qbase = NMETA + 128 * qi + 32 * qg, qpos = qbase + r32;
                const bf16* qrow = Qb + ((size_t)bh * VP + qpos) * 128 + c * 64 + 8 * hh;
                bf16x8 qf[4];
#pragma unroll
                for (int s = 0; s < 4; ++s) qf[s] = *(const bf16x8*)(qrow + 16 * s);
                f32x16 o[4];
#pragma unroll
                for (int d = 0; d < 4; ++d)
#pragma unroll
                    for (int e = 0; e < 16; ++e) o[d][e] = 0.f;
                float mrun = -1e30f, lsum = 0.f;
                const int ntiles = 2 * qi + 3;
                const bf16* ksrc[2]; const bf16* vsrc[2]; int kdst[2], vdst[2];
#pragma unroll
                for (int ii = 0; ii < 2; ++ii) { const int id = tid + NTHR * ii;
                    ksrc[ii] = Kb + ((size_t)bh * VP + (id >> 4)) * 128 + (id & 15) * 8; kdst[ii] = (id >> 4) * 272 + (id & 15) * 16;
                    vsrc[ii] = Vt + ((size_t)bh * 128 + (id >> 3)) * VP + (id & 7) * 8; vdst[ii] = ATT_KB + (id >> 3) * 136 + (id & 7) * 16; }
                u32x4 kr[2], vr[2];
#define ATT_LOAD(j_) do { _Pragma("unroll") for (int ii = 0; ii < 2; ++ii) { kr[ii] = *(const u32x4*)(ksrc[ii] + (size_t)(j_) * 64 * 128); vr[ii] = *(const u32x4*)(vsrc[ii] + (j_) * 64); } } while (0)
#define ATT_WRITE(j_) do { LAS unsigned char* bb_ = lds + ((j_) & 1) * ATT_BUF; _Pragma("unroll") for (int ii = 0; ii < 2; ++ii) { *(LAS u32x4*)(bb_ + kdst[ii]) = kr[ii]; \
        *(LAS u32x2*)(bb_ + vdst[ii]) = (u32x2){vr[ii].x, vr[ii].y}; *(LAS u32x2*)(bb_ + vdst[ii] + 8) = (u32x2){vr[ii].z, vr[ii].w}; } } while (0)
                ATT_LOAD(0); ATT_WRITE(0);
                __syncthreads();
                for (int j = 0; j < ntiles; ++j) {
                    if (j + 1 < ntiles) ATT_LOAD(j + 1);
                    if (64 * j <= qbase + 31) {
                        const LAS unsigned char* kb_ = lds + (j & 1) * ATT_BUF + r32 * 272 + c * 128 + hh * 16;
                        const LAS unsigned char* vb_ = lds + (j & 1) * ATT_BUF + ATT_KB + r32 * 136 + hh * 8;
                        f32x16 s0, s1;
#pragma unroll
                        for (int e = 0; e < 16; ++e) { s0[e] = 0.f; s1[e] = 0.f; }
#pragma unroll
                        for (int s = 0; s < 4; ++s) { s0 = mfma32(*(const LAS bf16x8*)(kb_ + s * 32), qf[s], s0); s1 = mfma32(*(const LAS bf16x8*)(kb_ + 32 * 272 + s * 32), qf[s], s1); }
                        if (64 * j + 63 > qbase) {
#pragma unroll
                            for (int e = 0; e < 16; ++e) { const int key = 64 * j + (e & 3) + 8 * (e >> 2) + 4 * hh; if (key > qpos) s0[e] = -1e30f; if (key + 32 > qpos) s1[e] = -1e30f; }
                        }
                        float tm = fmaxf(s0[0], s1[0]);
#pragma unroll
                        for (int e = 1; e < 16; ++e) tm = fmaxf(tm, fmaxf(s0[e], s1[e]));
                        tm = fmaxf(tm, __shfl_xor(tm, 32));
                        const float mnew = fmaxf(mrun, tm), alpha = __builtin_amdgcn_exp2f(mrun - mnew); mrun = mnew;
                        float rsum = 0.f;
#pragma unroll
                        for (int e = 0; e < 16; ++e) { s0[e] = __builtin_amdgcn_exp2f(s0[e] - mnew); s1[e] = __builtin_amdgcn_exp2f(s1[e] - mnew); rsum += s0[e] + s1[e]; }
                        lsum = lsum * alpha + rsum;
                        if (__builtin_amdgcn_ballot_w64(alpha != 1.0f) != 0ull) {
#pragma unroll
                            for (int d = 0; d < 4; ++d) o[d] = o[d] * alpha;
                        }
                        bf16x8 pf[4];
#pragma unroll
                        for (int s = 0; s < 4; ++s) { u32x4 w;
                            if (s < 2) { w.x = pk2(s0[8 * s], s0[8 * s + 1]); w.y = pk2(s0[8 * s + 2], s0[8 * s + 3]); w.z = pk2(s0[8 * s + 4], s0[8 * s + 5]); w.w = pk2(s0[8 * s + 6], s0[8 * s + 7]); }
                            else { const int t = s - 2; w.x = pk2(s1[8 * t], s1[8 * t + 1]); w.y = pk2(s1[8 * t + 2], s1[8 * t + 3]); w.z = pk2(s1[8 * t + 4], s1[8 * t + 5]); w.w = pk2(s1[8 * t + 6], s1[8 * t + 7]); }
                            pf[s] = __builtin_bit_cast(bf16x8, w); }
#pragma unroll
                        for (int d = 0; d < 4; ++d)
#pragma unroll
                            for (int s = 0; s < 4; ++s) {
                                const u32x2 lo = *(const LAS u32x2*)(vb_ + d * 32 * 136 + s * 32), hi = *(const LAS u32x2*)(vb_ + d * 32 * 136 + s * 32 + 16);
                                const u32x4 vv = {lo.x, lo.y, hi.x, hi.y};
                                o[d] = mfma32(__builtin_bit_cast(bf16x8, vv), pf[s], o[d]);
                            }
                    }
                    if (j + 1 < ntiles) ATT_WRITE(j + 1);
                    __syncthreads();
                }
#undef ATT_LOAD
#undef ATT_WRITE
                lsum += __shfl_xor(lsum, 32);
                const float inv = 1.0f / lsum;
                LAS float* X = (LAS float*)lds;
                if (c == 1) {
#pragma unroll
                    for (int d = 0; d < 4; ++d)
#pragma unroll
                        for (int e = 0; e < 16; ++e) X[((qg * 4 + d) * 16 + e) * 64 + lane] = o[d][e] * inv;
                }
                __syncthreads();
                if (c == 0) {
                    float sq = 0.f;
#pragma unroll
                    for (int d = 0; d < 4; ++d)
#pragma unroll
                        for (int e = 0; e < 16; ++e) { const float v = o[d][e] * inv - lam * X[((qg * 4 + d) * 16 + e) * 64 + lane]; o[d][e] = v; sq += v * v; }
                    sq += __shfl_xor(sq, 32);
                    const float rn = rsqrtf(sq * (1.0f / 128) + NORM_EPS) * 0.8f;
                    bf16* orow = XB + (size_t)(b * T + 128 * qi + 32 * qg + r32) * D + h * 128;
#pragma unroll
                    for (int d = 0; d < 4; ++d)
#pragma unroll
                        for (int g4 = 0; g4 < 4; ++g4) {
                            const int dv0 = 32 * d + 8 * g4 + 4 * hh;
                            const f32x4 sl = *(const f32x4*)(args.in[I_SUBLN] + dv0);
                            u32x2 w; w.x = pk2(o[d][4 * g4] * rn * sl.x, o[d][4 * g4 + 1] * rn * sl.y); w.y = pk2(o[d][4 * g4 + 2] * rn * sl.z, o[d][4 * g4 + 3] * rn * sl.w);
                            *(u32x2*)(orow + dv0) = w;
                        }
                }
                __syncthreads();
            }
        }
        if (bx >= 64) {
            LAS float* scr = (LAS float*)(lds + wave * 16640);
            constexpr int IT_G = (D / 64) * (FF / 64), IT_D = (FF / 64) * (D / 64), NIT = 2 * IT_G + IT_D;
            for (int it = (bx - 64) * NWAVES + wave; it < NIT; it += (G - 64) * NWAVES) {
                int r = it;
                if (r < IT_G) { transpose_item(args.in[I_F2G], D, FF, W2A, args.in[I_F2N], 1, scr, r, lane); continue; } r -= IT_G;
                if (r < IT_G) { transpose_item(args.in[I_F2U], D, FF, W2A, args.in[I_F2N], 2, scr, r, lane); continue; } r -= IT_G;
                transpose_item(args.in[I_F2D], FF, D, W2D, nullptr, 0, scr, r, lane);
            }
            unsigned* subw = (unsigned*)(sm + SM_BAR) + SUBW;
            XcdBarrier xsub; xsub.bar = (unsigned*)(sm + SM_BAR) + 4096; xsub.x = xbar.x; xsub.st = (volatile LAS unsigned*)(lds + LDS_MISC + 72); const unsigned GS = (unsigned)(G - 64);
            xcd_barrier(xsub, GS);
            wait_flag(subw + 64 * 7, 64u);
            TAIL_HALF(0, G - 64, bx - 64, xcd_barrier(xsub, GS), xcd_barrier(xsub, GS));
        }
    }
    xcd_barrier(xbar);

    TAIL_HALF(1, G, bx, xcd_barrier(xbar), xcd_barrier(xbar));
    xcd_barrier(xbar);
    {
        pg8::Gemm g{TC, W2D, M, D, FF}; pg8::StaticOrder S; S.init(M, D, G, bx);
        EpiRes E{out, out, nullptr, nullptr, 0.5f, 0, 3};
        pg8::gemm_phase<EpiRes, pg8::StaticOrder, PG8_ALIGN, PG8_SP2>(lds, g, S, E);
    }
}

extern "C" void kernel_launch(void* const* d_in, const int* in_sizes, int n_in, void* d_out, int out_size, void* d_ws, size_t ws_size, hipStream_t stream) {
    static int grid = 0;
    if (grid == 0) {
        if (n_in != 31 || out_size != M * D || ws_size < WS_END) { fprintf(stderr, "kernel_launch: unexpected shapes (n_in %d out %d ws %zu)\n", n_in, out_size, ws_size); grid = -1; return; }
        int dev = 0, cus = 0, per_cu = 0;
        (void)hipGetDevice(&dev); (void)hipDeviceGetAttribute(&cus, hipDeviceAttributeMultiprocessorCount, dev);
        if (hipFuncSetAttribute((const void*)fwd_kernel, hipFuncAttributeMaxDynamicSharedMemorySize, LDS_BYTES) != hipSuccess) { fprintf(stderr, "kernel_launch: hipFuncSetAttribute failed\n"); grid = -1; return; }
        if (hipOccupancyMaxActiveBlocksPerMultiprocessor(&per_cu, (const void*)fwd_kernel, NTHR, LDS_BYTES) != hipSuccess || per_cu < 1) { fprintf(stderr, "kernel_launch: occupancy query says %d\n", per_cu); per_cu = 1; }
        (void)hipGetLastError();
        grid = cus;
        if (grid > cus * per_cu) grid = cus * per_cu;
        if (grid > 256) grid = 256;
    }
    if (grid < 0) return;
    Args a{};
    for (int i = 0; i < 31; ++i) a.in[i] = (const float*)d_in[i];
    a.out = (float*)d_out; a.ws = (unsigned char*)d_ws;
    (void)hipMemsetAsync((unsigned char*)d_ws + WS_SMALL + SM_BAR, 0, 32768, stream);
    void* kargs[] = {&a};
    hipError_t e = hipLaunchCooperativeKernel((const void*)fwd_kernel, dim3(grid), dim3(NTHR), kargs, LDS_BYTES, stream);
    if (e != hipSuccess) fprintf(stderr, "cooperative launch failed: %s (grid %d)\n", hipGetErrorString(e), grid);
}
```
